# Optimizing an MI355X kernel written in HIP

```python
import math
import jax, jax.numpy as jnp
from jax import lax
import numpy as np

D_MODEL = 1024
BATCH = 4
SEQ = 4096
DEPTH = 2

GRID_W = 64
CTX_LEN = 256
HEAD_DIM = 64
ROPE_FREQS = HEAD_DIM // 4
ROPE_THETA = 10000.0
Q_BLOCK = 128
EPS = 1e-6
ATTN_SCALE = HEAD_DIM ** -0.5

FOURIER_GROUP_DIM = 64
FOURIER_GROUPS = (3 * D_MODEL // 8) // FOURIER_GROUP_DIM
FOURIER_WIDTH = FOURIER_GROUPS * FOURIER_GROUP_DIM
DIFF_HEADS = D_MODEL // 256
DIFF_QK_WIDTH = DIFF_HEADS * 2 * HEAD_DIM
DIFF_V_DIM = 2 * HEAD_DIM
DIFF_V_WIDTH = DIFF_HEADS * DIFF_V_DIM
GQA_Q_HEADS = D_MODEL // 128
GQA_GROUP = 4
GQA_KV_HEADS = GQA_Q_HEADS // GQA_GROUP
GQA_Q_WIDTH = GQA_Q_HEADS * HEAD_DIM
GQA_KV_WIDTH = GQA_KV_HEADS * HEAD_DIM
CONV_WIDTH = 3 * D_MODEL // 8
CONV_KERNEL = 31
N_BRANCHES = 4
D_FF = 4 * D_MODEL
N_MOD = 6

KV_SIZES = (DIFF_QK_WIDTH, DIFF_V_WIDTH, GQA_KV_WIDTH, GQA_KV_WIDTH)
REST_SIZES = (FOURIER_WIDTH, DIFF_QK_WIDTH, GQA_Q_WIDTH, 2 * CONV_WIDTH, N_BRANCHES * D_MODEL)
KV_COLS = sum(KV_SIZES)
IN_COLS = KV_COLS + sum(REST_SIZES)

kernel_name = "hybrid_parallel_dit_block"


def _split(t, sizes):
    idx = np.cumsum(sizes)[:-1].tolist()
    return jnp.split(t, idx, axis=-1)


def _rms_norm(x, g):
    xf = x.astype(jnp.float32)
    y = xf * lax.rsqrt(jnp.mean(xf * xf, axis=-1, keepdims=True) + EPS)
    return (y * g.astype(jnp.float32)).astype(x.dtype)


def _layer_norm(x, g, b):
    xf = x.astype(jnp.float32)
    mu = jnp.mean(xf, axis=-1, keepdims=True)
    var = jnp.mean(jnp.square(xf - mu), axis=-1, keepdims=True)
    y = (xf - mu) * lax.rsqrt(var + EPS) * g.astype(jnp.float32) + b.astype(jnp.float32)
    return y.astype(x.dtype)


def _modulate(x, g, shift, scale):
    return _rms_norm(x, g) * (1 + scale) + shift


def _axial_rope_tables(seq_len):
    rows = seq_len // GRID_W
    row = jnp.repeat(jnp.arange(rows, dtype=jnp.float32), GRID_W)
    col = jnp.tile(jnp.arange(GRID_W, dtype=jnp.float32), rows)
    inv_freq = ROPE_THETA ** (-jnp.arange(ROPE_FREQS, dtype=jnp.float32) / ROPE_FREQS)
    ang = jnp.stack([row[:, None] * inv_freq, col[:, None] * inv_freq], axis=1)
    return jnp.cos(ang), jnp.sin(ang)


def _apply_rope(x, cos, sin):
    xf = x.astype(jnp.float32).reshape(x.shape[:-1] + (2, 2, ROPE_FREQS))
    bshape = (cos.shape[0],) + (1,) * (x.ndim - 3) + cos.shape[1:]
    cs, sn = cos.reshape(bshape), sin.reshape(bshape)
    re, im = xf[..., 0, :], xf[..., 1, :]
    out = jnp.stack([re * cs - im * sn, im * cs + re * sn], axis=-2)
    return out.reshape(x.shape).astype(x.dtype)


def _kv_heads(kv, k_norm):
    b, l = kv.shape[:2]
    dk, dv, gk, gv = _split(kv, KV_SIZES)
    dk = dk.reshape(b, l, DIFF_HEADS, 2, HEAD_DIM)
    dv = dv.reshape(b, l, DIFF_HEADS, DIFF_V_DIM)
    gk = _rms_norm(gk.reshape(b, l, GQA_KV_HEADS, HEAD_DIM), k_norm)
    gv = gv.reshape(b, l, GQA_KV_HEADS, HEAD_DIM)
    return dk, dv, gk, gv


def _diff_attention(dq, dk, dv, lam):
    s = jnp.einsum('bqhjd,bkhjd->bhjqk', dq, dk).astype(jnp.float32) * ATTN_SCALE
    p = jax.nn.softmax(s, axis=-1)
    a = (p[:, :, 0] - lam * p[:, :, 1]).astype(dv.dtype)
    return jnp.einsum('bhqk,bkhe->bqhe', a, dv)


def _gqa_attention(gq, gk, gv):
    s = jnp.einsum('bqhgd,bkhd->bhgqk', gq, gk).astype(jnp.float32) * ATTN_SCALE
    p = jax.nn.softmax(s, axis=-1).astype(gv.dtype)
    return jnp.einsum('bhgqk,bkhd->bqhgd', p, gv)


def _sweep_query_blocks(fn, qs):
    b, l = qs[0].shape[:2]
    n = l // Q_BLOCK
    def to_blocks(q):
        return jnp.moveaxis(q.reshape((b, n, Q_BLOCK) + q.shape[2:]), 1, 0)
    out = lax.map(lambda qb: fn(*qb), tuple(to_blocks(q) for q in qs))
    def from_blocks(o):
        return jnp.moveaxis(o, 0, 1).reshape((b, l) + o.shape[3:])
    return jax.tree_util.tree_map(from_blocks, out)


def _fourier_mix(u):
    b, l = u.shape[:2]
    ug = u.astype(jnp.float32).reshape(b, l, FOURIER_GROUPS, FOURIER_GROUP_DIM)
    y = jnp.fft.fft2(ug, axes=(1, 3), norm='ortho').real
    return y.reshape(b, l, FOURIER_WIDTH).astype(u.dtype)


def _conformer_conv(u, dw, dw_bias, ln_g, ln_b):
    a, g = jnp.split(u, 2, axis=-1)
    v = a * jax.nn.sigmoid(g)
    y = lax.conv_general_dilated(
        v, dw[:, None, :], window_strides=(1,),
        padding=[(CONV_KERNEL // 2, CONV_KERNEL // 2)],
        dimension_numbers=('NWC', 'WIO', 'NWC'),
        feature_group_count=CONV_WIDTH) + dw_bias
    return jax.nn.silu(_layer_norm(y, ln_g, ln_b))


def _token_mixer(h, kv_ctx, rope, lp, lam, lam_init):
    b, l = h.shape[:2]
    w_in = lp['w_in']
    if rope is None:
        rest = h @ w_in[:, KV_COLS:]
        dk, dv, gk, gv = kv_ctx
    else:
        proj = h @ w_in
        dk, dv, gk, gv = _kv_heads(proj[..., :KV_COLS], lp['k_norm'])
        rest = proj[..., KV_COLS:]
    u_f, dq, gq, u_c, gate_logits = _split(rest, REST_SIZES)
    dq = dq.reshape(b, l, DIFF_HEADS, 2, HEAD_DIM)
    gq = _rms_norm(gq.reshape(b, l, GQA_KV_HEADS, GQA_GROUP, HEAD_DIM), lp['q_norm'])
    if rope is None:
        o_d = _diff_attention(dq, dk, dv, lam)
        o_g = _gqa_attention(gq, gk, gv)
    else:
        cos, sin = rope
        dq, dk = _apply_rope(dq, cos, sin), _apply_rope(dk, cos, sin)
        gq, gk = _apply_rope(gq, cos, sin), _apply_rope(gk, cos, sin)
        cdk, cdv, cgk, cgv = kv_ctx
        dk_all = jnp.concatenate([dk, cdk], axis=1)
        dv_all = jnp.concatenate([dv, cdv], axis=1)
        gk_all = jnp.concatenate([gk, cgk], axis=1)
        gv_all = jnp.concatenate([gv, cgv], axis=1)
        o_d, o_g = _sweep_query_blocks(
            lambda qd, qg: (_diff_attention(qd, dk_all, dv_all, lam), _gqa_attention(qg, gk_all, gv_all)),
            (dq, gq))
    o_d = (_rms_norm(o_d, lp['subln']) * (1.0 - lam_init)).reshape(b, l, DIFF_V_WIDTH)
    o_g = o_g.reshape(b, l, GQA_Q_WIDTH)
    y_f = _fourier_mix(u_f)
    y_c = _conformer_conv(u_c, lp['conv_dw'], lp['conv_dw_bias'], lp['conv_ln_g'], lp['conv_ln_b'])
    g_f, g_d, g_g, g_c = jnp.split(jax.nn.sigmoid(gate_logits), N_BRANCHES, axis=-1)
    merged = (g_f * (y_f @ lp['w_br_fourier']) + g_d * (o_d @ lp['w_br_diff'])
              + g_g * (o_g @ lp['w_br_gqa']) + g_c * (y_c @ lp['w_br_conv']))
    return merged @ lp['w_out']


def _sq_relu_mlp(h, w1, w2):
    return jnp.square(jax.nn.relu(h @ w1)) @ w2


def setup_inputs(seed: int = 0) -> dict:
    key = jax.random.key(seed)
    ks = jax.random.split(key, 32)
    f32 = jnp.float32
    def nrm(k, shape, scale):
        return jax.random.normal(k, shape, f32) * scale
    def gain(k, shape):
        return 1.0 + 0.02 * jax.random.normal(k, shape, f32)
    D = D_MODEL
    return {
        "x": nrm(ks[0], (BATCH, SEQ, D), 1.0),
        "c": nrm(ks[1], (BATCH, D), 1.0),
        "ctx": nrm(ks[2], (BATCH, CTX_LEN, D), 1.0),
        "c_ctx": nrm(ks[3], (D,), 1.0),
        "w_mod": nrm(ks[4], (DEPTH, D, N_MOD * D), 0.5 * D ** -0.5),
        "b_mod": nrm(ks[5], (DEPTH, N_MOD * D), 0.01),
        "g_pre_mix": gain(ks[6], (DEPTH, D)),
        "g_post_mix": gain(ks[7], (DEPTH, D)),
        "g_pre_mlp": gain(ks[8], (DEPTH, D)),
        "g_post_mlp": gain(ks[9], (DEPTH, D)),
        "w_in": nrm(ks[10], (DEPTH, D, IN_COLS), D ** -0.5),
        "q_norm": gain(ks[11], (DEPTH, HEAD_DIM)),
        "k_norm": gain(ks[12], (DEPTH, HEAD_DIM)),
        "diff_lambda": nrm(ks[13], (DEPTH, 4, HEAD_DIM), 0.1),
        "diff_subln": gain(ks[14], (DEPTH, DIFF_V_DIM)),
        "conv_dw": nrm(ks[15], (DEPTH, CONV_KERNEL, CONV_WIDTH), CONV_KERNEL ** -0.5),
        "conv_dw_bias": nrm(ks[16], (DEPTH, CONV_WIDTH), 0.01),
        "conv_ln_g": gain(ks[17], (DEPTH, CONV_WIDTH)),
        "conv_ln_b": nrm(ks[18], (DEPTH, CONV_WIDTH), 0.01),
        "w_br_fourier": nrm(ks[19], (DEPTH, FOURIER_WIDTH, D), FOURIER_WIDTH ** -0.5),
        "w_br_diff": nrm(ks[20], (DEPTH, DIFF_V_WIDTH, D), DIFF_V_WIDTH ** -0.5),
        "w_br_gqa": nrm(ks[21], (DEPTH, GQA_Q_WIDTH, D), GQA_Q_WIDTH ** -0.5),
        "w_br_conv": nrm(ks[22], (DEPTH, CONV_WIDTH, D), CONV_WIDTH ** -0.5),
        "w_out": nrm(ks[23], (DEPTH, D, D), D ** -0.5),
        "w_ff1": nrm(ks[24], (DEPTH, D, D_FF), D ** -0.5),
        "w_ff2": nrm(ks[25], (DEPTH, D_FF, D), D_FF ** -0.5),
    }


def reference(x, c, ctx, c_ctx, w_mod, b_mod, g_pre_mix, g_post_mix, g_pre_mlp, g_post_mlp,
              w_in, q_norm, k_norm, diff_lambda, diff_subln, conv_dw, conv_dw_bias, conv_ln_g, conv_ln_b,
              w_br_fourier, w_br_diff, w_br_gqa, w_br_conv, w_out, w_ff1, w_ff2):
    rope = _axial_rope_tables(x.shape[1])
    xc = ctx
    for l in range(DEPTH):
        lp = {
            'w_in': w_in[l], 'q_norm': q_norm[l], 'k_norm': k_norm[l], 'subln': diff_subln[l],
            'conv_dw': conv_dw[l], 'conv_dw_bias': conv_dw_bias[l],
            'conv_ln_g': conv_ln_g[l], 'conv_ln_b': conv_ln_b[l],
            'w_br_fourier': w_br_fourier[l], 'w_br_diff': w_br_diff[l],
            'w_br_gqa': w_br_gqa[l], 'w_br_conv': w_br_conv[l], 'w_out': w_out[l],
        }
        lam_init = 0.8 - 0.6 * math.exp(-0.3 * l)
        lv = diff_lambda[l].astype(jnp.float32)
        lam = jnp.exp(jnp.sum(lv[0] * lv[1])) - jnp.exp(jnp.sum(lv[2] * lv[3])) + lam_init

        mod_x = (jax.nn.silu(c) @ w_mod[l] + b_mod[l])[:, None, :]
        mod_c = (jax.nn.silu(c_ctx) @ w_mod[l] + b_mod[l])[None, None, :]
        sx1, cx1, gx1, sx2, cx2, gx2 = jnp.split(mod_x, N_MOD, axis=-1)
        sc1, cc1, gc1, sc2, cc2, gc2 = jnp.split(mod_c, N_MOD, axis=-1)

        hc = _modulate(xc, g_pre_mix[l], sc1, cc1)
        kv_ctx = _kv_heads(hc @ w_in[l][:, :KV_COLS], k_norm[l])

        h = _modulate(x, g_pre_mix[l], sx1, cx1)
        x = x + gx1 * _rms_norm(_token_mixer(h, kv_ctx, rope, lp, lam, lam_init), g_post_mix[l])
        hm = _modulate(x, g_pre_mlp[l], sx2, cx2)
        x = x + gx2 * _rms_norm(_sq_relu_mlp(hm, w_ff1[l], w_ff2[l]), g_post_mlp[l])

        if l < DEPTH - 1:
            xc = xc + gc1 * _rms_norm(_token_mixer(hc, kv_ctx, None, lp, lam, lam_init), g_post_mix[l])
            hcm = _modulate(xc, g_pre_mlp[l], sc2, cc2)
            xc = xc + gc2 * _rms_norm(_sq_relu_mlp(hcm, w_ff1[l], w_ff2[l]), g_post_mlp[l])
    return x
```

```cpp
#include <hip/hip_runtime.h>
#include <hip/hip_cooperative_groups.h>
#include <cstdint>
#include <cstdio>
namespace cg = cooperative_groups;

#define LAS __attribute__((address_space(3)))
#define DI __device__ __forceinline__
typedef unsigned short bf16_t;
typedef short bf16x8 __attribute__((ext_vector_type(8)));
typedef short s16x4 __attribute__((ext_vector_type(4)));
typedef float f32x4 __attribute__((ext_vector_type(4)));
typedef float f32x2 __attribute__((ext_vector_type(2)));
typedef float f32x16 __attribute__((ext_vector_type(16)));
typedef unsigned u32x4 __attribute__((ext_vector_type(4)));
typedef unsigned u32x2 __attribute__((ext_vector_type(2)));
typedef __bf16 bf16x2_t __attribute__((ext_vector_type(2)));

DI unsigned pk2(float lo, float hi) { f32x2 v = {lo, hi}; return __builtin_bit_cast(unsigned, __builtin_convertvector(v, bf16x2_t)); }
DI float bflo(unsigned u) { return __uint_as_float(u << 16); }
DI float bfhi(unsigned u) { return __uint_as_float(u & 0xffff0000u); }
DI float sigmoidf_(float x) { return __builtin_amdgcn_rcpf(1.0f + __builtin_amdgcn_exp2f(-1.44269504f * x)); }
DI int tid_() { int t = threadIdx.x; asm volatile("" : "+v"(t)); return t; }
DI float wave_sum(float v) {
#pragma unroll
    for (int o = 32; o >= 1; o >>= 1) v += __shfl_xor(v, o);
    return v;
}

constexpr int D = 1024, NB = 4, SEQ = 4096, LC = 256, MLAT = NB * SEQ, MCTX = NB * LC, MTOT = MLAT + MCTX, LKV = SEQ + LC;
constexpr int IN_COLS = 7552, NIN = 7936, DFF = 4096, KBR = 1792;
constexpr float EPS = 1e-6f;
constexpr float QSCALE = 0.125f * 1.44269504f;
enum { I_X = 0, I_C, I_CTX, I_CCTX, I_WMOD, I_BMOD, I_GPREMIX, I_GPOSTMIX, I_GPREMLP, I_GPOSTMLP, I_WIN, I_QNORM, I_KNORM, I_LAMBDA, I_SUBLN,
       I_CONVDW, I_CONVB, I_CONVLNG, I_CONVLNB, I_WBRF, I_WBRD, I_WBRG, I_WBRC, I_WOUT, I_WFF1, I_WFF2 };

constexpr size_t OFF_CTL = 0, OFF_MISC = 4096, OFF_MOD = 8192, OFF_ROPE = 253952, OFF_DFTC = 262144, OFF_HS = 524288;
constexpr size_t OFF_WINT = OFF_HS + (size_t)MTOT * D * 2;
constexpr size_t ARENA = OFF_WINT + (size_t)NIN * D * 2;
constexpr size_t A_BRQ = ARENA, A_MIXO = ARENA;
constexpr size_t A_G = ARENA + (size_t)MTOT * KBR * 2;
constexpr size_t A_DFT = A_G;
constexpr size_t A_FTF = A_DFT + (size_t)4096 * 4096 * 2;
constexpr size_t A_FT = A_DFT + (size_t)4096 * 8192 * 2;
constexpr size_t A_FTC = A_FT + (size_t)NB * 384 * 8192 * 2;
constexpr size_t A_DK = A_FTC + (size_t)NB * 384 * 512 * 2;
constexpr size_t A_DV = A_DK + (size_t)MTOT * 512 * 2;
constexpr size_t A_GK = A_DV + (size_t)MTOT * 512 * 2;
constexpr size_t A_GV = A_GK + (size_t)MTOT * 128 * 2;
constexpr size_t A_V = A_GV + (size_t)MTOT * 128 * 2;
constexpr size_t A_VEND = A_V + (size_t)MTOT * 384 * 2;
constexpr size_t A_WBRT = A_G + (size_t)MTOT * 4096 * 2;
constexpr size_t A_WOUTT = A_WBRT + (size_t)D * KBR * 2;
constexpr size_t A_FF = ARENA + (size_t)MTOT * D * 2;
constexpr size_t A_WFF1T = A_FF + (size_t)MTOT * DFF * 2;
constexpr size_t A_WFF2T = A_WFF1T + (size_t)DFF * D * 2;
constexpr size_t A_XC = A_WFF2T + (size_t)DFF * D * 2;
constexpr size_t OFF_BAR = A_VEND;
constexpr size_t WS_END = OFF_BAR + 16384;
static_assert(A_XC + (size_t)MCTX * D * 4 <= A_WBRT, "xc overlaps");
static_assert(A_WOUTT + (size_t)D * D * 2 <= WS_END, "ws end");
static_assert(WS_END <= 268435456ull, "workspace too large");

constexpr int LDS_BYTES = 131072 + 256 + 18432;
constexpr int NTHREADS = 512;

namespace pg8 {
constexpr int BM = 256, BK = 64, HALF = 128, HTB = HALF * BK * 2, NXCD = 8, WGM = 8;
DI int lds_byte(int r, int c) { const int st = (r >> 4) * 2 + (c >> 5), rr = r & 15, cc = c & 31, ob = rr * 64 + cc * 2; return st * 1024 + (ob ^ (((ob >> 9) & 1) << 5)); }
DI void stage_rc(int b, int& R, int& C) { const int st = b / 1024, sb = b % 1024, swz = sb ^ (((sb >> 9) & 1) << 5); R = (st >> 1) * 16 + swz / 64; C = (st & 1) * 32 + (swz % 64) / 2; }
DI int perm32(int rho) { const int n = rho >> 4, i = rho & 15; return 8 * (i >> 2) + 4 * n + (i & 3); }

struct Unit { const char* A; const char* B; int nt, pm, pn; };

DI void rect_map(int L, int nM, int nN, int& pm, int& pn) {
    const int nwg = nM * nN; int wgid = L;
    { const int q = nwg / NXCD, r = nwg % NXCD, xcd = wgid % NXCD, off = wgid / NXCD; wgid = (xcd < r ? xcd * (q + 1) : r * (q + 1) + (xcd - r) * q) + off; }
    const int nig = WGM * nN, gid = wgid / nig, fm = gid * WGM, gsz = (nM - fm) < WGM ? (nM - fm) : WGM;
    pm = fm + ((wgid % nig) % gsz); pn = (wgid % nig) / gsz;
}

template <class Epi, class Sched>
DI void gemm_phase(LAS unsigned char* lds, const int lda, const int ldb, const Sched& S, const Epi& E) {
    int tid = threadIdx.x; asm volatile("" : "+v"(tid));
    const int wid = __builtin_amdgcn_readfirstlane(tid >> 6), lane = tid & 63, wr = wid >> 2, wc = wid & 3, fr = lane & 15, fq = lane >> 4;
    unsigned voffA[2], voffB[2];
#pragma unroll
    for (int i = 0; i < 2; ++i) { int R, C; stage_rc(tid * 16 + i * 8192, R, C); const int Rb = Epi::PERM ? ((R & ~31) + perm32(R & 31)) : R;
        voffA[i] = (unsigned)(R * lda + C) * 2u; voffB[i] = (unsigned)(Rb * ldb + C) * 2u; }
    const size_t kstep = (size_t)(BK * 2);
    const size_t hstepA = (size_t)HALF * lda * 2, hstepB = (size_t)HALF * ldb * 2;
    const unsigned ldsw = (unsigned)wid * 1024u;
    const int aoff = lds_byte(wr * 64 + fr, fq * 8), boff = lds_byte(wc * 32 + fr, fq * 8);
#define PG8_SA(b, h) (((b) * 2 + (h)) * HTB)
#define PG8_SB(b, h) ((4 + (b) * 2 + (h)) * HTB)
#define PG8_STAGE(bufoff, gbase, voff) do { _Pragma("unroll") for (int _i = 0; _i < 2; ++_i) \
        __builtin_amdgcn_global_load_lds((const unsigned*)((const char*)(gbase) + (voff)[_i]), (LAS unsigned*)(lds + (bufoff) + ldsw + _i * 8192), 16, 0, 0); } while (0)
#define PG8_LDA(dst, b, h) do { _Pragma("unroll") for (int m = 0; m < 4; ++m) _Pragma("unroll") for (int k = 0; k < 2; ++k) dst[m][k] = *(const LAS bf16x8*)(lds + PG8_SA(b, h) + aoff + m * 2048 + k * 1024); } while (0)
#define PG8_LDB(dst, b, h) do { _Pragma("unroll") for (int n = 0; n < 2; ++n) _Pragma("unroll") for (int k = 0; k < 2; ++k) dst[n][k] = *(const LAS bf16x8*)(lds + PG8_SB(b, h) + boff + n * 2048 + k * 1024); } while (0)
#define PG8_MMA(ai, bj, At, Bt) do { __builtin_amdgcn_s_setprio(1); _Pragma("unroll") for (int m = 0; m < 4; ++m) _Pragma("unroll") for (int n = 0; n < 2; ++n) _Pragma("unroll") for (int k = 0; k < 2; ++k) \
        acc[ai][bj][m][n] = __builtin_amdgcn_mfma_f32_16x16x32_bf16(Bt[n][k], At[m][k], acc[ai][bj][m][n], 0, 0, 0); __builtin_amdgcn_s_setprio(0); } while (0)
#define PG8_WAIT_V(n) asm volatile("s_waitcnt vmcnt(" #n ")" ::: "memory")
#define PG8_WAIT_L(n) asm volatile("s_waitcnt lgkmcnt(" #n ")" ::: "memory")
#define PG8_BAR __builtin_amdgcn_s_barrier()
#define PG8_SCHED __builtin_amdgcn_sched_barrier(0)
    Unit cur, nxt; int ui = 0;
    if (!S.next(0, cur)) return;
    f32x4 acc[2][2][4][2];
#pragma unroll
    for (int a = 0; a < 2; ++a)
#pragma unroll
        for (int b = 0; b < 2; ++b)
#pragma unroll
            for (int m = 0; m < 4; ++m)
#pragma unroll
                for (int n = 0; n < 2; ++n) acc[a][b][m][n] = (f32x4){0.f, 0.f, 0.f, 0.f};
    bf16x8 At[4][2], B0[2][2], B1[2][2];
    const char* cA = cur.A; const char* cB = cur.B;
    PG8_STAGE(PG8_SB(0, 0), cB, voffB); PG8_STAGE(PG8_SB(0, 1), cB + hstepB, voffB); PG8_STAGE(PG8_SA(0, 0), cA, voffA); PG8_STAGE(PG8_SA(0, 1), cA + hstepA, voffA);
    if (wr == 1) PG8_BAR;
    PG8_WAIT_V(2); PG8_BAR;
    PG8_STAGE(PG8_SB(1, 0), cB + kstep, voffB); PG8_STAGE(PG8_SA(1, 0), cA + kstep, voffA); PG8_STAGE(PG8_SB(1, 1), cB + hstepB + kstep, voffB);
    PG8_WAIT_V(6); PG8_BAR;
    for (;;) {
        const bool has_next = S.next(ui + 1, nxt);
        const char* nA = has_next ? nxt.A : cA; const char* nB = has_next ? nxt.B : cB;
        const int nt = cur.nt;
        for (int t = 0; t < nt; t += 2) {
            if constexpr (Epi::HOOK) { if (t == 6 || t == 14 || t == 22) E.hook(acc, cur, t, wr, wc, fr, fq); }
            const bool last = (t == nt - 2);
            const char* a1 = cA + (size_t)(t + 1) * kstep;
            const char* a2 = last ? nA : cA + (size_t)(t + 2) * kstep; const char* b2 = last ? nB : cB + (size_t)(t + 2) * kstep;
            const char* a3 = a2 + kstep; const char* b3 = b2 + kstep;
            PG8_LDB(B0, 0, 0); PG8_LDB(B1, 0, 1); PG8_SCHED; PG8_LDA(At, 0, 0); PG8_STAGE(PG8_SA(1, 1), a1 + hstepA, voffA);
            PG8_WAIT_V(8); PG8_WAIT_L(0); PG8_BAR; PG8_MMA(0, 0, At, B0); PG8_MMA(0, 1, At, B1); PG8_BAR; PG8_SCHED;
            PG8_LDA(At, 0, 1); PG8_STAGE(PG8_SB(0, 0), b2, voffB); PG8_STAGE(PG8_SB(0, 1), b2 + hstepB, voffB); PG8_STAGE(PG8_SA(0, 0), a2, voffA);
            PG8_WAIT_V(8); PG8_WAIT_L(0); PG8_BAR; PG8_MMA(1, 0, At, B0); PG8_MMA(1, 1, At, B1); PG8_BAR; PG8_SCHED;
            PG8_LDB(B0, 1, 0); PG8_LDB(B1, 1, 1); PG8_SCHED; PG8_LDA(At, 1, 0); PG8_STAGE(PG8_SA(0, 1), a2 + hstepA, voffA);
            PG8_WAIT_V(8); PG8_WAIT_L(0); PG8_BAR; PG8_MMA(0, 0, At, B0); PG8_MMA(0, 1, At, B1); PG8_BAR; PG8_SCHED;
            PG8_LDA(At, 1, 1); PG8_STAGE(PG8_SB(1, 0), b3, voffB); PG8_STAGE(PG8_SB(1, 1), b3 + hstepB, voffB); PG8_STAGE(PG8_SA(1, 0), a3, voffA);
            PG8_WAIT_V(8); PG8_WAIT_L(0); PG8_BAR; PG8_MMA(1, 0, At, B0); PG8_MMA(1, 1, At, B1); PG8_BAR; PG8_SCHED;
        }
        if (wr == 0) PG8_BAR;
        E(acc, cur, wr, wc, fr, fq);
        if (!has_next) break;
#pragma unroll
        for (int a = 0; a < 2; ++a)
#pragma unroll
            for (int b = 0; b < 2; ++b)
#pragma unroll
                for (int m = 0; m < 4; ++m)
#pragma unroll
                    for (int n = 0; n < 2; ++n) acc[a][b][m][n] = (f32x4){0.f, 0.f, 0.f, 0.f};
        cur = nxt; cA = nA; cB = nB; ++ui;
        if (wr == 1) PG8_BAR;
    }
    PG8_WAIT_V(0);
    PG8_BAR;
#undef PG8_SA
#undef PG8_SB
#undef PG8_STAGE
#undef PG8_LDA
#undef PG8_LDB
#undef PG8_MMA
#undef PG8_WAIT_V
#undef PG8_WAIT_L
#undef PG8_BAR
#undef PG8_SCHED
}
}
using pg8::Unit;
typedef f32x4 Acc[2][2][4][2];

struct RectSched {
    const char* A; const char* B; size_t astep, bstep;
    int nt, G, c, nM1, nN1, m2, nM2, nN2;
    DI bool next(int i, Unit& u) const {
        const int L = i * G + c; const int n1 = nM1 * nN1;
        int pm, pn;
        if (L < n1) pg8::rect_map(L, nM1, nN1, pm, pn);
        else if (L < n1 + nM2 * nN2) { pg8::rect_map(L - n1, nM2, nN2, pm, pn); pm += m2; }
        else return false;
        u.pm = pm; u.pn = pn; u.nt = nt; u.A = A + (size_t)pm * astep; u.B = B + (size_t)pn * bstep; return true;
    }
};
struct OneSched {
    Unit u; bool have;
    DI bool next(int i, Unit& o) const { if (i != 0 || !have) return false; o = u; return true; }
};

struct Ptrs {
    const float* in[26]; float* out; unsigned char* ws;
};

struct EpiInA {
    static constexpr bool PERM = true, HOOK = false;
    unsigned char* ws; const float* qn; const float* kn;
    LAS unsigned char* scr;
    unsigned* nrm;
    DI void hook(Acc&, const Unit&, int, int, int, int, int) const {}
    DI void operator()(const Acc& acc, const Unit& u, int wr, int wc, int fr, int fq) const {
        const int pn = u.pn;
        const f32x2* rope = (const f32x2*)(ws + OFF_ROPE);
        bf16_t* BRQ = (bf16_t*)(ws + A_BRQ);
        const bool ctx = u.pm >= 64;
        if (pn <= 1 || pn == 5 || pn == 6) {
            float nmax = 0.f;
#pragma unroll
            for (int ai = 0; ai < 2; ++ai)
#pragma unroll
                for (int m = 0; m < 4; ++m) {
                const int row = u.pm * 256 + ai * 128 + wr * 64 + m * 16 + fr;
                int b, t, kvrow;
                if (!ctx) { b = row >> 12; t = row & 4095; kvrow = b * LKV + t; }
                else { const int j = row - MLAT; b = j >> 8; t = j & 255; kvrow = b * LKV + SEQ + t; }
                const int prow = t >> 6, pcol = t & 63; (void)b; (void)kvrow; (void)prow; (void)pcol;
                    const bool isq = pn >= 5;
                    const int axis = wc & 1; const int pos = axis ? pcol : prow;
                    f32x2 cs[4];
#pragma unroll
                    for (int j = 0; j < 4; ++j) cs[j] = ctx ? (f32x2){1.f, 0.f} : rope[pos * 16 + 4 * fq + j];
#pragma unroll
                    for (int bj = 0; bj < 2; ++bj) {
                        const f32x4 re = acc[ai][bj][m][0], im = acc[ai][bj][m][1];
                        float o0[4], o1[4];
#pragma unroll
                        for (int j = 0; j < 4; ++j) { o0[j] = re[j] * cs[j].x - im[j] * cs[j].y; o1[j] = im[j] * cs[j].x + re[j] * cs[j].y; if (isq) { o0[j] *= QSCALE; o1[j] *= QSCALE; } }
                        const int c = (isq ? (pn - 5) : pn) * 256 + bj * 128 + wc * 32 + 8 * fq;
                        bf16_t* dst = isq ? (BRQ + (size_t)row * KBR + 384 + c) : ((bf16_t*)(ws + A_DK) + (size_t)kvrow * 512 + c);
                        *(u32x4*)dst = (u32x4){pk2(o0[0], o0[1]), pk2(o0[2], o0[3]), pk2(o1[0], o1[1]), pk2(o1[2], o1[3])};
                        float ss = o0[0] * o0[0] + o0[1] * o0[1] + o0[2] * o0[2] + o0[3] * o0[3] + o1[0] * o1[0] + o1[1] * o1[1] + o1[2] * o1[2] + o1[3] * o1[3];
                        ss += __shfl_xor(ss, 16); ss += __shfl_xor(ss, 32); nmax = fmaxf(nmax, ss);
                    }
                }
#pragma unroll
            for (int o = 8; o >= 1; o >>= 1) nmax = fmaxf(nmax, __shfl_xor(nmax, o));
            if (fq == 0 && fr == 0) atomicMax(nrm + (pn >= 5 ? 1 : 0), __float_as_uint(nmax));
        } else if (pn == 2 || pn == 3) {
#pragma unroll
            for (int ai = 0; ai < 2; ++ai)
#pragma unroll
                for (int m = 0; m < 4; ++m) {
                const int row = u.pm * 256 + ai * 128 + wr * 64 + m * 16 + fr;
                int b, t, kvrow;
                if (!ctx) { b = row >> 12; t = row & 4095; kvrow = b * LKV + t; }
                else { const int j = row - MLAT; b = j >> 8; t = j & 255; kvrow = b * LKV + SEQ + t; }
                const int prow = t >> 6, pcol = t & 63; (void)b; (void)kvrow; (void)prow; (void)pcol;
#pragma unroll
                    for (int bj = 0; bj < 2; ++bj)
#pragma unroll
                        for (int n = 0; n < 2; ++n) { const f32x4 v = acc[ai][bj][m][n]; const int c = (pn - 2) * 256 + bj * 128 + wc * 32 + 8 * fq + 4 * n;
                            *(u32x2*)((bf16_t*)(ws + A_DV) + (size_t)kvrow * 512 + c) = (u32x2){pk2(v[0], v[1]), pk2(v[2], v[3])}; }
                }
        } else if (pn == 4 || pn == 7 || pn == 8) {
#pragma unroll
            for (int ai = 0; ai < 2; ++ai)
#pragma unroll
                for (int m = 0; m < 4; ++m) {
                const int row = u.pm * 256 + ai * 128 + wr * 64 + m * 16 + fr;
                int b, t, kvrow;
                if (!ctx) { b = row >> 12; t = row & 4095; kvrow = b * LKV + t; }
                else { const int j = row - MLAT; b = j >> 8; t = j & 255; kvrow = b * LKV + SEQ + t; }
                const int prow = t >> 6, pcol = t & 63; (void)b; (void)kvrow; (void)prow; (void)pcol;
                    const bool isq = pn >= 7; const bool isv = (pn == 4) && wc >= 2;
                    float ss = 0.f;
#pragma unroll
                    for (int bj = 0; bj < 2; ++bj)
#pragma unroll
                        for (int n = 0; n < 2; ++n) { const f32x4 v = acc[ai][bj][m][n]; ss += v[0] * v[0] + v[1] * v[1] + v[2] * v[2] + v[3] * v[3]; }
                    ss += __shfl_xor(ss, 16); ss += __shfl_xor(ss, 32);
                    const float rs = isv ? 1.f : __builtin_amdgcn_rsqf(ss * (1.0f / 64.0f) + EPS);
                    const float* gn = isq ? qn : kn;
                    bf16_t* dst;
                    if (isq) dst = BRQ + (size_t)row * KBR + 896 + ((pn - 7) * 4 + wc) * 64;
                    else if (isv) dst = (bf16_t*)(ws + A_GV) + (size_t)kvrow * 128 + (wc - 2) * 64;
                    else dst = (bf16_t*)(ws + A_GK) + (size_t)kvrow * 128 + wc * 64;
#pragma unroll
                    for (int bj = 0; bj < 2; ++bj) {
                        const int pos = bj ? pcol : prow;
                        float o0[4], o1[4];
#pragma unroll
                        for (int j = 0; j < 4; ++j) {
                            float re = acc[ai][bj][m][0][j], im = acc[ai][bj][m][1][j];
                            if (!isv) { re *= rs * gn[32 * bj + 4 * fq + j]; im *= rs * gn[32 * bj + 16 + 4 * fq + j]; }
                            f32x2 cs = (ctx || isv) ? (f32x2){1.f, 0.f} : rope[pos * 16 + 4 * fq + j];
                            o0[j] = re * cs.x - im * cs.y; o1[j] = im * cs.x + re * cs.y;
                            if (isq) { o0[j] *= QSCALE; o1[j] *= QSCALE; }
                        }
                        *(u32x4*)(dst + 32 * bj + 8 * fq) = (u32x4){pk2(o0[0], o0[1]), pk2(o0[2], o0[3]), pk2(o1[0], o1[1]), pk2(o1[2], o1[3])};
                    }
                }
        } else if (pn <= 11) {
            const int lane = fq * 16 + fr, col = lane >> 2, chunk = lane & 3;
            LAS bf16_t* sw = (LAS bf16_t*)(scr + (wr * 4 + wc) * 2304);
#pragma unroll
            for (int ai = 0; ai < 2; ++ai) {
                const int row0 = u.pm * 256 + ai * 128 + wr * 64;
                int b, t0; if (!ctx) { b = row0 >> 12; t0 = row0 & 4095; } else { const int j = row0 - MLAT; b = j >> 8; t0 = j & 255; }
#pragma unroll
                for (int bj = 0; bj < 2; ++bj)
#pragma unroll
                    for (int n = 0; n < 2; ++n) {
#pragma unroll
                        for (int m = 0; m < 4; ++m) { const f32x4 v = acc[ai][bj][m][n];
#pragma unroll
                            for (int j = 0; j < 4; ++j) sw[(4 * fq + j) * 72 + 16 * m + fr] = (bf16_t)(pk2(v[j], 0.f) & 0xffffu); }
                        asm volatile("s_waitcnt lgkmcnt(0)" ::: "memory");
                        const u32x4 v0 = *(const LAS u32x4*)(sw + col * 72 + chunk * 16), v1 = *(const LAS u32x4*)(sw + col * 72 + chunk * 16 + 8);
                        const int c0 = (pn - 9) * 256 + bj * 128 + wc * 32 + 8 * (col >> 2) + 4 * n + (col & 3); const int part = c0 >= 384 ? 1 : 0; const int ch = c0 - part * 384;
                        bf16_t* dst = ctx ? ((bf16_t*)(ws + A_FTC) + (size_t)(b * 384 + ch) * 512 + part * 256 + t0 + chunk * 16)
                                          : ((bf16_t*)(ws + A_FT) + (size_t)(b * 384 + ch) * 8192 + part * 4096 + t0 + chunk * 16);
                        *(u32x4*)dst = v0; *(u32x4*)(dst + 8) = v1;
                        asm volatile("s_waitcnt lgkmcnt(0)" ::: "memory");
                    }
            }
        } else {
#pragma unroll
            for (int ai = 0; ai < 2; ++ai)
#pragma unroll
                for (int m = 0; m < 4; ++m) {
                const int row = u.pm * 256 + ai * 128 + wr * 64 + m * 16 + fr;
                int b, t, kvrow;
                if (!ctx) { b = row >> 12; t = row & 4095; kvrow = b * LKV + t; }
                else { const int j = row - MLAT; b = j >> 8; t = j & 255; kvrow = b * LKV + SEQ + t; }
                const int prow = t >> 6, pcol = t & 63; (void)b; (void)kvrow; (void)prow; (void)pcol;
#pragma unroll
                    for (int bj = 0; bj < 2; ++bj) {
                        const f32x4 a = acc[ai][bj][m][0], g = acc[ai][bj][m][1];
                        const int ch = ((pn - 12) * 8 + 4 * bj + wc) * 16 + 4 * fq;
                        float o[4];
#pragma unroll
                        for (int j = 0; j < 4; ++j) o[j] = a[j] * sigmoidf_(g[j]);
                        *(u32x2*)((bf16_t*)(ws + A_V) + (size_t)row * 384 + ch) = (u32x2){pk2(o[0], o[1]), pk2(o[2], o[3])};
                    }
                }
        }
    }
};

template <int ACT> struct EpiBf16 {
    static constexpr bool PERM = true, HOOK = false;
    bf16_t* O; int ldc;
    DI void hook(Acc&, const Unit&, int, int, int, int, int) const {}
    DI void operator()(const Acc& acc, const Unit& u, int wr, int wc, int fr, int fq) const {
#pragma unroll
        for (int ai = 0; ai < 2; ++ai)
#pragma unroll
            for (int m = 0; m < 4; ++m) {
                bf16_t* rowp = O + (size_t)(u.pm * 256 + ai * 128 + wr * 64 + m * 16 + fr) * ldc + u.pn * 256 + wc * 32 + 8 * fq;
#pragma unroll
                for (int bj = 0; bj < 2; ++bj) {
                    f32x4 v0 = acc[ai][bj][m][0], v1 = acc[ai][bj][m][1];
                    if (ACT == 1) {
#pragma unroll
                        for (int j = 0; j < 4; ++j) { v0[j] = sigmoidf_(v0[j]); v1[j] = sigmoidf_(v1[j]); }
                    } else if (ACT == 2) {
#pragma unroll
                        for (int j = 0; j < 4; ++j) { float a = fmaxf(v0[j], 0.f), b = fmaxf(v1[j], 0.f); v0[j] = a * a; v1[j] = b * b; }
                    }
                    *(u32x4*)(rowp + bj * 128) = (u32x4){pk2(v0[0], v0[1]), pk2(v0[2], v0[3]), pk2(v1[0], v1[1]), pk2(v1[2], v1[3])};
                }
            }
    }
};

struct EpiBranch {
    static constexpr bool PERM = true, HOOK = true;
    const bf16_t* G; bf16_t* O;
    DI void hook(Acc& acc, const Unit& u, int t, int wr, int wc, int fr_, int fq) const {
        int fr = fr_; asm volatile("" : "+v"(fr));
        const int s = (t == 6) ? 0 : (t == 14 ? 1 : 2);
#pragma unroll
        for (int ai = 0; ai < 2; ++ai) {
            u32x4 ga[4][2], gb[4][2];
#pragma unroll
            for (int m = 0; m < 4; ++m) {
                const bf16_t* gp = G + (size_t)(u.pm * 256 + ai * 128 + wr * 64 + m * 16 + fr) * 4096 + s * 1024 + u.pn * 256 + wc * 32 + 8 * fq;
#pragma unroll
                for (int bj = 0; bj < 2; ++bj) { ga[m][bj] = *(const u32x4*)(gp + bj * 128); gb[m][bj] = *(const u32x4*)(gp + 1024 + bj * 128); }
            }
#pragma unroll
            for (int m = 0; m < 4; ++m)
#pragma unroll
                for (int bj = 0; bj < 2; ++bj)
#pragma unroll
                    for (int q = 0; q < 4; ++q) {
                        const float r0 = bflo(ga[m][bj][q]) * __builtin_amdgcn_rcpf(bflo(gb[m][bj][q])), r1 = bfhi(ga[m][bj][q]) * __builtin_amdgcn_rcpf(bfhi(gb[m][bj][q]));
                        acc[ai][bj][m][q >> 1][(q & 1) * 2] *= r0; acc[ai][bj][m][q >> 1][(q & 1) * 2 + 1] *= r1;
                    }
            asm volatile("" ::: "memory");
        }
    }
    DI void operator()(const Acc& acc, const Unit& u, int wr, int wc, int fr, int fq) const {
#pragma unroll
        for (int ai = 0; ai < 2; ++ai) {
            u32x4 g[4][2];
#pragma unroll
            for (int m = 0; m < 4; ++m)
#pragma unroll
                for (int bj = 0; bj < 2; ++bj) g[m][bj] = *(const u32x4*)(G + (size_t)(u.pm * 256 + ai * 128 + wr * 64 + m * 16 + fr) * 4096 + 3072 + u.pn * 256 + wc * 32 + 8 * fq + bj * 128);
#pragma unroll
            for (int m = 0; m < 4; ++m) {
                const size_t row = (size_t)(u.pm * 256 + ai * 128 + wr * 64 + m * 16 + fr);
                const int c = u.pn * 256 + wc * 32 + 8 * fq;
#pragma unroll
                for (int bj = 0; bj < 2; ++bj) {
                    const u32x4 gg = g[m][bj];
                    const f32x4 v0 = acc[ai][bj][m][0], v1 = acc[ai][bj][m][1];
                    *(u32x4*)(O + row * 1024 + c + bj * 128) = (u32x4){pk2(v0[0] * bflo(gg[0]), v0[1] * bfhi(gg[0])), pk2(v0[2] * bflo(gg[1]), v0[3] * bfhi(gg[1])),
                                                                      pk2(v1[0] * bflo(gg[2]), v1[1] * bfhi(gg[2])), pk2(v1[2] * bflo(gg[3]), v1[3] * bfhi(gg[3]))};
                }
            }
            asm volatile("" ::: "memory");
        }
    }
};

struct EpiFourier {
    static constexpr bool PERM = true, HOOK = false;
    bf16_t* BRQ; int row0, seqlen; float scale;
    DI void hook(Acc&, const Unit&, int, int, int, int, int) const {}
    DI void operator()(const Acc& acc, const Unit& u, int wr, int wc, int fr, int fq) const {
#pragma unroll
        for (int ai = 0; ai < 2; ++ai)
#pragma unroll
            for (int m = 0; m < 4; ++m) {
                const int pos = u.pm * 256 + ai * 128 + wr * 64 + m * 16 + fr;
#pragma unroll
                for (int bj = 0; bj < 2; ++bj) {
                    const int c = u.pn * 256 + bj * 128 + wc * 32 + 8 * fq; const int b = c / 384, ch = c - b * 384;
                    const f32x4 v0 = acc[ai][bj][m][0] * scale, v1 = acc[ai][bj][m][1] * scale;
                    *(u32x4*)(BRQ + (size_t)(row0 + b * seqlen + pos) * KBR + ch) = (u32x4){pk2(v0[0], v0[1]), pk2(v0[2], v0[3]), pk2(v1[0], v1[1]), pk2(v1[2], v1[3])};
                }
            }
    }
};

struct MapId { int off; DI int operator()(int n) const { return n + off; } };
struct MapWin {
    DI static int rp(int lc) { return 16 * ((lc >> 2) & 1) + 4 * (lc >> 3) + (lc & 3); }
    DI int operator()(int n) const {
        if (n < 512) return (n & ~31) + rp(n & 31);
        if (n < 1024) return n;
        if (n < 1280) { const int i = n - 1024, bj = i >> 7, wc = (i >> 5) & 3, lc = i & 31; return wc < 2 ? 1024 + wc * 64 + 32 * bj + rp(lc) : 1152 + (wc - 2) * 64 + 32 * bj + lc; }
        if (n < 1792) { const int i = n - 1280; return 1664 + (i & ~31) + rp(i & 31); }
        if (n < 2304) { const int i = n - 1792, tile = i >> 8, ii = i & 255, bj = ii >> 7, wc = (ii >> 5) & 3, lc = ii & 31; return 2176 + (tile * 4 + wc) * 64 + 32 * bj + rp(lc); }
        if (n < 3072) return -1;
        if (n < 3840) { const int i = n - 3072, grp = i >> 5, lc = i & 31, ch = grp * 16 + 4 * (lc >> 3) + (lc & 3); return ((lc >> 2) & 1) ? 3072 + ch : 2688 + ch; }
        return 3456 + (n - 3840);
    }
};
template <class Map>
DI void convT(LAS unsigned char* lds, const float* src, int sld, int K, bf16_t* dst, int dld, int N, const Map& map, int item0, int nblk) {
    LAS float* tile = (LAS float*)lds;
    const int tid = tid_(); const int tK = K / 128, tN = N / 64;
    for (int it = item0; it < tK * tN; it += nblk) {
        const int tn = it / tK, tk = it % tK;
        const int col = map(tn * 64 + (tid & 63));
        if (map(tn * 64) < 0) continue;
        float v[16];
#pragma unroll
        for (int p = 0; p < 16; ++p) v[p] = src[(size_t)(tk * 128 + p * 8 + (tid >> 6)) * sld + col];
#pragma unroll
        for (int p = 0; p < 16; ++p) tile[(p * 8 + (tid >> 6)) * 65 + (tid & 63)] = v[p];
        __syncthreads();
#pragma unroll
        for (int hh = 0; hh < 2; ++hh) { const int n = tid >> 3, kc = (tid & 7) + 8 * hh; float w[8];
#pragma unroll
          for (int e = 0; e < 8; ++e) w[e] = tile[(kc * 8 + e) * 65 + n];
          *(u32x4*)(dst + (size_t)(tn * 64 + n) * dld + tk * 128 + kc * 8) = (u32x4){pk2(w[0], w[1]), pk2(w[2], w[3]), pk2(w[4], w[5]), pk2(w[6], w[7])}; }
        __syncthreads();
    }
}
DI void conv_fold(LAS unsigned char* lds, const float* win, bf16_t* wint, int item0, int nblk) {
    LAS float* tile = (LAS float*)lds;
    LAS float* tab = (LAS float*)(lds + 64 * 65 * 4);
    LAS bf16_t* outb = (LAS bf16_t*)(lds + 64 * 65 * 4 + 256);
    const int tid = tid_();
    __syncthreads();
    if (tid < 64) tab[tid] = cospif((float)tid / 32.0f);
    for (int it = item0; it < 6 * 16; it += nblk) {
        const int g = it >> 4, tk = it & 15;
        __syncthreads();
#pragma unroll
        for (int p = 0; p < 8; ++p) { const int kk = p * 8 + (tid >> 6); tile[kk * 65 + (tid & 63)] = win[(size_t)(tk * 64 + kk) * IN_COLS + 1280 + g * 64 + (tid & 63)]; }
        __syncthreads();
        const int k = tid & 63, cq = tid >> 6;
        float ac[8], as[8];
#pragma unroll
        for (int e = 0; e < 8; ++e) { ac[e] = 0.f; as[e] = 0.f; }
        for (int c = 0; c < 64; ++c) {
            const float w = tile[k * 65 + c];
#pragma unroll
            for (int e = 0; e < 8; ++e) { const int idx = c * (cq * 8 + e); ac[e] += w * tab[idx & 63]; as[e] += w * tab[(idx - 16) & 63]; }
        }
#pragma unroll
        for (int e = 0; e < 8; ++e) { outb[(cq * 8 + e) * 72 + k] = (bf16_t)(pk2(ac[e], 0.f) & 0xffffu); outb[(64 + cq * 8 + e) * 72 + k] = (bf16_t)(pk2(as[e], 0.f) & 0xffffu); }
        __syncthreads();
        for (int i = tid; i < 128 * 8; i += NTHREADS) { const int rr = i >> 3, ch = i & 7; const int part = rr >> 6, cp = rr & 63;
            *(u32x4*)(wint + (size_t)(2304 + part * 384 + g * 64 + cp) * D + tk * 64 + ch * 8) = *(const LAS u32x4*)(outb + rr * 72 + ch * 8); }
    }
    __syncthreads();
}
DI void conv_win(LAS unsigned char* lds, const Ptrs& P, int l, int item0, int nblk) {
    const float* win = P.in[I_WIN] + (size_t)l * D * IN_COLS;
    convT(lds, win, IN_COLS, D, (bf16_t*)(P.ws + OFF_WINT), D, NIN, MapWin{}, item0, nblk);
    conv_fold(lds, win, (bf16_t*)(P.ws + OFF_WINT), item0, nblk);
}
DI void gen_dft(LAS unsigned char* lds, unsigned char* ws, int item0, int nblk, bool also_small) {
    const int tid = tid_();
    bf16_t* dft = (bf16_t*)(ws + A_DFT);
    for (int it = item0 * NTHREADS + tid; it < 4096 * 512; it += nblk * NTHREADS) {
        const int k = it >> 9, j0 = (it & 511) * 8;
        float v[8];
#pragma unroll
        for (int e = 0; e < 8; ++e) { const int j = j0 + e; const bool sp = j >= 2049; const float fr = (float)((k * (sp ? j - 2048 : j)) & 4095) * (1.0f / 4096.0f); v[e] = sp ? -__builtin_amdgcn_sinf(fr) : __builtin_amdgcn_cosf(fr); }
        *(u32x4*)(dft + (size_t)k * 4096 + j0) = (u32x4){pk2(v[0], v[1]), pk2(v[2], v[3]), pk2(v[4], v[5]), pk2(v[6], v[7])};
    }
    if (also_small) {
        bf16_t* dc = (bf16_t*)(ws + OFF_DFTC);
        for (int it = item0 * NTHREADS + tid; it < 256 * 64; it += nblk * NTHREADS) {
            const int k = it >> 6, j0 = (it & 63) * 8; const int part = j0 >= 256; const int t0 = j0 & 255;
            float v[8];
#pragma unroll
            for (int e = 0; e < 8; ++e) { const float fr = (float)((k * (t0 + e)) & 255) * (1.0f / 256.0f); v[e] = part ? -__builtin_amdgcn_sinf(fr) : __builtin_amdgcn_cosf(fr); }
            *(u32x4*)(dc + (size_t)k * 512 + j0) = (u32x4){pk2(v[0], v[1]), pk2(v[2], v[3]), pk2(v[4], v[5]), pk2(v[6], v[7])};
        }
    }
}
DI void fourier_fold(unsigned char* ws, int item0, int nblk) {
    const int tid = tid_();
    const bf16_t* FT = (const bf16_t*)(ws + A_FT); bf16_t* FTF = (bf16_t*)(ws + A_FTF);
    for (int it = item0 * NTHREADS + tid; it < 1536 * 1024; it += nblk * NTHREADS) {
        const int n = it >> 10, j0 = (it & 1023) * 4;
        const bf16_t* s = FT + (size_t)n * 8192;
        float o[4];
#pragma unroll
        for (int e = 0; e < 4; ++e) { const int j = j0 + e;
            if (j <= 2048) { const float a = bflo((unsigned)s[j]); o[e] = (j == 0 || j == 2048) ? a : a + bflo((unsigned)s[4096 - j]); }
            else { const int t = j - 2048; o[e] = bflo((unsigned)s[4096 + t]) - bflo((unsigned)s[8192 - t]); } }
        *(u32x2*)(FTF + (size_t)n * 4096 + j0) = (u32x2){pk2(o[0], o[1]), pk2(o[2], o[3])};
    }
}

DI void mod_gemv(LAS unsigned char* lds, const Ptrs& P, int item0, int nblk) {
    LAS float* sc = (LAS float*)lds;
    LAS float* red = (LAS float*)(lds + 20480);
    const int tid = tid_();
    __syncthreads();
    for (int i = tid; i < 5 * 1024; i += NTHREADS) { const float v = i < 4096 ? P.in[I_C][i] : P.in[I_CCTX][i - 4096]; sc[i] = v * sigmoidf_(v); }
    __syncthreads();
    float* MOD = (float*)(P.ws + OFF_MOD);
    for (int it = item0; it < 2 * 192; it += nblk) {
        const int l = it / 192, cg32 = it % 192; const int kg = tid >> 5, cl = tid & 31;
        const float* w = P.in[I_WMOD] + (size_t)l * D * 6144 + cg32 * 32 + cl;
        float a[5] = {0.f, 0.f, 0.f, 0.f, 0.f};
        for (int k = kg * 64; k < kg * 64 + 64; ++k) { const float wv = w[(size_t)k * 6144];
#pragma unroll
            for (int r = 0; r < 5; ++r) a[r] += sc[r * 1024 + k] * wv; }
#pragma unroll
        for (int r = 0; r < 5; ++r) red[(kg * 5 + r) * 32 + cl] = a[r];
        __syncthreads();
        if (tid < 160) { const int r = tid >> 5; float s = 0.f;
#pragma unroll
            for (int g = 0; g < 16; ++g) s += red[(g * 5 + r) * 32 + cl];
            MOD[((size_t)l * 5 + r) * 6144 + cg32 * 32 + cl] = s + P.in[I_BMOD][l * 6144 + cg32 * 32 + cl]; }
        __syncthreads();
    }
}

DI void row_mod_store(const f32x4 (&x)[4], float rstd, const float* gain, const float* shift, const float* scale, bf16_t* hrow, int lane) {
#pragma unroll
    for (int i = 0; i < 4; ++i) { const int c = lane * 4 + 256 * i;
        const f32x4 g = *(const f32x4*)(gain + c), sh = *(const f32x4*)(shift + c), sc = *(const f32x4*)(scale + c);
        float o[4];
#pragma unroll
        for (int j = 0; j < 4; ++j) o[j] = x[i][j] * rstd * g[j] * (1.f + sc[j]) + sh[j];
        *(u32x2*)(hrow + c) = (u32x2){pk2(o[0], o[1]), pk2(o[2], o[3])}; }
}
DI float row_rstd(const f32x4 (&x)[4]) {
    float s = 0.f;
#pragma unroll
    for (int i = 0; i < 4; ++i) s += x[i][0] * x[i][0] + x[i][1] * x[i][1] + x[i][2] * x[i][2] + x[i][3] * x[i][3];
    s = wave_sum(s);
    return __builtin_amdgcn_rsqf(s * (1.0f / 1024.0f) + EPS);
}
DI void rows_first(const Ptrs& P) {
    const int tid = tid_(); const int lane = tid & 63, wv = tid >> 6;
    const float* MOD = (const float*)(P.ws + OFF_MOD);
    for (int row = blockIdx.x * 8 + wv; row < MTOT; row += gridDim.x * 8) {
        const float* xr = row < MLAT ? P.in[I_X] + (size_t)row * D : P.in[I_CTX] + (size_t)(row - MLAT) * D;
        const int mr = row < MLAT ? (row >> 12) : 4;
        f32x4 x[4];
#pragma unroll
        for (int i = 0; i < 4; ++i) x[i] = *(const f32x4*)(xr + lane * 4 + 256 * i);
        const float rstd = row_rstd(x);
        const float* mod = MOD + (size_t)mr * 6144;
        row_mod_store(x, rstd, P.in[I_GPREMIX], mod, mod + 1024, (bf16_t*)(P.ws + OFF_HS) + (size_t)row * D, lane);
    }
}
DI void rows_update(const Ptrs& P, int l, int which  , int nrows) {
    const int tid = tid_(); const int lane = tid & 63, wv = tid >> 6;
    const float* MOD = (const float*)(P.ws + OFF_MOD);
    const bf16_t* Y = (const bf16_t*)(P.ws + A_MIXO);
    const float* gpost = P.in[which ? I_GPOSTMLP : I_GPOSTMIX] + l * D;
    const bool do_h = (which == 0) || (l == 0);
    const int ln = which ? l + 1 : l;
    const float* gnext = which ? P.in[I_GPREMIX] + (do_h ? ln : 0) * D : P.in[I_GPREMLP] + l * D;
    for (int row = blockIdx.x * 8 + wv; row < nrows; row += gridDim.x * 8) {
        const bool lat = row < MLAT;
        const float* xin = lat ? ((l == 0 && which == 0) ? P.in[I_X] + (size_t)row * D : P.out + (size_t)row * D)
                               : ((which == 0) ? P.in[I_CTX] + (size_t)(row - MLAT) * D : (const float*)(P.ws + A_XC) + (size_t)(row - MLAT) * D);
        float* xout = lat ? P.out + (size_t)row * D : (float*)(P.ws + A_XC) + (size_t)(row - MLAT) * D;
        const int mr = lat ? (row >> 12) : 4;
        const float* mod = MOD + ((size_t)l * 5 + mr) * 6144;
        const float* gate = mod + (which ? 5 : 2) * 1024;
        f32x4 x[4], y[4];
#pragma unroll
        for (int i = 0; i < 4; ++i) { x[i] = *(const f32x4*)(xin + lane * 4 + 256 * i);
            const u32x2 yb = *(const u32x2*)(Y + (size_t)row * D + lane * 4 + 256 * i); y[i] = (f32x4){bflo(yb[0]), bfhi(yb[0]), bflo(yb[1]), bfhi(yb[1])}; }
        const float ry = row_rstd(y);
#pragma unroll
        for (int i = 0; i < 4; ++i) { const int c = lane * 4 + 256 * i; const f32x4 gp = *(const f32x4*)(gpost + c), gt = *(const f32x4*)(gate + c);
#pragma unroll
            for (int j = 0; j < 4; ++j) x[i][j] += gt[j] * (y[i][j] * ry * gp[j]);
            *(f32x4*)(xout + c) = x[i]; }
        if (do_h) {
            const float rx = row_rstd(x);
            const float* modn = MOD + ((size_t)ln * 5 + mr) * 6144;
            const float* shiftn = which ? modn : modn + 3 * 1024; const float* scalen = which ? modn + 1024 : modn + 4 * 1024;
            row_mod_store(x, rx, gnext, shiftn, scalen, (bf16_t*)(P.ws + OFF_HS) + (size_t)row * D, lane);
        }
    }
}

constexpr int AK_PITCH = 144;
constexpr int AK_BUF = 64 * AK_PITCH;
constexpr int AV_OFF = 2 * AK_BUF;
#define ATT_BAR() do { __builtin_amdgcn_sched_barrier(0); asm volatile("s_waitcnt lgkmcnt(0)" ::: "memory"); __builtin_amdgcn_s_barrier(); asm volatile("" ::: "memory"); __builtin_amdgcn_sched_barrier(0); } while (0)
DI float max3_(float a, float b, float c) { float d; asm("v_max3_f32 %0, %1, %2, %3" : "=v"(d) : "v"(a), "v"(b), "v"(c)); return d; }
template <int NMB, bool NOMAX = false>
DI void flash_pass(LAS unsigned char* lds, const bf16x8 (&qf)[4], const bf16_t* Kg, int ldk, const bf16_t* Vg, int ldv, int ntiles, f32x16 (&O)[NMB], float& lsum) {
    constexpr int VP = NMB == 4 ? 320 : 192;
    constexpr int VBUF = 64 * VP;
    constexpr int VCH = NMB * 4;
    constexpr int VPT = NMB / 2;
    const int tid = tid_(), lane = tid & 63, g = __builtin_amdgcn_readfirstlane(tid >> 8);
    const int r = lane & 31, h = lane >> 5, i16 = lane & 15, q4 = i16 >> 2, p4 = i16 & 3, blk = (lane >> 4) & 1;
    const int kkey = tid >> 3, kch = tid & 7;
    const unsigned kwoff = kkey * AK_PITCH + kch * 16;
    const unsigned vrd = (4 * h + q4) * VP + 32 * blk + 8 * p4;
    const unsigned krd = r * AK_PITCH + 16 * h;
    const bf16_t* kgp = Kg + (size_t)kkey * ldk + kch * 8;
    unsigned vwoff[VPT]; const bf16_t* vgp[VPT];
#pragma unroll
    for (int p = 0; p < VPT; ++p) { const int idx = tid + p * NTHREADS; vwoff[p] = (idx / VCH) * VP + (idx % VCH) * 16; vgp[p] = Vg + (size_t)(idx / VCH) * ldv + (idx % VCH) * 8; }
    float m_run = -1e30f; lsum = 0.f;
#pragma unroll
    for (int mb = 0; mb < NMB; ++mb)
#pragma unroll
        for (int i = 0; i < 16; ++i) O[mb][i] = 0.f;
    u32x4 kreg, vreg[VPT];
    {
        const u32x4 k0 = *(const u32x4*)kgp, k1 = *(const u32x4*)(kgp + (size_t)64 * ldk);
#pragma unroll
        for (int p = 0; p < VPT; ++p) vreg[p] = *(const u32x4*)vgp[p];
        __syncthreads();
        *(LAS u32x4*)(lds + kwoff) = k0; *(LAS u32x4*)(lds + AK_BUF + kwoff) = k1;
#pragma unroll
        for (int p = 0; p < VPT; ++p) *(LAS u32x4*)(lds + AV_OFF + vwoff[p]) = vreg[p];
    }
    __syncthreads();
    kreg = *(const u32x4*)(kgp + (size_t)(ntiles > 2 ? 128 : 0) * ldk);
#pragma unroll
    for (int p = 0; p < VPT; ++p) vreg[p] = *(const u32x4*)(vgp[p] + (size_t)64 * ldv);
    f32x16 S0, S1;
#pragma unroll
    for (int i = 0; i < 16; ++i) { S0[i] = 0.f; S1[i] = 0.f; }
#pragma unroll
    for (int c = 0; c < 4; ++c) {
        const bf16x8 a0 = *(const LAS bf16x8*)(lds + krd + 32 * c);
        const bf16x8 a1 = *(const LAS bf16x8*)(lds + krd + 32 * AK_PITCH + 32 * c);
        S0 = __builtin_amdgcn_mfma_f32_32x32x16_bf16(a0, qf[c], S0, 0, 0, 0);
        S1 = __builtin_amdgcn_mfma_f32_32x32x16_bf16(a1, qf[c], S1, 0, 0, 0);
    }
    if (g == 1) ATT_BAR();
    for (int t = 0; t < ntiles; ++t) {
        const int sv = t + g;
        if (sv >= 1) {
            if (sv < ntiles) {
#pragma unroll
                for (int p = 0; p < VPT; ++p) *(LAS u32x4*)(lds + AV_OFF + (sv & 1) * VBUF + vwoff[p]) = vreg[p]; }
            if (sv + 1 < ntiles) *(LAS u32x4*)(lds + ((sv + 1) & 1) * AK_BUF + kwoff) = kreg;
        }
        if (sv + 1 < ntiles) {
#pragma unroll
            for (int p = 0; p < VPT; ++p) vreg[p] = *(const u32x4*)(vgp[p] + (size_t)(sv + 1) * 64 * ldv); }
        if (sv + 2 < ntiles) kreg = *(const u32x4*)(kgp + (size_t)(sv + 2) * 64 * ldk);
        if constexpr (!NOMAX) {
        float mx = max3_(S0[0], S1[0], S0[1]), mx2 = max3_(S1[1], S0[2], S1[2]);
#pragma unroll
        for (int i = 3; i < 15; i += 2) { mx = max3_(mx, S0[i], S1[i]); mx2 = max3_(mx2, S0[i + 1], S1[i + 1]); }
        mx = max3_(mx, S0[15], S1[15]);
        mx = max3_(mx, mx2, mx2);
        { const u32x2 sw = __builtin_amdgcn_permlane32_swap(__float_as_uint(mx), __float_as_uint(mx), false, false);
          mx = max3_(__uint_as_float(sw[0]), __uint_as_float(sw[1]), m_run); }
        const float m_new = mx;
        if (__builtin_amdgcn_ballot_w64(m_new > m_run) != 0ull) {
            const float alpha = __builtin_amdgcn_exp2f(m_run - m_new);
            lsum *= alpha;
#pragma unroll
            for (int mb = 0; mb < NMB; ++mb)
#pragma unroll
                for (int i = 0; i < 16; ++i) O[mb][i] *= alpha;
            m_run = m_new;
        }
        }
        float ps = 0.f;
#pragma unroll
        for (int i = 0; i < 16; ++i) { if constexpr (NOMAX) { S0[i] = __builtin_amdgcn_exp2f(S0[i]); S1[i] = __builtin_amdgcn_exp2f(S1[i]); } else { S0[i] = __builtin_amdgcn_exp2f(S0[i] - m_run); S1[i] = __builtin_amdgcn_exp2f(S1[i] - m_run); } ps += S0[i] + S1[i]; }
        lsum += ps;
        bf16x8 pf[4];
#pragma unroll
        for (int cp = 0; cp < 2; ++cp) {
            u32x4 w0, w1;
#pragma unroll
            for (int q = 0; q < 4; ++q) { w0[q] = pk2(S0[8 * cp + 2 * q], S0[8 * cp + 2 * q + 1]); w1[q] = pk2(S1[8 * cp + 2 * q], S1[8 * cp + 2 * q + 1]); }
            pf[cp] = __builtin_bit_cast(bf16x8, w0); pf[2 + cp] = __builtin_bit_cast(bf16x8, w1);
        }
        ATT_BAR();
        {
            const LAS unsigned char* Vb = lds + AV_OFF + (t & 1) * VBUF + vrd;
            const LAS unsigned char* Kb = lds + ((t + 1) & 1) * AK_BUF + krd;
            const bool qk = t + 1 < ntiles;
            bf16x8 kf[8], va[NMB], vb[NMB];
#define ATT_LDV(dst, kc) do { _Pragma("unroll") for (int mb = 0; mb < NMB; ++mb) { \
                const s16x4 lo_ = __builtin_amdgcn_ds_read_tr16_b64_v4i16((LAS s16x4*)(Vb + (16 * (kc)) * VP + 64 * mb)); \
                const s16x4 hi_ = __builtin_amdgcn_ds_read_tr16_b64_v4i16((LAS s16x4*)(Vb + (16 * (kc) + 8) * VP + 64 * mb)); \
                dst[mb] = __builtin_shufflevector(lo_, hi_, 0, 1, 2, 3, 4, 5, 6, 7); } } while (0)
#define ATT_PV(srcv, kc) do { _Pragma("unroll") for (int mb = 0; mb < NMB; ++mb) O[mb] = __builtin_amdgcn_mfma_f32_32x32x16_bf16(srcv[mb], pf[kc], O[mb], 0, 0, 0); } while (0)
            if (qk) {
#pragma unroll
                for (int c = 0; c < 4; ++c) { kf[2 * c] = *(const LAS bf16x8*)(Kb + 32 * c); kf[2 * c + 1] = *(const LAS bf16x8*)(Kb + 32 * AK_PITCH + 32 * c); }
            }
            ATT_LDV(va, 0);
            __builtin_amdgcn_sched_barrier(0);
            if (qk) {
#pragma unroll
                for (int i = 0; i < 16; ++i) { S0[i] = 0.f; S1[i] = 0.f; }
#pragma unroll
                for (int c = 0; c < 4; ++c) {
                    S0 = __builtin_amdgcn_mfma_f32_32x32x16_bf16(kf[2 * c], qf[c], S0, 0, 0, 0);
                    S1 = __builtin_amdgcn_mfma_f32_32x32x16_bf16(kf[2 * c + 1], qf[c], S1, 0, 0, 0);
                }
            }
            ATT_LDV(vb, 1);
            __builtin_amdgcn_sched_barrier(0);
            ATT_PV(va, 0);
            ATT_LDV(va, 2);
            __builtin_amdgcn_sched_barrier(0);
            ATT_PV(vb, 1);
            ATT_LDV(vb, 3);
            __builtin_amdgcn_sched_barrier(0);
            ATT_PV(va, 2);
            ATT_PV(vb, 3);
#undef ATT_LDV
#undef ATT_PV
        }
        ATT_BAR();
    }
    if (g == 0) ATT_BAR();
    lsum += __shfl_xor(lsum, 32);
}

DI void diff_unit(LAS unsigned char* lds, const Ptrs& P, int l, int b, int hd, int qrow0, int key0, int ntiles, float lam, float lam_init) {
    const int tid = tid_(); const int lane = tid & 63, wv = tid >> 6, r = lane & 31, h = lane >> 5;
    bf16_t* BRQ = (bf16_t*)(P.ws + A_BRQ);
    const bf16_t* DK = (const bf16_t*)(P.ws + A_DK) + (size_t)(b * LKV + key0) * 512 + hd * 128;
    const bf16_t* DV = (const bf16_t*)(P.ws + A_DV) + (size_t)(b * LKV + key0) * 512 + hd * 128;
    bf16_t* qp = BRQ + (size_t)(qrow0 + wv * 32 + r) * KBR + 384 + hd * 128;
    bf16x8 q0[4], q1[4];
#pragma unroll
    for (int c = 0; c < 4; ++c) { q0[c] = *(const bf16x8*)(qp + 16 * c + 8 * h); q1[c] = *(const bf16x8*)(qp + 64 + 16 * c + 8 * h); }
    f32x16 O[4]; float l0;
    const unsigned* nrm = (const unsigned*)(P.ws + OFF_CTL) + 32 + 2 * l;
    const float bnd = 2.04f * sqrtf(__uint_as_float(__hip_atomic_load(nrm, __ATOMIC_RELAXED, __HIP_MEMORY_SCOPE_AGENT)) * __uint_as_float(__hip_atomic_load(nrm + 1, __ATOMIC_RELAXED, __HIP_MEMORY_SCOPE_AGENT)));
    const bool small = __builtin_amdgcn_readfirstlane((int)(bnd < 60.0f)) != 0;
    if (small) flash_pass<4, true>(lds, q0, DK, 512, DV, 512, ntiles, O, l0); else
    flash_pass<4>(lds, q0, DK, 512, DV, 512, ntiles, O, l0);
    { const float inv = 1.0f / l0;
#pragma unroll
      for (int mb = 0; mb < 4; ++mb)
#pragma unroll
          for (int g = 0; g < 4; ++g) { const int dv = 32 * mb + 8 * g + 4 * h;
              *(u32x2*)(qp + dv) = (u32x2){pk2(O[mb][4 * g] * inv, O[mb][4 * g + 1] * inv), pk2(O[mb][4 * g + 2] * inv, O[mb][4 * g + 3] * inv)}; } }
    if (small) flash_pass<4, true>(lds, q1, DK + 64, 512, DV, 512, ntiles, O, l0); else
    flash_pass<4>(lds, q1, DK + 64, 512, DV, 512, ntiles, O, l0);
    { const float s1 = lam / l0; float ss = 0.f;
#pragma unroll
      for (int mb = 0; mb < 4; ++mb)
#pragma unroll
          for (int g = 0; g < 4; ++g) { const int dv = 32 * mb + 8 * g + 4 * h; const u32x2 o0 = *(const u32x2*)(qp + dv);
              const float a0 = bflo(o0[0]) - s1 * O[mb][4 * g], a1 = bfhi(o0[0]) - s1 * O[mb][4 * g + 1], a2 = bflo(o0[1]) - s1 * O[mb][4 * g + 2], a3 = bfhi(o0[1]) - s1 * O[mb][4 * g + 3];
              O[mb][4 * g] = a0; O[mb][4 * g + 1] = a1; O[mb][4 * g + 2] = a2; O[mb][4 * g + 3] = a3; ss += a0 * a0 + a1 * a1 + a2 * a2 + a3 * a3; }
      ss += __shfl_xor(ss, 32);
      const float rs = __builtin_amdgcn_rsqf(ss * (1.0f / 128.0f) + EPS) * (1.0f - lam_init);
      const float* sg = P.in[I_SUBLN] + l * 128;
#pragma unroll
      for (int mb = 0; mb < 4; ++mb)
#pragma unroll
          for (int g = 0; g < 4; ++g) { const int dv = 32 * mb + 8 * g + 4 * h; const f32x4 gg = *(const f32x4*)(sg + dv);
              *(u32x2*)(qp + dv) = (u32x2){pk2(O[mb][4 * g] * rs * gg[0], O[mb][4 * g + 1] * rs * gg[1]), pk2(O[mb][4 * g + 2] * rs * gg[2], O[mb][4 * g + 3] * rs * gg[3])}; }
    }
}
DI void gqa_unit(LAS unsigned char* lds, const Ptrs& P, int l, int b, int qh, int qrow0, int key0, int ntiles) {
    const int tid = tid_(); const int lane = tid & 63, wv = tid >> 6, r = lane & 31, h = lane >> 5;
    bf16_t* BRQ = (bf16_t*)(P.ws + A_BRQ);
    const int kvh = qh >> 2;
    const bf16_t* GK = (const bf16_t*)(P.ws + A_GK) + (size_t)(b * LKV + key0) * 128 + kvh * 64;
    const bf16_t* GV = (const bf16_t*)(P.ws + A_GV) + (size_t)(b * LKV + key0) * 128 + kvh * 64;
    bf16_t* qp = BRQ + (size_t)(qrow0 + wv * 32 + r) * KBR + 896 + qh * 64;
    bf16x8 q0[4];
#pragma unroll
    for (int c = 0; c < 4; ++c) q0[c] = *(const bf16x8*)(qp + 16 * c + 8 * h);
    f32x16 O[2]; float l0;
    float mq = fabsf(P.in[I_QNORM][l * 64 + lane]), mk = fabsf(P.in[I_KNORM][l * 64 + lane]);
#pragma unroll
    for (int o = 32; o >= 1; o >>= 1) { mq = fmaxf(mq, __shfl_xor(mq, o)); mk = fmaxf(mk, __shfl_xor(mk, o)); }
    const bool small = __builtin_amdgcn_readfirstlane((int)(64.0f * QSCALE * 1.02f * mq * mk < 60.0f)) != 0;
    if (small) flash_pass<2, true>(lds, q0, GK, 128, GV, 128, ntiles, O, l0);
    else flash_pass<2, false>(lds, q0, GK, 128, GV, 128, ntiles, O, l0);
    const float inv = 1.0f / l0;
#pragma unroll
    for (int mb = 0; mb < 2; ++mb)
#pragma unroll
        for (int g = 0; g < 4; ++g) { const int dv = 32 * mb + 8 * g + 4 * h;
            *(u32x2*)(qp + dv) = (u32x2){pk2(O[mb][4 * g] * inv, O[mb][4 * g + 1] * inv), pk2(O[mb][4 * g + 2] * inv, O[mb][4 * g + 3] * inv)}; }
}

DI void conv_unit(LAS unsigned char* lds, const Ptrs& P, int l, int m0, int s0, int Ls) {
    const int tid = tid_(), lane = tid & 63, wv = tid >> 6;
    LAS bf16_t* vs = (LAS bf16_t*)lds;
    LAS float* wsm = (LAS float*)(lds + 94 * 384 * 2);
    const bf16_t* V = (const bf16_t*)(P.ws + A_V);
    __syncthreads();
    for (int idx = tid; idx < 94 * 48; idx += NTHREADS) { const int rr = idx / 48, ch = idx % 48; const int row = m0 - 15 + rr;
        u32x4 v = (u32x4){0u, 0u, 0u, 0u};
        if (row >= s0 && row < s0 + Ls) v = *(const u32x4*)(V + (size_t)row * 384 + ch * 8);
        *(LAS u32x4*)(vs + rr * 384 + ch * 8) = v; }
    const float* dw = P.in[I_CONVDW] + (size_t)l * 31 * 384;
    for (int idx = tid; idx < 31 * 384; idx += NTHREADS) wsm[idx] = dw[idx];
    __syncthreads();
    const float* bias = P.in[I_CONVB] + l * 384; const float* lg = P.in[I_CONVLNG] + l * 384; const float* lb = P.in[I_CONVLNB] + l * 384;
    const int c0 = lane * 6;
    bf16_t* BRQ = (bf16_t*)(P.ws + A_BRQ);
    float a[8][6];
#pragma unroll
    for (int tt = 0; tt < 8; ++tt)
#pragma unroll
        for (int c = 0; c < 6; ++c) a[tt][c] = bias[c0 + c];
    const LAS bf16_t* vbase = vs + (wv * 8) * 384 + c0;
#pragma unroll 1
    for (int j = 0; j < 31; ++j) {
        const LAS float* wp = wsm + j * 384 + c0;
        const f32x2 w01 = *(const LAS f32x2*)wp, w23 = *(const LAS f32x2*)(wp + 2), w45 = *(const LAS f32x2*)(wp + 4);
#pragma unroll
        for (int tt = 0; tt < 8; ++tt) {
            const LAS unsigned* vp = (const LAS unsigned*)(vbase + (tt + j) * 384);
            const unsigned v0 = vp[0], v1 = vp[1], v2 = vp[2];
            a[tt][0] += w01.x * bflo(v0); a[tt][1] += w01.y * bfhi(v0); a[tt][2] += w23.x * bflo(v1); a[tt][3] += w23.y * bfhi(v1); a[tt][4] += w45.x * bflo(v2); a[tt][5] += w45.y * bfhi(v2);
        }
    }
    float lgv[6], lbv[6];
#pragma unroll
    for (int c = 0; c < 6; ++c) { lgv[c] = lg[c0 + c]; lbv[c] = lb[c0 + c]; }
#pragma unroll
    for (int tt = 0; tt < 8; ++tt) {
        float s = a[tt][0] + a[tt][1] + a[tt][2] + a[tt][3] + a[tt][4] + a[tt][5];
        s = wave_sum(s);
        const float mu = s * (1.0f / 384.0f);
        float q = 0.f;
#pragma unroll
        for (int c = 0; c < 6; ++c) { const float d = a[tt][c] - mu; q += d * d; }
        q = wave_sum(q);
        const float rs = __builtin_amdgcn_rsqf(q * (1.0f / 384.0f) + EPS);
        float o[6];
#pragma unroll
        for (int c = 0; c < 6; ++c) { const float y = (a[tt][c] - mu) * rs * lgv[c] + lbv[c]; o[c] = y * sigmoidf_(y); }
        unsigned* dst = (unsigned*)(BRQ + (size_t)(m0 + wv * 8 + tt) * KBR + 1408 + c0);
        dst[0] = pk2(o[0], o[1]); dst[1] = pk2(o[2], o[3]); dst[2] = pk2(o[4], o[5]);
    }
}


#define XB_TMO      128
#define XB_XCNT(j)  (256  + 64 * (j))
#define XB_XSUB(j)  (1280 + 64 * (j))
#define XB_XGEN(j)  (2304 + 64 * (j))
#define XB_TOP      3328
#define XB_TOPGEN   3392
#define XCD_BAR_WORDS 3456
#define XB_SPIN_CAP (1u << 20)
DI unsigned xb_ld(unsigned* p)              { return __hip_atomic_load(p, __ATOMIC_RELAXED, __HIP_MEMORY_SCOPE_AGENT); }
DI unsigned xb_add(unsigned* p, unsigned v) { return __hip_atomic_fetch_add(p, v, __ATOMIC_RELAXED, __HIP_MEMORY_SCOPE_AGENT); }
DI unsigned xb_xcc_id() { return (unsigned)__builtin_amdgcn_s_getreg((3 << 11) | 20) & 0xFu; }
#define XB_SPIN(cond, bar) do { unsigned _sp = 0; while (cond) { \
    if ((++_sp & 255u) == 0u) { if (xb_ld(&(bar)[XB_TMO])) break; if (_sp > XB_SPIN_CAP) { atomicAdd(&(bar)[XB_TMO], 1u); break; } } } } while (0)
struct XcdBarrier { unsigned* bar; unsigned x; volatile LAS unsigned* st; };
DI XcdBarrier xcd_barrier_post(unsigned* bar, volatile LAS unsigned* st) {
    XcdBarrier b; b.bar = bar; b.x = xb_xcc_id(); b.st = st;
    if (threadIdx.x == 0) (void)xb_add(&bar[XB_XCNT(b.x)], 1u);
    return b;
}
DI void xcd_barrier_complete(unsigned* bar, unsigned x, unsigned& nloc, unsigned& nx) {
    const unsigned G = gridDim.x * gridDim.y * gridDim.z;
    unsigned sum, cnt, mine, sp = 0u;
    for (;;) {
        sum = 0u; cnt = 0u; mine = 0u;
#pragma unroll
        for (unsigned j = 0; j < 16; ++j) { const unsigned c = xb_ld(&bar[XB_XCNT(j)]); sum += c; cnt += (c > 0u) ? 1u : 0u; mine = (j == x) ? c : mine; }
        if (sum == G) break;
        __builtin_amdgcn_s_sleep(1);
        if ((++sp & 255u) == 0u) { if (xb_ld(&bar[XB_TMO])) break; if (sp > XB_SPIN_CAP) { atomicAdd(&bar[XB_TMO], 1u); break; } }
    }
    nloc = mine > 0u ? mine : 1u; nx = cnt > 0u ? cnt : 1u;
}
DI void xcd_barrier(const XcdBarrier& b) {
    asm volatile("s_waitcnt vmcnt(0)" ::: "memory");
    __syncthreads();
    if (threadIdx.x == 0) {
        unsigned* bar = b.bar;
        __builtin_amdgcn_s_waitcnt(0);
        unsigned nloc = b.st[0], nx = b.st[1];
        if (nloc == 0u) { xcd_barrier_complete(bar, b.x, nloc, nx); b.st[0] = nloc; b.st[1] = nx; }
        const unsigned old = xb_add(&bar[XB_XSUB(b.x)], 1u);
        const unsigned gen = old / nloc;
        if (old + 1u == (gen + 1u) * nloc) {
            __builtin_amdgcn_fence(__ATOMIC_RELEASE, "agent");
            asm volatile("s_waitcnt vmcnt(0)" ::: "memory");
            const unsigned og = xb_add(&bar[XB_TOP], 1u);
            const unsigned tg = og / nx;
            if (og + 1u == (tg + 1u) * nx) xb_add(&bar[XB_TOPGEN], 1u);
            else XB_SPIN(xb_ld(&bar[XB_TOPGEN]) == tg, bar);
            __builtin_amdgcn_fence(__ATOMIC_ACQUIRE, "agent");
            xb_add(&bar[XB_XGEN(b.x)], 1u);
            asm volatile("s_waitcnt vmcnt(0)" ::: "memory");
        } else {
            XB_SPIN(xb_ld(&bar[XB_XGEN(b.x)]) == gen, bar);
            __builtin_amdgcn_fence(__ATOMIC_ACQUIRE, "agent");
            asm volatile("s_waitcnt vmcnt(0)" ::: "memory");
        }
    }
    __syncthreads();
}

struct KArgs { Ptrs p; int ph_lo, ph_hi; };

__global__ void __launch_bounds__(NTHREADS, 2) fwd_mega(KArgs args) {
    extern __shared__ __attribute__((aligned(16))) unsigned char lds_raw[];
    LAS unsigned char* lds = (LAS unsigned char*)lds_raw;
    cg::grid_group grid = cg::this_grid();
    const Ptrs& P = args.p;
    unsigned char* ws = P.ws;
    const int tid = threadIdx.x, bid = blockIdx.x, G = gridDim.x;
    unsigned* ctl = (unsigned*)(ws + OFF_CTL);
    float* misc = (float*)(ws + OFF_MISC);
    int ph = 0;
    if (args.ph_hi < 0) grid.sync();
    volatile LAS unsigned* xst = (volatile LAS unsigned*)(lds + 131072 + 16);
    if (tid == 0) { xst[0] = 0u; xst[1] = 0u; }
    __syncthreads();
    { const XcdBarrier xb0 = xcd_barrier_post((unsigned*)(ws + OFF_BAR), xst); if (tid == 0) xst[2] = xb0.x; }
    __syncthreads();
#define PHASE_BEGIN if (ph >= args.ph_lo && ph < args.ph_hi) {
#define PHASE_END(dosync_) if ((dosync_) && ph + 1 < args.ph_hi) { XcdBarrier xb_; xb_.bar = (unsigned*)(args.p.ws + OFF_BAR); xb_.st = (volatile LAS unsigned*)(lds + 131072 + 16); xb_.x = xb_.st[2]; xcd_barrier(xb_); } } ++ph;

    PHASE_BEGIN
        if (bid == 0) {
            if (tid < 64) ctl[tid] = 0u;
            if (tid < 2) { const float* lv = P.in[I_LAMBDA] + tid * 256; float s0 = 0.f, s1 = 0.f;
                for (int i = 0; i < 64; ++i) { s0 += lv[i] * lv[64 + i]; s1 += lv[128 + i] * lv[192 + i]; }
                const float li = 0.8f - 0.6f * expf(-0.3f * (float)tid);
                misc[tid * 2] = expf(s0) - expf(s1) + li; misc[tid * 2 + 1] = li; }
            for (int i = tid; i < 64 * 16; i += NTHREADS) { const int pos = i >> 4, f = i & 15; const float inv = powf(10000.0f, -(float)f / 16.0f); const float ang = (float)pos * inv;
                ((f32x2*)(ws + OFF_ROPE))[i] = (f32x2){cosf(ang), sinf(ang)}; }
        }
        mod_gemv(lds, P, bid, G);
        conv_win(lds, P, 0, bid, G);
        gen_dft(lds, ws, bid, G, true);
    PHASE_END(true)
    PHASE_BEGIN
        rows_first(P);
    PHASE_END(true)

    for (int l = 0; l < 2; ++l) {
        const int nMt = l == 0 ? 68 : 64;
        PHASE_BEGIN
            RectSched S{(const char*)(ws + OFF_HS), (const char*)(ws + OFF_WINT), (size_t)256 * D * 2, (size_t)256 * D * 2, 16, G, bid, nMt, 15, 64, l == 0 ? 0 : 4, 5};
            EpiInA E{ws, P.in[I_QNORM] + l * 64, P.in[I_KNORM] + l * 64, lds + 131072 + 256, ctl + 32 + 2 * l};
            pg8::gemm_phase(lds, D, D, S, E);
        PHASE_END(true)
        PHASE_BEGIN
            fourier_fold(ws, bid, G);
        PHASE_END(true)
        PHASE_BEGIN
            if (bid < 96) {
                OneSched S; S.have = true; S.u.pm = bid & 15; S.u.pn = bid >> 4; S.u.nt = 64;
                S.u.A = (const char*)(ws + A_DFT) + (size_t)S.u.pm * 256 * 4096 * 2; S.u.B = (const char*)(ws + A_FTF) + (size_t)S.u.pn * 256 * 4096 * 2;
                EpiFourier E{(bf16_t*)(ws + A_BRQ), 0, SEQ, 1.0f / 512.0f};
                pg8::gemm_phase(lds, 4096, 4096, S, E);
            } else if (l == 0 && bid < 102) {
                OneSched S; S.have = true; S.u.pm = 0; S.u.pn = bid - 96; S.u.nt = 8;
                S.u.A = (const char*)(ws + OFF_DFTC); S.u.B = (const char*)(ws + A_FTC) + (size_t)S.u.pn * 256 * 512 * 2;
                EpiFourier E{(bf16_t*)(ws + A_BRQ), MLAT, LC, 1.0f / 128.0f};
                pg8::gemm_phase(lds, 512, 512, S, E);
            }
            {
                const float lam = misc[l * 2], lam_init = misc[l * 2 + 1];
                const int n_diff = 32, n_gqa = 64, n_cd = l == 0 ? 2 : 0, n_cg = l == 0 ? 4 : 0, n_conv = l == 0 ? 34 : 32;
                const int total = n_diff + n_gqa + n_cd + n_cg + n_conv;
                volatile LAS int* slot = (volatile LAS int*)(lds + 131072);
                for (int dx = 0; dx < 8; ++dx) {
                    const int x = (bid + dx) & 7;
                    for (;;) {
                        __syncthreads();
                        if (tid == 0) *slot = (int)atomicAdd(ctl + l * 8 + x, 1u);
                        __syncthreads();
                        int it = *slot;
                        if (it >= total) break;
                        if (it < n_diff) { const int pi = 2 * x + (it >> 4), b = pi >> 2, hd = pi & 3, qb = it & 15; diff_unit(lds, P, l, b, hd, b * SEQ + qb * 256, 0, LKV / 64, lam, lam_init); continue; }
                        it -= n_diff;
                        if (it < n_gqa) { const int b = x >> 1, qh = (x & 1) * 4 + (it >> 4), qb = it & 15; gqa_unit(lds, P, l, b, qh, b * SEQ + qb * 256, 0, LKV / 64); continue; }
                        it -= n_gqa;
                        if (it < n_cd) { const int pi = 2 * x + it, b = pi >> 2, hd = pi & 3; diff_unit(lds, P, l, b, hd, MLAT + b * LC, SEQ, LC / 64, lam, lam_init); continue; }
                        it -= n_cd;
                        if (it < n_cg) { const int b = x >> 1, qh = (x & 1) * 4 + it; gqa_unit(lds, P, l, b, qh, MLAT + b * LC, SEQ, LC / 64); continue; }
                        it -= n_cg;
                        { const int m0 = (x * n_conv + it) * 64; int s0, Ls; if (m0 < MLAT) { s0 = m0 & ~4095; Ls = SEQ; } else { s0 = MLAT + ((m0 - MLAT) & ~255); Ls = LC; }
                          conv_unit(lds, P, l, m0, s0, Ls); }
                    }
                }
                __syncthreads();
            }
        PHASE_END(true)
        PHASE_BEGIN
            {
                bf16_t* wbr = (bf16_t*)(ws + A_WBRT);
                convT(lds, P.in[I_WBRF] + (size_t)l * 384 * D, D, 384, wbr, KBR, D, MapId{0}, bid, G);
                convT(lds, P.in[I_WBRD] + (size_t)l * 512 * D, D, 512, wbr + 384, KBR, D, MapId{0}, (bid + 48) % G, G);
                convT(lds, P.in[I_WBRG] + (size_t)l * 512 * D, D, 512, wbr + 896, KBR, D, MapId{0}, (bid + 112) % G, G);
                convT(lds, P.in[I_WBRC] + (size_t)l * 384 * D, D, 384, wbr + 1408, KBR, D, MapId{0}, (bid + 176) % G, G);
                convT(lds, P.in[I_WOUT] + (size_t)l * D * D, D, D, (bf16_t*)(ws + A_WOUTT), D, D, MapId{0}, (bid + 224) % G, G);
                __syncthreads();
            }
            RectSched S{(const char*)(ws + OFF_HS), (const char*)(ws + OFF_WINT) + (size_t)3840 * D * 2, (size_t)256 * D * 2, (size_t)256 * D * 2, 16, G, bid, nMt, 16, 0, 0, 0};
            EpiBf16<1> E{(bf16_t*)(ws + A_G), 4096};
            pg8::gemm_phase(lds, D, D, S, E);
        PHASE_END(true)
        PHASE_BEGIN
            RectSched S{(const char*)(ws + A_BRQ), (const char*)(ws + A_WBRT), (size_t)256 * KBR * 2, (size_t)256 * KBR * 2, 28, G, bid, nMt, 4, 0, 0, 0};
            EpiBranch E{(const bf16_t*)(ws + A_G), (bf16_t*)(ws + OFF_HS)};
            pg8::gemm_phase(lds, KBR, KBR, S, E);
        PHASE_END(true)
        PHASE_BEGIN
            RectSched S{(const char*)(ws + OFF_HS), (const char*)(ws + A_WOUTT), (size_t)256 * D * 2, (size_t)256 * D * 2, 16, G, bid, nMt, 4, 0, 0, 0};
            EpiBf16<0> E{(bf16_t*)(ws + A_MIXO), D};
            pg8::gemm_phase(lds, D, D, S, E);
        PHASE_END(true)
        PHASE_BEGIN
            rows_update(P, l, 0, l == 0 ? MTOT : MLAT);
            convT(lds, P.in[I_WFF1] + (size_t)l * D * DFF, DFF, D, (bf16_t*)(ws + A_WFF1T), D, DFF, MapId{0}, bid, G);
            convT(lds, P.in[I_WFF2] + (size_t)l * DFF * D, D, DFF, (bf16_t*)(ws + A_WFF2T), DFF, D, MapId{0}, bid, G);
        PHASE_END(true)
        PHASE_BEGIN
            RectSched S{(const char*)(ws + OFF_HS), (const char*)(ws + A_WFF1T), (size_t)256 * D * 2, (size_t)256 * D * 2, 16, G, bid, nMt, 16, 0, 0, 0};
            EpiBf16<2> E{(bf16_t*)(ws + A_FF), DFF};
            pg8::gemm_phase(lds, D, D, S, E);
        PHASE_END(true)
        PHASE_BEGIN
            RectSched S{(const char*)(ws + A_FF), (const char*)(ws + A_WFF2T), (size_t)256 * DFF * 2, (size_t)256 * DFF * 2, 64, G, bid, nMt, 4, 0, 0, 0};
            EpiBf16<0> E{(bf16_t*)(ws + A_MIXO), D};
            pg8::gemm_phase(lds, DFF, DFF, S, E);
        PHASE_END(true)
        PHASE_BEGIN
            rows_update(P, l, 1, l == 0 ? MTOT : MLAT);
            if (l == 0) { conv_win(lds, P, 1, bid, G); gen_dft(lds, ws, bid, G, false); }
        PHASE_END(l == 0)
    }
}

extern "C" void kernel_launch(void* const* d_in, const int* in_sizes, int n_in, void* d_out, int out_size, void* d_ws, size_t ws_size, hipStream_t stream) {
    static int grid = 0;
    if (grid == 0) {
        if (n_in != 26 || ws_size < WS_END) { fprintf(stderr, "kernel_launch: unexpected inputs (%d) or workspace (%zu < %zu)\n", n_in, ws_size, (size_t)WS_END); grid = -1; return; }
        int dev = 0, cus = 0, per_cu = 0;
        (void)hipGetDevice(&dev);
        (void)hipDeviceGetAttribute(&cus, hipDeviceAttributeMultiprocessorCount, dev);
        if (hipFuncSetAttribute((const void*)fwd_mega, hipFuncAttributeMaxDynamicSharedMemorySize, LDS_BYTES) != hipSuccess) { fprintf(stderr, "hipFuncSetAttribute failed\n"); grid = -1; return; }
        if (hipOccupancyMaxActiveBlocksPerMultiprocessor(&per_cu, (const void*)fwd_mega, NTHREADS, LDS_BYTES) != hipSuccess || per_cu < 1) { fprintf(stderr, "occupancy query: %d\n", per_cu); per_cu = 1; }
        (void)hipGetLastError();
        grid = cus * per_cu;
        if (grid > 256) grid = 256;
    }
    if (grid < 0) return;
    KArgs a{};
    for (int i = 0; i < 26; ++i) a.p.in[i] = (const float*)d_in[i];
    a.p.out = (float*)d_out; a.p.ws = (unsigned char*)d_ws;
#ifndef PROBE_RANGES
#define PROBE_RANGES {0, 1000}
#endif
    static const int ranges[][2] = { PROBE_RANGES };
    const int nr = (int)(sizeof(ranges) / sizeof(ranges[0]));
    for (int i = 0; i < nr; ++i) {
        if (i > 0) (void)hipMemsetAsync((char*)d_ws + OFF_CTL, 0, 256, stream);
        (void)hipMemsetAsync((char*)d_ws + OFF_BAR, 0, 16384, stream);
        a.ph_lo = ranges[i][0]; a.ph_hi = ranges[i][1];
        void* kargs[] = {&a};
        hipError_t e = hipLaunchCooperativeKernel((const void*)fwd_mega, dim3(grid), dim3(NTHREADS), kargs, LDS_BYTES, stream);
        if (e != hipSuccess) fprintf(stderr, "cooperative launch failed: %s (grid %d)\n", hipGetErrorString(e), grid);
    }
}
```

```cpp
#include <hip/hip_runtime.h>
#include <hip/hip_cooperative_groups.h>
#include <cstdint>
#include <cstdio>
namespace cg = cooperative_groups;

#define LAS __attribute__((address_space(3)))
#define DI __device__ __forceinline__
typedef unsigned short bf16_t;
typedef short bf16x8 __attribute__((ext_vector_type(8)));
typedef short s16x4 __attribute__((ext_vector_type(4)));
typedef float f32x4 __attribute__((ext_vector_type(4)));
typedef float f32x2 __attribute__((ext_vector_type(2)));
typedef float f32x16 __attribute__((ext_vector_type(16)));
typedef unsigned u32x4 __attribute__((ext_vector_type(4)));
typedef unsigned u32x2 __attribute__((ext_vector_type(2)));
typedef __bf16 bf16x2_t __attribute__((ext_vector_type(2)));

DI unsigned pk2(float lo, float hi) { f32x2 v = {lo, hi}; return __builtin_bit_cast(unsigned, __builtin_convertvector(v, bf16x2_t)); }
DI float bflo(unsigned u) { return __uint_as_float(u << 16); }
DI float bfhi(unsigned u) { return __uint_as_float(u & 0xffff0000u); }
DI float sigmoidf_(float x) { return __builtin_amdgcn_rcpf(1.0f + __builtin_amdgcn_exp2f(-1.44269504f * x)); }
DI int tid_() { int t = threadIdx.x; asm volatile("" : "+v"(t)); return t; }
DI float wave_sum(float v) {
#pragma unroll
    for (int o = 32; o >= 1; o >>= 1) v += __shfl_xor(v, o);
    return v;
}

constexpr int D = 1024, NB = 4, SEQ = 4096, LC = 256, MLAT = NB * SEQ, MCTX = NB * LC, MTOT = MLAT + MCTX, LKV = SEQ + LC;
constexpr int IN_COLS = 7552, NIN = 7936, DFF = 4096, KBR = 1792;
constexpr float EPS = 1e-6f;
constexpr float QSCALE = 0.125f * 1.44269504f;
enum { I_X = 0, I_C, I_CTX, I_CCTX, I_WMOD, I_BMOD, I_GPREMIX, I_GPOSTMIX, I_GPREMLP, I_GPOSTMLP, I_WIN, I_QNORM, I_KNORM, I_LAMBDA, I_SUBLN,
       I_CONVDW, I_CONVB, I_CONVLNG, I_CONVLNB, I_WBRF, I_WBRD, I_WBRG, I_WBRC, I_WOUT, I_WFF1, I_WFF2 };

constexpr size_t OFF_CTL = 0, OFF_MISC = 4096, OFF_MOD = 8192, OFF_ROPE = 253952, OFF_DFTC = 262144, OFF_HS = 524288;
constexpr size_t OFF_WINT = OFF_HS + (size_t)MTOT * D * 2;
constexpr size_t ARENA = OFF_WINT + (size_t)NIN * D * 2;
constexpr size_t A_BRQ = ARENA, A_MIXO = ARENA;
constexpr size_t A_G = ARENA + (size_t)MTOT * KBR * 2;
constexpr size_t A_DFT = A_G;
constexpr size_t A_FTF = A_DFT + (size_t)4096 * 4096 * 2;
constexpr size_t A_FT = A_DFT + (size_t)4096 * 8192 * 2;
constexpr size_t A_FTC = A_FT + (size_t)NB * 384 * 8192 * 2;
constexpr size_t A_DK = A_FTC + (size_t)NB * 384 * 512 * 2;
constexpr size_t A_DV = A_DK + (size_t)MTOT * 512 * 2;
constexpr size_t A_GK = A_DV + (size_t)MTOT * 512 * 2;
constexpr size_t A_GV = A_GK + (size_t)MTOT * 128 * 2;
constexpr size_t A_V = A_GV + (size_t)MTOT * 128 * 2;
constexpr size_t A_VEND = A_V + (size_t)MTOT * 384 * 2;
constexpr size_t A_WBRT = A_G + (size_t)MTOT * 4096 * 2;
constexpr size_t A_WOUTT = A_WBRT + (size_t)D * KBR * 2;
constexpr size_t A_FF = ARENA + (size_t)MTOT * D * 2;
constexpr size_t A_WFF1T = A_FF + (size_t)MTOT * DFF * 2;
constexpr size_t A_WFF2T = A_WFF1T + (size_t)DFF * D * 2;
constexpr size_t A_XC = A_WFF2T + (size_t)DFF * D * 2;
constexpr size_t OFF_BAR = A_VEND;
constexpr size_t WS_END = OFF_BAR + 16384;
static_assert(A_XC + (size_t)MCTX * D * 4 <= A_WBRT, "xc overlaps");
static_assert(A_WOUTT + (size_t)D * D * 2 <= WS_END, "ws end");
static_assert(WS_END <= 268435456ull, "workspace too large");

constexpr int LDS_BYTES = 131072 + 256 + 18432;
constexpr int NTHREADS = 512;

namespace pg8 {
constexpr int BM = 256, BK = 64, HALF = 128, HTB = HALF * BK * 2, NXCD = 8, WGM = 8;
DI int lds_byte(int r, int c) { const int st = (r >> 4) * 2 + (c >> 5), rr = r & 15, cc = c & 31, ob = rr * 64 + cc * 2; return st * 1024 + (ob ^ (((ob >> 9) & 1) << 5)); }
DI void stage_rc(int b, int& R, int& C) { const int st = b / 1024, sb = b % 1024, swz = sb ^ (((sb >> 9) & 1) << 5); R = (st >> 1) * 16 + swz / 64; C = (st & 1) * 32 + (swz % 64) / 2; }
DI int perm32(int rho) { const int n = rho >> 4, i = rho & 15; return 8 * (i >> 2) + 4 * n + (i & 3); }

struct Unit { const char* A; const char* B; int nt, pm, pn; };

DI void rect_map(int L, int nM, int nN, int& pm, int& pn) {
    const int nwg = nM * nN; int wgid = L;
    { const int q = nwg / NXCD, r = nwg % NXCD, xcd = wgid % NXCD, off = wgid / NXCD; wgid = (xcd < r ? xcd * (q + 1) : r * (q + 1) + (xcd - r) * q) + off; }
    const int nig = WGM * nN, gid = wgid / nig, fm = gid * WGM, gsz = (nM - fm) < WGM ? (nM - fm) : WGM;
    pm = fm + ((wgid % nig) % gsz); pn = (wgid % nig) / gsz;
}

template <class Epi, class Sched>
DI void gemm_phase(LAS unsigned char* lds, const int lda, const int ldb, const Sched& S, const Epi& E) {
    int tid = threadIdx.x; asm volatile("" : "+v"(tid));
    const int wid = __builtin_amdgcn_readfirstlane(tid >> 6), lane = tid & 63, wr = wid >> 2, wc = wid & 3, fr = lane & 15, fq = lane >> 4;
    unsigned voffA[2], voffB[2];
#pragma unroll
    for (int i = 0; i < 2; ++i) { int R, C; stage_rc(tid * 16 + i * 8192, R, C); const int Rb = Epi::PERM ? ((R & ~31) + perm32(R & 31)) : R;
        voffA[i] = (unsigned)(R * lda + C) * 2u; voffB[i] = (unsigned)(Rb * ldb + C) * 2u; }
    const size_t kstep = (size_t)(BK * 2);
    const size_t hstepA = (size_t)HALF * lda * 2, hstepB = (size_t)HALF * ldb * 2;
    const unsigned ldsw = (unsigned)wid * 1024u;
    const int aoff = lds_byte(wr * 64 + fr, fq * 8), boff = lds_byte(wc * 32 + fr, fq * 8);
#define PG8_SA(b, h) (((b) * 2 + (h)) * HTB)
#define PG8_SB(b, h) ((4 + (b) * 2 + (h)) * HTB)
#define PG8_STAGE(bufoff, gbase, voff) do { _Pragma("unroll") for (int _i = 0; _i < 2; ++_i) \
        __builtin_amdgcn_global_load_lds((const unsigned*)((const char*)(gbase) + (voff)[_i]), (LAS unsigned*)(lds + (bufoff) + ldsw + _i * 8192), 16, 0, 0); } while (0)
#define PG8_LDA(dst, b, h) do { _Pragma("unroll") for (int m = 0; m < 4; ++m) _Pragma("unroll") for (int k = 0; k < 2; ++k) dst[m][k] = *(const LAS bf16x8*)(lds + PG8_SA(b, h) + aoff + m * 2048 + k * 1024); } while (0)
#define PG8_LDB(dst, b, h) do { _Pragma("unroll") for (int n = 0; n < 2; ++n) _Pragma("unroll") for (int k = 0; k < 2; ++k) dst[n][k] = *(const LAS bf16x8*)(lds + PG8_SB(b, h) + boff + n * 2048 + k * 1024); } while (0)
#define PG8_MMA(ai, bj, At, Bt) do { __builtin_amdgcn_s_setprio(1); _Pragma("unroll") for (int m = 0; m < 4; ++m) _Pragma("unroll") for (int n = 0; n < 2; ++n) _Pragma("unroll") for (int k = 0; k < 2; ++k) \
        acc[ai][bj][m][n] = __builtin_amdgcn_mfma_f32_16x16x32_bf16(Bt[n][k], At[m][k], acc[ai][bj][m][n], 0, 0, 0); __builtin_amdgcn_s_setprio(0); } while (0)
#define PG8_WAIT_V(n) asm volatile("s_waitcnt vmcnt(" #n ")" ::: "memory")
#define PG8_WAIT_L(n) asm volatile("s_waitcnt lgkmcnt(" #n ")" ::: "memory")
#define PG8_BAR __builtin_amdgcn_s_barrier()
#define PG8_SCHED __builtin_amdgcn_sched_barrier(0)
    Unit cur, nxt; int ui = 0;
    if (!S.next(0, cur)) return;
    f32x4 acc[2][2][4][2];
#pragma unroll
    for (int a = 0; a < 2; ++a)
#pragma unroll
        for (int b = 0; b < 2; ++b)
#pragma unroll
            for (int m = 0; m < 4; ++m)
#pragma unroll
                for (int n = 0; n < 2; ++n) acc[a][b][m][n] = (f32x4){0.f, 0.f, 0.f, 0.f};
    bf16x8 At[4][2], B0[2][2], B1[2][2];
    const char* cA = cur.A; const char* cB = cur.B;
    PG8_STAGE(PG8_SB(0, 0), cB, voffB); PG8_STAGE(PG8_SB(0, 1), cB + hstepB, voffB); PG8_STAGE(PG8_SA(0, 0), cA, voffA); PG8_STAGE(PG8_SA(0, 1), cA + hstepA, voffA);
    if (wr == 1) PG8_BAR;
    PG8_WAIT_V(2); PG8_BAR;
    PG8_STAGE(PG8_SB(1, 0), cB + kstep, voffB); PG8_STAGE(PG8_SA(1, 0), cA + kstep, voffA); PG8_STAGE(PG8_SB(1, 1), cB + hstepB + kstep, voffB);
    PG8_WAIT_V(6); PG8_BAR;
    for (;;) {
        const bool has_next = S.next(ui + 1, nxt);
        const char* nA = has_next ? nxt.A : cA; const char* nB = has_next ? nxt.B : cB;
        const int nt = cur.nt;
        for (int t = 0; t < nt; t += 2) {
            if constexpr (Epi::HOOK) { if (t == 6 || t == 14 || t == 22) E.hook(acc, cur, t, wr, wc, fr, fq); }
            const bool last = (t == nt - 2);
            const char* a1 = cA + (size_t)(t + 1) * kstep;
            const char* a2 = last ? nA : cA + (size_t)(t + 2) * kstep; const char* b2 = last ? nB : cB + (size_t)(t + 2) * kstep;
            const char* a3 = a2 + kstep; const char* b3 = b2 + kstep;
            PG8_LDB(B0, 0, 0); PG8_LDB(B1, 0, 1); PG8_SCHED; PG8_LDA(At, 0, 0); PG8_STAGE(PG8_SA(1, 1), a1 + hstepA, voffA);
            PG8_WAIT_V(8); PG8_WAIT_L(0); PG8_BAR; PG8_MMA(0, 0, At, B0); PG8_MMA(0, 1, At, B1); PG8_BAR; PG8_SCHED;
            PG8_LDA(At, 0, 1); PG8_STAGE(PG8_SB(0, 0), b2, voffB); PG8_STAGE(PG8_SB(0, 1), b2 + hstepB, voffB); PG8_STAGE(PG8_SA(0, 0), a2, voffA);
            PG8_WAIT_V(8); PG8_WAIT_L(0); PG8_BAR; PG8_MMA(1, 0, At, B0); PG8_MMA(1, 1, At, B1); PG8_BAR; PG8_SCHED;
            PG8_LDB(B0, 1, 0); PG8_LDB(B1, 1, 1); PG8_SCHED; PG8_LDA(At, 1, 0); PG8_STAGE(PG8_SA(0, 1), a2 + hstepA, voffA);
            PG8_WAIT_V(8); PG8_WAIT_L(0); PG8_BAR; PG8_MMA(0, 0, At, B0); PG8_MMA(0, 1, At, B1); PG8_BAR; PG8_SCHED;
            PG8_LDA(At, 1, 1); PG8_STAGE(PG8_SB(1, 0), b3, voffB); PG8_STAGE(PG8_SB(1, 1), b3 + hstepB, voffB); PG8_STAGE(PG8_SA(1, 0), a3, voffA);
            PG8_WAIT_V(8); PG8_WAIT_L(0); PG8_BAR; PG8_MMA(1, 0, At, B0); PG8_MMA(1, 1, At, B1); PG8_BAR; PG8_SCHED;
        }
        if (wr == 0) PG8_BAR;
        E(acc, cur, wr, wc, fr, fq);
        if (!has_next) break;
#pragma unroll
        for (int a = 0; a < 2; ++a)
#pragma unroll
            for (int b = 0; b < 2; ++b)
#pragma unroll
                for (int m = 0; m < 4; ++m)
#pragma unroll
                    for (int n = 0; n < 2; ++n) acc[a][b][m][n] = (f32x4){0.f, 0.f, 0.f, 0.f};
        cur = nxt; cA = nA; cB = nB; ++ui;
        if (wr == 1) PG8_BAR;
    }
    PG8_WAIT_V(0);
    PG8_BAR;
#undef PG8_SA
#undef PG8_SB
#undef PG8_STAGE
#undef PG8_LDA
#undef PG8_LDB
#undef PG8_MMA
#undef PG8_WAIT_V
#undef PG8_WAIT_L
#undef PG8_BAR
#undef PG8_SCHED
}
}
using pg8::Unit;
typedef f32x4 Acc[2][2][4][2];

struct RectSched {
    const char* A; const char* B; size_t astep, bstep;
    int nt, G, c, nM1, nN1, m2, nM2, nN2;
    DI bool next(int i, Unit& u) const {
        const int L = i * G + c; const int n1 = nM1 * nN1;
        int pm, pn;
        if (L < n1) pg8::rect_map(L, nM1, nN1, pm, pn);
        else if (L < n1 + nM2 * nN2) { pg8::rect_map(L - n1, nM2, nN2, pm, pn); pm += m2; }
        else return false;
        u.pm = pm; u.pn = pn; u.nt = nt; u.A = A + (size_t)pm * astep; u.B = B + (size_t)pn * bstep; return true;
    }
};
struct OneSched {
    Unit u; bool have;
    DI bool next(int i, Unit& o) const { if (i != 0 || !have) return false; o = u; return true; }
};

struct Ptrs {
    const float* in[26]; float* out; unsigned char* ws;
};

struct EpiInA {
    static constexpr bool PERM = true, HOOK = false;
    unsigned char* ws; const float* qn; const float* kn;
    LAS unsigned char* scr;
    unsigned* nrm;
    DI void hook(Acc&, const Unit&, int, int, int, int, int) const {}
    DI void operator()(const Acc& acc, const Unit& u, int wr, int wc, int fr, int fq) const {
        const int pn = u.pn;
        const f32x2* rope = (const f32x2*)(ws + OFF_ROPE);
        bf16_t* BRQ = (bf16_t*)(ws + A_BRQ);
        const bool ctx = u.pm >= 64;
        if (pn <= 1 || pn == 5 || pn == 6) {
            float nmax = 0.f;
#pragma unroll
            for (int ai = 0; ai < 2; ++ai)
#pragma unroll
                for (int m = 0; m < 4; ++m) {
                const int row = u.pm * 256 + ai * 128 + wr * 64 + m * 16 + fr;
                int b, t, kvrow;
                if (!ctx) { b = row >> 12; t = row & 4095; kvrow = b * LKV + t; }
                else { const int j = row - MLAT; b = j >> 8; t = j & 255; kvrow = b * LKV + SEQ + t; }
                const int prow = t >> 6, pcol = t & 63; (void)b; (void)kvrow; (void)prow; (void)pcol;
                    const bool isq = pn >= 5;
                    const int axis = wc & 1; const int pos = axis ? pcol : prow;
                    f32x2 cs[4];
#pragma unroll
                    for (int j = 0; j < 4; ++j) cs[j] = ctx ? (f32x2){1.f, 0.f} : rope[pos * 16 + 4 * fq + j];
#pragma unroll
                    for (int bj = 0; bj < 2; ++bj) {
                        const f32x4 re = acc[ai][bj][m][0], im = acc[ai][bj][m][1];
                        float o0[4], o1[4];
#pragma unroll
                        for (int j = 0; j < 4; ++j) { o0[j] = re[j] * cs[j].x - im[j] * cs[j].y; o1[j] = im[j] * cs[j].x + re[j] * cs[j].y; if (isq) { o0[j] *= QSCALE; o1[j] *= QSCALE; } }
                        const int c = (isq ? (pn - 5) : pn) * 256 + bj * 128 + wc * 32 + 8 * fq;
                        bf16_t* dst = isq ? (BRQ + (size_t)row * KBR + 384 + c) : ((bf16_t*)(ws + A_DK) + (size_t)kvrow * 512 + c);
                        *(u32x4*)dst = (u32x4){pk2(o0[0], o0[1]), pk2(o0[2], o0[3]), pk2(o1[0], o1[1]), pk2(o1[2], o1[3])};
                        float ss = o0[0] * o0[0] + o0[1] * o0[1] + o0[2] * o0[2] + o0[3] * o0[3] + o1[0] * o1[0] + o1[1] * o1[1] + o1[2] * o1[2] + o1[3] * o1[3];
                        ss += __shfl_xor(ss, 16); ss += __shfl_xor(ss, 32); nmax = fmaxf(nmax, ss);
                    }
                }
#pragma unroll
            for (int o = 8; o >= 1; o >>= 1) nmax = fmaxf(nmax, __shfl_xor(nmax, o));
            if (fq == 0 && fr == 0) atomicMax(nrm + (pn >= 5 ? 1 : 0), __float_as_uint(nmax));
        } else if (pn == 2 || pn == 3) {
#pragma unroll
            for (int ai = 0; ai < 2; ++ai)
#pragma unroll
                for (int m = 0; m < 4; ++m) {
                const int row = u.pm * 256 + ai * 128 + wr * 64 + m * 16 + fr;
                int b, t, kvrow;
                if (!ctx) { b = row >> 12; t = row & 4095; kvrow = b * LKV + t; }
                else { const int j = row - MLAT; b = j >> 8; t = j & 255; kvrow = b * LKV + SEQ + t; }
                const int prow = t >> 6, pcol = t & 63; (void)b; (void)kvrow; (void)prow; (void)pcol;
#pragma unroll
                    for (int bj = 0; bj < 2; ++bj)
#pragma unroll
                        for (int n = 0; n < 2; ++n) { const f32x4 v = acc[ai][bj][m][n]; const int c = (pn - 2) * 256 + bj * 128 + wc * 32 + 8 * fq + 4 * n;
                            *(u32x2*)((bf16_t*)(ws + A_DV) + (size_t)kvrow * 512 + c) = (u32x2){pk2(v[0], v[1]), pk2(v[2], v[3])}; }
                }
        } else if (pn == 4 || pn == 7 || pn == 8) {
#pragma unroll
            for (int ai = 0; ai < 2; ++ai)
#pragma unroll
                for (int m = 0; m < 4; ++m) {
                const int row = u.pm * 256 + ai * 128 + wr * 64 + m * 16 + fr;
                int b, t, kvrow;
                if (!ctx) { b = row >> 12; t = row & 4095; kvrow = b * LKV + t; }
                else { const int j = row - MLAT; b = j >> 8; t = j & 255; kvrow = b * LKV + SEQ + t; }
                const int prow = t >> 6, pcol = t & 63; (void)b; (void)kvrow; (void)prow; (void)pcol;
                    const bool isq = pn >= 7; const bool isv = (pn == 4) && wc >= 2;
                    float ss = 0.f;
#pragma unroll
                    for (int bj = 0; bj < 2; ++bj)
#pragma unroll
                        for (int n = 0; n < 2; ++n) { const f32x4 v = acc[ai][bj][m][n]; ss += v[0] * v[0] + v[1] * v[1] + v[2] * v[2] + v[3] * v[3]; }
                    ss += __shfl_xor(ss, 16); ss += __shfl_xor(ss, 32);
                    const float rs = isv ? 1.f : __builtin_amdgcn_rsqf(ss * (1.0f / 64.0f) + EPS);
                    const float* gn = isq ? qn : kn;
                    bf16_t* dst;
                    if (isq) dst = BRQ + (size_t)row * KBR + 896 + ((pn - 7) * 4 + wc) * 64;
                    else if (isv) dst = (bf16_t*)(ws + A_GV) + (size_t)kvrow * 128 + (wc - 2) * 64;
                    else dst = (bf16_t*)(ws + A_GK) + (size_t)kvrow * 128 + wc * 64;
#pragma unroll
                    for (int bj = 0; bj < 2; ++bj) {
                        const int pos = bj ? pcol : prow;
                        float o0[4], o1[4];
#pragma unroll
                        for (int j = 0; j < 4; ++j) {
                            float re = acc[ai][bj][m][0][j], im = acc[ai][bj][m][1][j];
                            if (!isv) { re *= rs * gn[32 * bj + 4 * fq + j]; im *= rs * gn[32 * bj + 16 + 4 * fq + j]; }
                            f32x2 cs = (ctx || isv) ? (f32x2){1.f, 0.f} : rope[pos * 16 + 4 * fq + j];
                            o0[j] = re * cs.x - im * cs.y; o1[j] = im * cs.x + re * cs.y;
                            if (isq) { o0[j] *= QSCALE; o1[j] *= QSCALE; }
                        }
                        *(u32x4*)(dst + 32 * bj + 8 * fq) = (u32x4){pk2(o0[0], o0[1]), pk2(o0[2], o0[3]), pk2(o1[0], o1[1]), pk2(o1[2], o1[3])};
                    }
                }
        } else if (pn <= 11) {
            const int lane = fq * 16 + fr, col = lane >> 2, chunk = lane & 3;
            LAS bf16_t* sw = (LAS bf16_t*)(scr + (wr * 4 + wc) * 2304);
#pragma unroll
            for (int ai = 0; ai < 2; ++ai) {
                const int row0 = u.pm * 256 + ai * 128 + wr * 64;
                int b, t0; if (!ctx) { b = row0 >> 12; t0 = row0 & 4095; } else { const int j = row0 - MLAT; b = j >> 8; t0 = j & 255; }
#pragma unroll
                for (int bj = 0; bj < 2; ++bj)
#pragma unroll
                    for (int n = 0; n < 2; ++n) {
#pragma unroll
                        for (int m = 0; m < 4; ++m) { const f32x4 v = acc[ai][bj][m][n];
#pragma unroll
                            for (int j = 0; j < 4; ++j) sw[(4 * fq + j) * 72 + 16 * m + fr] = (bf16_t)(pk2(v[j], 0.f) & 0xffffu); }
                        asm volatile("s_waitcnt lgkmcnt(0)" ::: "memory");
                        const u32x4 v0 = *(const LAS u32x4*)(sw + col * 72 + chunk * 16), v1 = *(const LAS u32x4*)(sw + col * 72 + chunk * 16 + 8);
                        const int c0 = (pn - 9) * 256 + bj * 128 + wc * 32 + 8 * (col >> 2) + 4 * n + (col & 3); const int part = c0 >= 384 ? 1 : 0; const int ch = c0 - part * 384;
                        bf16_t* dst = ctx ? ((bf16_t*)(ws + A_FTC) + (size_t)(b * 384 + ch) * 512 + part * 256 + t0 + chunk * 16)
                                          : ((bf16_t*)(ws + A_FT) + (size_t)(b * 384 + ch) * 8192 + part * 4096 + t0 + chunk * 16);
                        *(u32x4*)dst = v0; *(u32x4*)(dst + 8) = v1;
                        asm volatile("s_waitcnt lgkmcnt(0)" ::: "memory");
                    }
            }
        } else {
#pragma unroll
            for (int ai = 0; ai < 2; ++ai)
#pragma unroll
                for (int m = 0; m < 4; ++m) {
                const int row = u.pm * 256 + ai * 128 + wr * 64 + m * 16 + fr;
                int b, t, kvrow;
                if (!ctx) { b = row >> 12; t = row & 4095; kvrow = b * LKV + t; }
                else { const int j = row - MLAT; b = j >> 8; t = j & 255; kvrow = b * LKV + SEQ + t; }
                const int prow = t >> 6, pcol = t & 63; (void)b; (void)kvrow; (void)prow; (void)pcol;
#pragma unroll
                    for (int bj = 0; bj < 2; ++bj) {
                        const f32x4 a = acc[ai][bj][m][0], g = acc[ai][bj][m][1];
                        const int ch = ((pn - 12) * 8 + 4 * bj + wc) * 16 + 4 * fq;
                        float o[4];
#pragma unroll
                        for (int j = 0; j < 4; ++j) o[j] = a[j] * sigmoidf_(g[j]);
                        *(u32x2*)((bf16_t*)(ws + A_V) + (size_t)row * 384 + ch) = (u32x2){pk2(o[0], o[1]), pk2(o[2], o[3])};
                    }
                }
        }
    }
};

template <int ACT> struct EpiBf16 {
    static constexpr bool PERM = true, HOOK = false;
    bf16_t* O; int ldc;
    DI void hook(Acc&, const Unit&, int, int, int, int, int) const {}
    DI void operator()(const Acc& acc, const Unit& u, int wr, int wc, int fr, int fq) const {
#pragma unroll
        for (int ai = 0; ai < 2; ++ai)
#pragma unroll
            for (int m = 0; m < 4; ++m) {
                bf16_t* rowp = O + (size_t)(u.pm * 256 + ai * 128 + wr * 64 + m * 16 + fr) * ldc + u.pn * 256 + wc * 32 + 8 * fq;
#pragma unroll
                for (int bj = 0; bj < 2; ++bj) {
                    f32x4 v0 = acc[ai][bj][m][0], v1 = acc[ai][bj][m][1];
                    if (ACT == 1) {
#pragma unroll
                        for (int j = 0; j < 4; ++j) { v0[j] = sigmoidf_(v0[j]); v1[j] = sigmoidf_(v1[j]); }
                    } else if (ACT == 2) {
#pragma unroll
                        for (int j = 0; j < 4; ++j) { float a = fmaxf(v0[j], 0.f), b = fmaxf(v1[j], 0.f); v0[j] = a * a; v1[j] = b * b; }
                    }
                    *(u32x4*)(rowp + bj * 128) = (u32x4){pk2(v0[0], v0[1]), pk2(v0[2], v0[3]), pk2(v1[0], v1[1]), pk2(v1[2], v1[3])};
                }
            }
    }
};

struct EpiBranch {
    static constexpr bool PERM = true, HOOK = true;
    const bf16_t* G; bf16_t* O;
    DI void hook(Acc& acc, const Unit& u, int t, int wr, int wc, int fr_, int fq) const {
        int fr = fr_; asm volatile("" : "+v"(fr));
        const int s = (t == 6) ? 0 : (t == 14 ? 1 : 2);
#pragma unroll
        for (int ai = 0; ai < 2; ++ai) {
            u32x4 ga[4][2], gb[4][2];
#pragma unroll
            for (int m = 0; m < 4; ++m) {
                const bf16_t* gp = G + (size_t)(u.pm * 256 + ai * 128 + wr * 64 + m * 16 + fr) * 4096 + s * 1024 + u.pn * 256 + wc * 32 + 8 * fq;
#pragma unroll
                for (int bj = 0; bj < 2; ++bj) { ga[m][bj] = *(const u32x4*)(gp + bj * 128); gb[m][bj] = *(const u32x4*)(gp + 1024 + bj * 128); }
            }
#pragma unroll
            for (int m = 0; m < 4; ++m)
#pragma unroll
                for (int bj = 0; bj < 2; ++bj)
#pragma unroll
                    for (int q = 0; q < 4; ++q) {
                        const float r0 = bflo(ga[m][bj][q]) * __builtin_amdgcn_rcpf(bflo(gb[m][bj][q])), r1 = bfhi(ga[m][bj][q]) * __builtin_amdgcn_rcpf(bfhi(gb[m][bj][q]));
                        acc[ai][bj][m][q >> 1][(q & 1) * 2] *= r0; acc[ai][bj][m][q >> 1][(q & 1) * 2 + 1] *= r1;
                    }
            asm volatile("" ::: "memory");
        }
    }
    DI void operator()(const Acc& acc, const Unit& u, int wr, int wc, int fr, int fq) const {
#pragma unroll
        for (int ai = 0; ai < 2; ++ai) {
            u32x4 g[4][2];
#pragma unroll
            for (int m = 0; m < 4; ++m)
#pragma unroll
                for (int bj = 0; bj < 2; ++bj) g[m][bj] = *(const u32x4*)(G + (size_t)(u.pm * 256 + ai * 128 + wr * 64 + m * 16 + fr) * 4096 + 3072 + u.pn * 256 + wc * 32 + 8 * fq + bj * 128);
#pragma unroll
            for (int m = 0; m < 4; ++m) {
                const size_t row = (size_t)(u.pm * 256 + ai * 128 + wr * 64 + m * 16 + fr);
                const int c = u.pn * 256 + wc * 32 + 8 * fq;
#pragma unroll
                for (int bj = 0; bj < 2; ++bj) {
                    const u32x4 gg = g[m][bj];
                    const f32x4 v0 = acc[ai][bj][m][0], v1 = acc[ai][bj][m][1];
                    *(u32x4*)(O + row * 1024 + c + bj * 128) = (u32x4){pk2(v0[0] * bflo(gg[0]), v0[1] * bfhi(gg[0])), pk2(v0[2] * bflo(gg[1]), v0[3] * bfhi(gg[1])),
                                                                      pk2(v1[0] * bflo(gg[2]), v1[1] * bfhi(gg[2])), pk2(v1[2] * bflo(gg[3]), v1[3] * bfhi(gg[3]))};
                }
            }
            asm volatile("" ::: "memory");
        }
    }
};

struct EpiFourier {
    static constexpr bool PERM = true, HOOK = false;
    bf16_t* BRQ; int row0, seqlen; float scale;
    DI void hook(Acc&, const Unit&, int, int, int, int, int) const {}
    DI void operator()(const Acc& acc, const Unit& u, int wr, int wc, int fr, int fq) const {
#pragma unroll
        for (int ai = 0; ai < 2; ++ai)
#pragma unroll
            for (int m = 0; m < 4; ++m) {
                const int pos = u.pm * 256 + ai * 128 + wr * 64 + m * 16 + fr;
#pragma unroll
                for (int bj = 0; bj < 2; ++bj) {
                    const int c = u.pn * 256 + bj * 128 + wc * 32 + 8 * fq; const int b = c / 384, ch = c - b * 384;
                    const f32x4 v0 = acc[ai][bj][m][0] * scale, v1 = acc[ai][bj][m][1] * scale;
                    *(u32x4*)(BRQ + (size_t)(row0 + b * seqlen + pos) * KBR + ch) = (u32x4){pk2(v0[0], v0[1]), pk2(v0[2], v0[3]), pk2(v1[0], v1[1]), pk2(v1[2], v1[3])};
                }
            }
    }
};

struct MapId { int off; DI int operator()(int n) const { return n + off; } };
struct MapWin {
    DI static int rp(int lc) { return 16 * ((lc >> 2) & 1) + 4 * (lc >> 3) + (lc & 3); }
    DI int operator()(int n) const {
        if (n < 512) return (n & ~31) + rp(n & 31);
        if (n < 1024) return n;
        if (n < 1280) { const int i = n - 1024, bj = i >> 7, wc = (i >> 5) & 3, lc = i & 31; return wc < 2 ? 1024 + wc * 64 + 32 * bj + rp(lc) : 1152 + (wc - 2) * 64 + 32 * bj + lc; }
        if (n < 1792) { const int i = n - 1280; return 1664 + (i & ~31) + rp(i & 31); }
        if (n < 2304) { const int i = n - 1792, tile = i >> 8, ii = i & 255, bj = ii >> 7, wc = (ii >> 5) & 3, lc = ii & 31; return 2176 + (tile * 4 + wc) * 64 + 32 * bj + rp(lc); }
        if (n < 3072) return -1;
        if (n < 3840) { const int i = n - 3072, grp = i >> 5, lc = i & 31, ch = grp * 16 + 4 * (lc >> 3) + (lc & 3); return ((lc >> 2) & 1) ? 3072 + ch : 2688 + ch; }
        return 3456 + (n - 3840);
    }
};
template <class Map>
DI void convT(LAS unsigned char* lds, const float* src, int sld, int K, bf16_t* dst, int dld, int N, const Map& map, int item0, int nblk) {
    LAS float* tile = (LAS float*)lds;
    const int tid = tid_(); const int tK = K / 128, tN = N / 64;
    for (int it = item0; it < tK * tN; it += nblk) {
        const int tn = it / tK, tk = it % tK;
        const int col = map(tn * 64 + (tid & 63));
        if (map(tn * 64) < 0) continue;
        float v[16];
#pragma unroll
        for (int p = 0; p < 16; ++p) v[p] = src[(size_t)(tk * 128 + p * 8 + (tid >> 6)) * sld + col];
#pragma unroll
        for (int p = 0; p < 16; ++p) tile[(p * 8 + (tid >> 6)) * 65 + (tid & 63)] = v[p];
        __syncthreads();
#pragma unroll
        for (int hh = 0; hh < 2; ++hh) { const int n = tid >> 3, kc = (tid & 7) + 8 * hh; float w[8];
#pragma unroll
          for (int e = 0; e < 8; ++e) w[e] = tile[(kc * 8 + e) * 65 + n];
          *(u32x4*)(dst + (size_t)(tn * 64 + n) * dld + tk * 128 + kc * 8) = (u32x4){pk2(w[0], w[1]), pk2(w[2], w[3]), pk2(w[4], w[5]), pk2(w[6], w[7])}; }
        __syncthreads();
    }
}
DI void conv_fold(LAS unsigned char* lds, const float* win, bf16_t* wint, int item0, int nblk) {
    LAS float* tile = (LAS float*)lds;
    LAS float* tab = (LAS float*)(lds + 64 * 65 * 4);
    LAS bf16_t* outb = (LAS bf16_t*)(lds + 64 * 65 * 4 + 256);
    const int tid = tid_();
    __syncthreads();
    if (tid < 64) tab[tid] = cospif((float)tid / 32.0f);
    for (int it = item0; it < 6 * 16; it += nblk) {
        const int g = it >> 4, tk = it & 15;
        __syncthreads();
#pragma unroll
        for (int p = 0; p < 8; ++p) { const int kk = p * 8 + (tid >> 6); tile[kk * 65 + (tid & 63)] = win[(size_t)(tk * 64 + kk) * IN_COLS + 1280 + g * 64 + (tid & 63)]; }
        __syncthreads();
        const int k = tid & 63, cq = tid >> 6;
        float ac[8], as[8];
#pragma unroll
        for (int e = 0; e < 8; ++e) { ac[e] = 0.f; as[e] = 0.f; }
        for (int c = 0; c < 64; ++c) {
            const float w = tile[k * 65 + c];
#pragma unroll
            for (int e = 0; e < 8; ++e) { const int idx = c * (cq * 8 + e); ac[e] += w * tab[idx & 63]; as[e] += w * tab[(idx - 16) & 63]; }
        }
#pragma unroll
        for (int e = 0; e < 8; ++e) { outb[(cq * 8 + e) * 72 + k] = (bf16_t)(pk2(ac[e], 0.f) & 0xffffu); outb[(64 + cq * 8 + e) * 72 + k] = (bf16_t)(pk2(as[e], 0.f) & 0xffffu); }
        __syncthreads();
        for (int i = tid; i < 128 * 8; i += NTHREADS) { const int rr = i >> 3, ch = i & 7; const int part = rr >> 6, cp = rr & 63;
            *(u32x4*)(wint + (size_t)(2304 + part * 384 + g * 64 + cp) * D + tk * 64 + ch * 8) = *(const LAS u32x4*)(outb + rr * 72 + ch * 8); }
    }
    __syncthreads();
}
DI void conv_win(LAS unsigned char* lds, const Ptrs& P, int l, int item0, int nblk) {
    const float* win = P.in[I_WIN] + (size_t)l * D * IN_COLS;
    convT(lds, win, IN_COLS, D, (bf16_t*)(P.ws + OFF_WINT), D, NIN, MapWin{}, item0, nblk);
    conv_fold(lds, win, (bf16_t*)(P.ws + OFF_WINT), item0, nblk);
}
DI void gen_dft(LAS unsigned char* lds, unsigned char* ws, int item0, int nblk, bool also_small) {
    const int tid = tid_();
    bf16_t* dft = (bf16_t*)(ws + A_DFT);
    for (int it = item0 * NTHREADS + tid; it < 4096 * 512; it += nblk * NTHREADS) {
        const int k = it >> 9, j0 = (it & 511) * 8;
        float v[8];
#pragma unroll
        for (int e = 0; e < 8; ++e) { const int j = j0 + e; const bool sp = j >= 2049; const float fr = (float)((k * (sp ? j - 2048 : j)) & 4095) * (1.0f / 4096.0f); v[e] = sp ? -__builtin_amdgcn_sinf(fr) : __builtin_amdgcn_cosf(fr); }
        *(u32x4*)(dft + (size_t)k * 4096 + j0) = (u32x4){pk2(v[0], v[1]), pk2(v[2], v[3]), pk2(v[4], v[5]), pk2(v[6], v[7])};
    }
    if (also_small) {
        bf16_t* dc = (bf16_t*)(ws + OFF_DFTC);
        for (int it = item0 * NTHREADS + tid; it < 256 * 64; it += nblk * NTHREADS) {
            const int k = it >> 6, j0 = (it & 63) * 8; const int part = j0 >= 256; const int t0 = j0 & 255;
            float v[8];
#pragma unroll
            for (int e = 0; e < 8; ++e) { const float fr = (float)((k * (t0 + e)) & 255) * (1.0f / 256.0f); v[e] = part ? -__builtin_amdgcn_sinf(fr) : __builtin_amdgcn_cosf(fr); }
            *(u32x4*)(dc + (size_t)k * 512 + j0) = (u32x4){pk2(v[0], v[1]), pk2(v[2], v[3]), pk2(v[4], v[5]), pk2(v[6], v[7])};
        }
    }
}
DI void fourier_fold(unsigned char* ws, int item0, int nblk) {
    const int tid = tid_();
    const bf16_t* FT = (const bf16_t*)(ws + A_FT); bf16_t* FTF = (bf16_t*)(ws + A_FTF);
    for (int it = item0 * NTHREADS + tid; it < 1536 * 1024; it += nblk * NTHREADS) {
        const int n = it >> 10, j0 = (it & 1023) * 4;
        const bf16_t* s = FT + (size_t)n * 8192;
        float o[4];
#pragma unroll
        for (int e = 0; e < 4; ++e) { const int j = j0 + e;
            if (j <= 2048) { const float a = bflo((unsigned)s[j]); o[e] = (j == 0 || j == 2048) ? a : a + bflo((unsigned)s[4096 - j]); }
            else { const int t = j - 2048; o[e] = bflo((unsigned)s[4096 + t]) - bflo((unsigned)s[8192 - t]); } }
        *(u32x2*)(FTF + (size_t)n * 4096 + j0) = (u32x2){pk2(o[0], o[1]), pk2(o[2], o[3])};
    }
}

DI void mod_gemv(LAS unsigned char* lds, const Ptrs& P, int item0, int nblk) {
    LAS float* sc = (LAS float*)lds;
    LAS float* red = (LAS float*)(lds + 20480);
    const int tid = tid_();
    __syncthreads();
    for (int i = tid; i < 5 * 1024; i += NTHREADS) { const float v = i < 4096 ? P.in[I_C][i] : P.in[I_CCTX][i - 4096]; sc[i] = v * sigmoidf_(v); }
    __syncthreads();
    float* MOD = (float*)(P.ws + OFF_MOD);
    for (int it = item0; it < 2 * 192; it += nblk) {
        const int l = it / 192, cg32 = it % 192; const int kg = tid >> 5, cl = tid & 31;
        const float* w = P.in[I_WMOD] + (size_t)l * D * 6144 + cg32 * 32 + cl;
        float a[5] = {0.f, 0.f, 0.f, 0.f, 0.f};
        for (int k = kg * 64; k < kg * 64 + 64; ++k) { const float wv = w[(size_t)k * 6144];
#pragma unroll
            for (int r = 0; r < 5; ++r) a[r] += sc[r * 1024 + k] * wv; }
#pragma unroll
        for (int r = 0; r < 5; ++r) red[(kg * 5 + r) * 32 + cl] = a[r];
        __syncthreads();
        if (tid < 160) { const int r = tid >> 5; float s = 0.f;
#pragma unroll
            for (int g = 0; g < 16; ++g) s += red[(g * 5 + r) * 32 + cl];
            MOD[((size_t)l * 5 + r) * 6144 + cg32 * 32 + cl] = s + P.in[I_BMOD][l * 6144 + cg32 * 32 + cl]; }
        __syncthreads();
    }
}

DI void row_mod_store(const f32x4 (&x)[4], float rstd, const float* gain, const float* shift, const float* scale, bf16_t* hrow, int lane) {
#pragma unroll
    for (int i = 0; i < 4; ++i) { const int c = lane * 4 + 256 * i;
        const f32x4 g = *(const f32x4*)(gain + c), sh = *(const f32x4*)(shift + c), sc = *(const f32x4*)(scale + c);
        float o[4];
#pragma unroll
        for (int j = 0; j < 4; ++j) o[j] = x[i][j] * rstd * g[j] * (1.f + sc[j]) + sh[j];
        *(u32x2*)(hrow + c) = (u32x2){pk2(o[0], o[1]), pk2(o[2], o[3])}; }
}
DI float row_rstd(const f32x4 (&x)[4]) {
    float s = 0.f;
#pragma unroll
    for (int i = 0; i < 4; ++i) s += x[i][0] * x[i][0] + x[i][1] * x[i][1] + x[i][2] * x[i][2] + x[i][3] * x[i][3];
    s = wave_sum(s);
    return __builtin_amdgcn_rsqf(s * (1.0f / 1024.0f) + EPS);
}
DI void rows_first(const Ptrs& P) {
    const int tid = tid_(); const int lane = tid & 63, wv = tid >> 6;
    const float* MOD = (const float*)(P.ws + OFF_MOD);
    for (int row = blockIdx.x * 8 + wv; row < MTOT; row += gridDim.x * 8) {
        const float* xr = row < MLAT ? P.in[I_X] + (size_t)row * D : P.in[I_CTX] + (size_t)(row - MLAT) * D;
        const int mr = row < MLAT ? (row >> 12) : 4;
        f32x4 x[4];
#pragma unroll
        for (int i = 0; i < 4; ++i) x[i] = *(const f32x4*)(xr + lane * 4 + 256 * i);
        const float rstd = row_rstd(x);
        const float* mod = MOD + (size_t)mr * 6144;
        row_mod_store(x, rstd, P.in[I_GPREMIX], mod, mod + 1024, (bf16_t*)(P.ws + OFF_HS) + (size_t)row * D, lane);
    }
}
DI void rows_update(const Ptrs& P, int l, int which  , int nrows) {
    const int tid = tid_(); const int lane = tid & 63, wv = tid >> 6;
    const float* MOD = (const float*)(P.ws + OFF_MOD);
    const bf16_t* Y = (const bf16_t*)(P.ws + A_MIXO);
    const float* gpost = P.in[which ? I_GPOSTMLP : I_GPOSTMIX] + l * D;
    const bool do_h = (which == 0) || (l == 0);
    const int ln = which ? l + 1 : l;
    const float* gnext = which ? P.in[I_GPREMIX] + (do_h ? ln : 0) * D : P.in[I_GPREMLP] + l * D;
    for (int row = blockIdx.x * 8 + wv; row < nrows; row += gridDim.x * 8) {
        const bool lat = row < MLAT;
        const float* xin = lat ? ((l == 0 && which == 0) ? P.in[I_X] + (size_t)row * D : P.out + (size_t)row * D)
                               : ((which == 0) ? P.in[I_CTX] + (size_t)(row - MLAT) * D : (const float*)(P.ws + A_XC) + (size_t)(row - MLAT) * D);
        float* xout = lat ? P.out + (size_t)row * D : (float*)(P.ws + A_XC) + (size_t)(row - MLAT) * D;
        const int mr = lat ? (row >> 12) : 4;
        const float* mod = MOD + ((size_t)l * 5 + mr) * 6144;
        const float* gate = mod + (which ? 5 : 2) * 1024;
        f32x4 x[4], y[4];
#pragma unroll
        for (int i = 0; i < 4; ++i) { x[i] = *(const f32x4*)(xin + lane * 4 + 256 * i);
            const u32x2 yb = *(const u32x2*)(Y + (size_t)row * D + lane * 4 + 256 * i); y[i] = (f32x4){bflo(yb[0]), bfhi(yb[0]), bflo(yb[1]), bfhi(yb[1])}; }
        const float ry = row_rstd(y);
#pragma unroll
        for (int i = 0; i < 4; ++i) { const int c = lane * 4 + 256 * i; const f32x4 gp = *(const f32x4*)(gpost + c), gt = *(const f32x4*)(gate + c);
#pragma unroll
            for (int j = 0; j < 4; ++j) x[i][j] += gt[j] * (y[i][j] * ry * gp[j]);
            *(f32x4*)(xout + c) = x[i]; }
        if (do_h) {
            const float rx = row_rstd(x);
            const float* modn = MOD + ((size_t)ln * 5 + mr) * 6144;
            const float* shiftn = which ? modn : modn + 3 * 1024; const float* scalen = which ? modn + 1024 : modn + 4 * 1024;
            row_mod_store(x, rx, gnext, shiftn, scalen, (bf16_t*)(P.ws + OFF_HS) + (size_t)row * D, lane);
        }
    }
}

constexpr int AK_PITCH = 144;
constexpr int AK_BUF = 64 * AK_PITCH;
constexpr int AV_OFF = 2 * AK_BUF;
#define ATT_BAR() do { __builtin_amdgcn_sched_barrier(0); asm volatile("s_waitcnt lgkmcnt(0)" ::: "memory"); __builtin_amdgcn_s_barrier(); asm volatile("" ::: "memory"); __builtin_amdgcn_sched_barrier(0); } while (0)
DI float max3_(float a, float b, float c) { float d; asm("v_max3_f32 %0, %1, %2, %3" : "=v"(d) : "v"(a), "v"(b), "v"(c)); return d; }
template <int NMB, bool NOMAX = false>
DI void flash_pass(LAS unsigned char* lds, const bf16x8 (&qf)[4], const bf16_t* Kg, int ldk, const bf16_t* Vg, int ldv, int ntiles, f32x16 (&O)[NMB], float& lsum) {
    constexpr int VP = NMB == 4 ? 320 : 192;
    constexpr int VBUF = 64 * VP;
    constexpr int VCH = NMB * 4;
    constexpr int VPT = NMB / 2;
    const int tid = tid_(), lane = tid & 63, g = __builtin_amdgcn_readfirstlane(tid >> 8);
    const int r = lane & 31, h = lane >> 5, i16 = lane & 15, q4 = i16 >> 2, p4 = i16 & 3, blk = (lane >> 4) & 1;
    const int kkey = tid >> 3, kch = tid & 7;
    const unsigned kwoff = kkey * AK_PITCH + kch * 16;
    const unsigned vrd = (4 * h + q4) * VP + 32 * blk + 8 * p4;
    const unsigned krd = r * AK_PITCH + 16 * h;
    const bf16_t* kgp = Kg + (size_t)kkey * ldk + kch * 8;
    unsigned vwoff[VPT]; const bf16_t* vgp[VPT];
#pragma unroll
    for (int p = 0; p < VPT; ++p) { const int idx = tid + p * NTHREADS; vwoff[p] = (idx / VCH) * VP + (idx % VCH) * 16; vgp[p] = Vg + (size_t)(idx / VCH) * ldv + (idx % VCH) * 8; }
    float m_run = -1e30f; lsum = 0.f;
#pragma unroll
    for (int mb = 0; mb < NMB; ++mb)
#pragma unroll
        for (int i = 0; i < 16; ++i) O[mb][i] = 0.f;
    u32x4 kreg, vreg[VPT];
    {
        const u32x4 k0 = *(const u32x4*)kgp, k1 = *(const u32x4*)(kgp + (size_t)64 * ldk);
#pragma unroll
        for (int p = 0; p < VPT; ++p) vreg[p] = *(const u32x4*)vgp[p];
        __syncthreads();
        *(LAS u32x4*)(lds + kwoff) = k0; *(LAS u32x4*)(lds + AK_BUF + kwoff) = k1;
#pragma unroll
        for (int p = 0; p < VPT; ++p) *(LAS u32x4*)(lds + AV_OFF + vwoff[p]) = vreg[p];
    }
    __syncthreads();
    kreg = *(const u32x4*)(kgp + (size_t)(ntiles > 2 ? 128 : 0) * ldk);
#pragma unroll
    for (int p = 0; p < VPT; ++p) vreg[p] = *(const u32x4*)(vgp[p] + (size_t)64 * ldv);
    f32x16 S0, S1;
#pragma unroll
    for (int i = 0; i < 16; ++i) { S0[i] = 0.f; S1[i] = 0.f; }
#pragma unroll
    for (int c = 0; c < 4; ++c) {
        const bf16x8 a0 = *(const LAS bf16x8*)(lds + krd + 32 * c);
        const bf16x8 a1 = *(const LAS bf16x8*)(lds + krd + 32 * AK_PITCH + 32 * c);
        S0 = __builtin_amdgcn_mfma_f32_32x32x16_bf16(a0, qf[c], S0, 0, 0, 0);
        S1 = __builtin_amdgcn_mfma_f32_32x32x16_bf16(a1, qf[c], S1, 0, 0, 0);
    }
    if (g == 1) ATT_BAR();
    for (int t = 0; t < ntiles; ++t) {
        const int sv = t + g;
        if (sv >= 1) {
            if (sv < ntiles) {
#pragma unroll
                for (int p = 0; p < VPT; ++p) *(LAS u32x4*)(lds + AV_OFF + (sv & 1) * VBUF + vwoff[p]) = vreg[p]; }
            if (sv + 1 < ntiles) *(LAS u32x4*)(lds + ((sv + 1) & 1) * AK_BUF + kwoff) = kreg;
        }
        if (sv + 1 < ntiles) {
#pragma unroll
            for (int p = 0; p < VPT; ++p) vreg[p] = *(const u32x4*)(vgp[p] + (size_t)(sv + 1) * 64 * ldv); }
        if (sv + 2 < ntiles) kreg = *(const u32x4*)(kgp + (size_t)(sv + 2) * 64 * ldk);
        if constexpr (!NOMAX) {
        float mx = max3_(S0[0], S1[0], S0[1]), mx2 = max3_(S1[1], S0[2], S1[2]);
#pragma unroll
        for (int i = 3; i < 15; i += 2) { mx = max3_(mx, S0[i], S1[i]); mx2 = max3_(mx2, S0[i + 1], S1[i + 1]); }
        mx = max3_(mx, S0[15], S1[15]);
        mx = max3_(mx, mx2, mx2);
        { const u32x2 sw = __builtin_amdgcn_permlane32_swap(__float_as_uint(mx), __float_as_uint(mx), false, false);
          mx = max3_(__uint_as_float(sw[0]), __uint_as_float(sw[1]), m_run); }
        const float m_new = mx;
        if (__builtin_amdgcn_ballot_w64(m_new > m_run) != 0ull) {
            const float alpha = __builtin_amdgcn_exp2f(m_run - m_new);
            lsum *= alpha;
#pragma unroll
            for (int mb = 0; mb < NMB; ++mb)
#pragma unroll
                for (int i = 0; i < 16; ++i) O[mb][i] *= alpha;
            m_run = m_new;
        }
        }
#pragma unroll
        for (int i = 0; i < 16; ++i) { if constexpr (NOMAX) { S0[i] = __builtin_amdgcn_exp2f(S0[i]); S1[i] = __builtin_amdgcn_exp2f(S1[i]); } else { S0[i] = __builtin_amdgcn_exp2f(S0[i] - m_run); S1[i] = __builtin_amdgcn_exp2f(S1[i] - m_run); } }
        f32x2 ps2 = (f32x2){0.f, 0.f};
#pragma unroll
        for (int i = 0; i < 8; ++i) { ps2 += (f32x2){S0[2 * i], S0[2 * i + 1]}; ps2 += (f32x2){S1[2 * i], S1[2 * i + 1]}; }
        lsum += ps2.x + ps2.y;
        bf16x8 pf[4];
#pragma unroll
        for (int cp = 0; cp < 2; ++cp) {
            u32x4 w0, w1;
#pragma unroll
            for (int q = 0; q < 4; ++q) { w0[q] = pk2(S0[8 * cp + 2 * q], S0[8 * cp + 2 * q + 1]); w1[q] = pk2(S1[8 * cp + 2 * q], S1[8 * cp + 2 * q + 1]); }
            pf[cp] = __builtin_bit_cast(bf16x8, w0); pf[2 + cp] = __builtin_bit_cast(bf16x8, w1);
        }
        ATT_BAR();
        {
            const LAS unsigned char* Vb = lds + AV_OFF + (t & 1) * VBUF + vrd;
            const LAS unsigned char* Kb = lds + ((t + 1) & 1) * AK_BUF + krd;
            const bool qk = t + 1 < ntiles;
            bf16x8 kf[8], va[NMB], vb[NMB];
#define ATT_LDV(dst, kc) do { _Pragma("unroll") for (int mb = 0; mb < NMB; ++mb) { \
                const s16x4 lo_ = __builtin_amdgcn_ds_read_tr16_b64_v4i16((LAS s16x4*)(Vb + (16 * (kc)) * VP + 64 * mb)); \
                const s16x4 hi_ = __builtin_amdgcn_ds_read_tr16_b64_v4i16((LAS s16x4*)(Vb + (16 * (kc) + 8) * VP + 64 * mb)); \
                dst[mb] = __builtin_shufflevector(lo_, hi_, 0, 1, 2, 3, 4, 5, 6, 7); } } while (0)
#define ATT_PV(srcv, kc) do { _Pragma("unroll") for (int mb = 0; mb < NMB; ++mb) O[mb] = __builtin_amdgcn_mfma_f32_32x32x16_bf16(srcv[mb], pf[kc], O[mb], 0, 0, 0); } while (0)
            if (qk) {
#pragma unroll
                for (int c = 0; c < 4; ++c) { kf[2 * c] = *(const LAS bf16x8*)(Kb + 32 * c); kf[2 * c + 1] = *(const LAS bf16x8*)(Kb + 32 * AK_PITCH + 32 * c); }
            }
            ATT_LDV(va, 0);
            __builtin_amdgcn_sched_barrier(0);
            if (qk) {
#pragma unroll
                for (int i = 0; i < 16; ++i) { S0[i] = 0.f; S1[i] = 0.f; }
#pragma unroll
                for (int c = 0; c < 4; ++c) {
                    S0 = __builtin_amdgcn_mfma_f32_32x32x16_bf16(kf[2 * c], qf[c], S0, 0, 0, 0);
                    S1 = __builtin_amdgcn_mfma_f32_32x32x16_bf16(kf[2 * c + 1], qf[c], S1, 0, 0, 0);
                }
            }
            ATT_LDV(vb, 1);
            __builtin_amdgcn_sched_barrier(0);
            ATT_PV(va, 0);
            ATT_LDV(va, 2);
            __builtin_amdgcn_sched_barrier(0);
            ATT_PV(vb, 1);
            ATT_LDV(vb, 3);
            __builtin_amdgcn_sched_barrier(0);
            ATT_PV(va, 2);
            ATT_PV(vb, 3);
#undef ATT_LDV
#undef ATT_PV
        }
        ATT_BAR();
    }
    if (g == 0) ATT_BAR();
    lsum += __shfl_xor(lsum, 32);
}

DI void diff_unit(LAS unsigned char* lds, const Ptrs& P, int l, int b, int hd, int qrow0, int key0, int ntiles, float lam, float lam_init) {
    const int tid = tid_(); const int lane = tid & 63, wv = tid >> 6, r = lane & 31, h = lane >> 5;
    bf16_t* BRQ = (bf16_t*)(P.ws + A_BRQ);
    const bf16_t* DK = (const bf16_t*)(P.ws + A_DK) + (size_t)(b * LKV + key0) * 512 + hd * 128;
    const bf16_t* DV = (const bf16_t*)(P.ws + A_DV) + (size_t)(b * LKV + key0) * 512 + hd * 128;
    bf16_t* qp = BRQ + (size_t)(qrow0 + wv * 32 + r) * KBR + 384 + hd * 128;
    bf16x8 q0[4], q1[4];
#pragma unroll
    for (int c = 0; c < 4; ++c) { q0[c] = *(const bf16x8*)(qp + 16 * c + 8 * h); q1[c] = *(const bf16x8*)(qp + 64 + 16 * c + 8 * h); }
    f32x16 O[4]; float l0;
    const unsigned* nrm = (const unsigned*)(P.ws + OFF_CTL) + 32 + 2 * l;
    const float bnd = 2.04f * sqrtf(__uint_as_float(__hip_atomic_load(nrm, __ATOMIC_RELAXED, __HIP_MEMORY_SCOPE_AGENT)) * __uint_as_float(__hip_atomic_load(nrm + 1, __ATOMIC_RELAXED, __HIP_MEMORY_SCOPE_AGENT)));
    const bool small = __builtin_amdgcn_readfirstlane((int)(bnd < 60.0f)) != 0;
    if (small) flash_pass<4, true>(lds, q0, DK, 512, DV, 512, ntiles, O, l0); else
    flash_pass<4>(lds, q0, DK, 512, DV, 512, ntiles, O, l0);
    { const float inv = 1.0f / l0;
#pragma unroll
      for (int mb = 0; mb < 4; ++mb)
#pragma unroll
          for (int g = 0; g < 4; ++g) { const int dv = 32 * mb + 8 * g + 4 * h;
              *(u32x2*)(qp + dv) = (u32x2){pk2(O[mb][4 * g] * inv, O[mb][4 * g + 1] * inv), pk2(O[mb][4 * g + 2] * inv, O[mb][4 * g + 3] * inv)}; } }
    if (small) flash_pass<4, true>(lds, q1, DK + 64, 512, DV, 512, ntiles, O, l0); else
    flash_pass<4>(lds, q1, DK + 64, 512, DV, 512, ntiles, O, l0);
    { const float s1 = lam / l0; float ss = 0.f;
#pragma unroll
      for (int mb = 0; mb < 4; ++mb)
#pragma unroll
          for (int g = 0; g < 4; ++g) { const int dv = 32 * mb + 8 * g + 4 * h; const u32x2 o0 = *(const u32x2*)(qp + dv);
              const float a0 = bflo(o0[0]) - s1 * O[mb][4 * g], a1 = bfhi(o0[0]) - s1 * O[mb][4 * g + 1], a2 = bflo(o0[1]) - s1 * O[mb][4 * g + 2], a3 = bfhi(o0[1]) - s1 * O[mb][4 * g + 3];
              O[mb][4 * g] = a0; O[mb][4 * g + 1] = a1; O[mb][4 * g + 2] = a2; O[mb][4 * g + 3] = a3; ss += a0 * a0 + a1 * a1 + a2 * a2 + a3 * a3; }
      ss += __shfl_xor(ss, 32);
      const float rs = __builtin_amdgcn_rsqf(ss * (1.0f / 128.0f) + EPS) * (1.0f - lam_init);
      const float* sg = P.in[I_SUBLN] + l * 128;
#pragma unroll
      for (int mb = 0; mb < 4; ++mb)
#pragma unroll
          for (int g = 0; g < 4; ++g) { const int dv = 32 * mb + 8 * g + 4 * h; const f32x4 gg = *(const f32x4*)(sg + dv);
              *(u32x2*)(qp + dv) = (u32x2){pk2(O[mb][4 * g] * rs * gg[0], O[mb][4 * g + 1] * rs * gg[1]), pk2(O[mb][4 * g + 2] * rs * gg[2], O[mb][4 * g + 3] * rs * gg[3])}; }
    }
}
DI void gqa_unit(LAS unsigned char* lds, const Ptrs& P, int l, int b, int qh, int qrow0, int key0, int ntiles) {
    const int tid = tid_(); const int lane = tid & 63, wv = tid >> 6, r = lane & 31, h = lane >> 5;
    bf16_t* BRQ = (bf16_t*)(P.ws + A_BRQ);
    const int kvh = qh >> 2;
    const bf16_t* GK = (const bf16_t*)(P.ws + A_GK) + (size_t)(b * LKV + key0) * 128 + kvh * 64;
    const bf16_t* GV = (const bf16_t*)(P.ws + A_GV) + (size_t)(b * LKV + key0) * 128 + kvh * 64;
    bf16_t* qp = BRQ + (size_t)(qrow0 + wv * 32 + r) * KBR + 896 + qh * 64;
    bf16x8 q0[4];
#pragma unroll
    for (int c = 0; c < 4; ++c) q0[c] = *(const bf16x8*)(qp + 16 * c + 8 * h);
    f32x16 O[2]; float l0;
    float mq = fabsf(P.in[I_QNORM][l * 64 + lane]), mk = fabsf(P.in[I_KNORM][l * 64 + lane]);
#pragma unroll
    for (int o = 32; o >= 1; o >>= 1) { mq = fmaxf(mq, __shfl_xor(mq, o)); mk = fmaxf(mk, __shfl_xor(mk, o)); }
    const bool small = __builtin_amdgcn_readfirstlane((int)(64.0f * QSCALE * 1.02f * mq * mk < 60.0f)) != 0;
    if (small) flash_pass<2, true>(lds, q0, GK, 128, GV, 128, ntiles, O, l0);
    else flash_pass<2, false>(lds, q0, GK, 128, GV, 128, ntiles, O, l0);
    const float inv = 1.0f / l0;
#pragma unroll
    for (int mb = 0; mb < 2; ++mb)
#pragma unroll
        for (int g = 0; g < 4; ++g) { const int dv = 32 * mb + 8 * g + 4 * h;
            *(u32x2*)(qp + dv) = (u32x2){pk2(O[mb][4 * g] * inv, O[mb][4 * g + 1] * inv), pk2(O[mb][4 * g + 2] * inv, O[mb][4 * g + 3] * inv)}; }
}

DI void conv_unit(LAS unsigned char* lds, const Ptrs& P, int l, int m0, int s0, int Ls) {
    const int tid = tid_(), lane = tid & 63, wv = tid >> 6;
    LAS bf16_t* vs = (LAS bf16_t*)lds;
    LAS float* wsm = (LAS float*)(lds + 94 * 384 * 2);
    const bf16_t* V = (const bf16_t*)(P.ws + A_V);
    __syncthreads();
    for (int idx = tid; idx < 94 * 48; idx += NTHREADS) { const int rr = idx / 48, ch = idx % 48; const int row = m0 - 15 + rr;
        u32x4 v = (u32x4){0u, 0u, 0u, 0u};
        if (row >= s0 && row < s0 + Ls) v = *(const u32x4*)(V + (size_t)row * 384 + ch * 8);
        *(LAS u32x4*)(vs + rr * 384 + ch * 8) = v; }
    const float* dw = P.in[I_CONVDW] + (size_t)l * 31 * 384;
    for (int idx = tid; idx < 31 * 384; idx += NTHREADS) wsm[idx] = dw[idx];
    __syncthreads();
    const float* bias = P.in[I_CONVB] + l * 384; const float* lg = P.in[I_CONVLNG] + l * 384; const float* lb = P.in[I_CONVLNB] + l * 384;
    const int c0 = lane * 6;
    bf16_t* BRQ = (bf16_t*)(P.ws + A_BRQ);
    float a[8][6];
#pragma unroll
    for (int tt = 0; tt < 8; ++tt)
#pragma unroll
        for (int c = 0; c < 6; ++c) a[tt][c] = bias[c0 + c];
    const LAS bf16_t* vbase = vs + (wv * 8) * 384 + c0;
#pragma unroll 1
    for (int j = 0; j < 31; ++j) {
        const LAS float* wp = wsm + j * 384 + c0;
        const f32x2 w01 = *(const LAS f32x2*)wp, w23 = *(const LAS f32x2*)(wp + 2), w45 = *(const LAS f32x2*)(wp + 4);
#pragma unroll
        for (int tt = 0; tt < 8; ++tt) {
            const LAS unsigned* vp = (const LAS unsigned*)(vbase + (tt + j) * 384);
            const unsigned v0 = vp[0], v1 = vp[1], v2 = vp[2];
            a[tt][0] += w01.x * bflo(v0); a[tt][1] += w01.y * bfhi(v0); a[tt][2] += w23.x * bflo(v1); a[tt][3] += w23.y * bfhi(v1); a[tt][4] += w45.x * bflo(v2); a[tt][5] += w45.y * bfhi(v2);
        }
    }
    float lgv[6], lbv[6];
#pragma unroll
    for (int c = 0; c < 6; ++c) { lgv[c] = lg[c0 + c]; lbv[c] = lb[c0 + c]; }
#pragma unroll
    for (int tt = 0; tt < 8; ++tt) {
        float s = a[tt][0] + a[tt][1] + a[tt][2] + a[tt][3] + a[tt][4] + a[tt][5];
        s = wave_sum(s);
        const float mu = s * (1.0f / 384.0f);
        float q = 0.f;
#pragma unroll
        for (int c = 0; c < 6; ++c) { const float d = a[tt][c] - mu; q += d * d; }
        q = wave_sum(q);
        const float rs = __builtin_amdgcn_rsqf(q * (1.0f / 384.0f) + EPS);
        float o[6];
#pragma unroll
        for (int c = 0; c < 6; ++c) { const float y = (a[tt][c] - mu) * rs * lgv[c] + lbv[c]; o[c] = y * sigmoidf_(y); }
        unsigned* dst = (unsigned*)(BRQ + (size_t)(m0 + wv * 8 + tt) * KBR + 1408 + c0);
        dst[0] = pk2(o[0], o[1]); dst[1] = pk2(o[2], o[3]); dst[2] = pk2(o[4], o[5]);
    }
}


#define XB_TMO      128
#define XB_XCNT(j)  (256  + 64 * (j))
#define XB_XSUB(j)  (1280 + 64 * (j))
#define XB_XGEN(j)  (2304 + 64 * (j))
#define XB_TOP      3328
#define XB_TOPGEN   3392
#define XCD_BAR_WORDS 3456
#define XB_SPIN_CAP (1u << 20)
DI unsigned xb_ld(unsigned* p)              { return __hip_atomic_load(p, __ATOMIC_RELAXED, __HIP_MEMORY_SCOPE_AGENT); }
DI unsigned xb_add(unsigned* p, unsigned v) { return __hip_atomic_fetch_add(p, v, __ATOMIC_RELAXED, __HIP_MEMORY_SCOPE_AGENT); }
DI unsigned xb_xcc_id() { return (unsigned)__builtin_amdgcn_s_getreg((3 << 11) | 20) & 0xFu; }
#define XB_SPIN(cond, bar) do { unsigned _sp = 0; while (cond) { __builtin_amdgcn_s_sleep(1); \
    if ((++_sp & 255u) == 0u) { if (xb_ld(&(bar)[XB_TMO])) break; if (_sp > XB_SPIN_CAP) { atomicAdd(&(bar)[XB_TMO], 1u); break; } } } } while (0)
struct XcdBarrier { unsigned* bar; unsigned x; volatile LAS unsigned* st; };
DI XcdBarrier xcd_barrier_post(unsigned* bar, volatile LAS unsigned* st) {
    XcdBarrier b; b.bar = bar; b.x = xb_xcc_id(); b.st = st;
    if (threadIdx.x == 0) (void)xb_add(&bar[XB_XCNT(b.x)], 1u);
    return b;
}
DI void xcd_barrier_complete(unsigned* bar, unsigned x, unsigned& nloc, unsigned& nx) {
    const unsigned G = gridDim.x * gridDim.y * gridDim.z;
    unsigned sum, cnt, mine, sp = 0u;
    for (;;) {
        sum = 0u; cnt = 0u; mine = 0u;
#pragma unroll
        for (unsigned j = 0; j < 16; ++j) { const unsigned c = xb_ld(&bar[XB_XCNT(j)]); sum += c; cnt += (c > 0u) ? 1u : 0u; mine = (j == x) ? c : mine; }
        if (sum == G) break;
        __builtin_amdgcn_s_sleep(1);
        if ((++sp & 255u) == 0u) { if (xb_ld(&bar[XB_TMO])) break; if (sp > XB_SPIN_CAP) { atomicAdd(&bar[XB_TMO], 1u); break; } }
    }
    nloc = mine > 0u ? mine : 1u; nx = cnt > 0u ? cnt : 1u;
}
DI void xcd_barrier(const XcdBarrier& b) {
    asm volatile("s_waitcnt vmcnt(0)" ::: "memory");
    __syncthreads();
    if (threadIdx.x == 0) {
        unsigned* bar = b.bar;
        __builtin_amdgcn_s_waitcnt(0);
        unsigned nloc = b.st[0], nx = b.st[1];
        if (nloc == 0u) { xcd_barrier_complete(bar, b.x, nloc, nx); b.st[0] = nloc; b.st[1] = nx; }
        const unsigned old = xb_add(&bar[XB_XSUB(b.x)], 1u);
        const unsigned gen = old / nloc;
        if (old + 1u == (gen + 1u) * nloc) {
            __builtin_amdgcn_fence(__ATOMIC_RELEASE, "agent");
            asm volatile("s_waitcnt vmcnt(0)" ::: "memory");
            const unsigned og = xb_add(&bar[XB_TOP], 1u);
            const unsigned tg = og / nx;
            if (og + 1u == (tg + 1u) * nx) xb_add(&bar[XB_TOPGEN], 1u);
            else XB_SPIN(xb_ld(&bar[XB_TOPGEN]) == tg, bar);
            __builtin_amdgcn_fence(__ATOMIC_ACQUIRE, "agent");
            xb_add(&bar[XB_XGEN(b.x)], 1u);
            asm volatile("s_waitcnt vmcnt(0)" ::: "memory");
        } else {
            XB_SPIN(xb_ld(&bar[XB_XGEN(b.x)]) == gen, bar);
            __builtin_amdgcn_fence(__ATOMIC_ACQUIRE, "agent");
            asm volatile("s_waitcnt vmcnt(0)" ::: "memory");
        }
    }
    __syncthreads();
}

struct KArgs { Ptrs p; int ph_lo, ph_hi; };

__global__ void __launch_bounds__(NTHREADS, 2) fwd_mega(KArgs args) {
    extern __shared__ __attribute__((aligned(16))) unsigned char lds_raw[];
    LAS unsigned char* lds = (LAS unsigned char*)lds_raw;
    cg::grid_group grid = cg::this_grid();
    const Ptrs& P = args.p;
    unsigned char* ws = P.ws;
    const int tid = threadIdx.x, bid = blockIdx.x, G = gridDim.x;
    unsigned* ctl = (unsigned*)(ws + OFF_CTL);
    float* misc = (float*)(ws + OFF_MISC);
    int ph = 0;
    if (args.ph_hi < 0) grid.sync();
    volatile LAS unsigned* xst = (volatile LAS unsigned*)(lds + 131072 + 16);
    if (tid == 0) { xst[0] = 0u; xst[1] = 0u; }
    __syncthreads();
    { const XcdBarrier xb0 = xcd_barrier_post((unsigned*)(ws + OFF_BAR), xst); if (tid == 0) xst[2] = xb0.x; }
    __syncthreads();
#define PHASE_BEGIN if (ph >= args.ph_lo && ph < args.ph_hi) {
#define PHASE_END(dosync_) if ((dosync_) && ph + 1 < args.ph_hi) { XcdBarrier xb_; xb_.bar = (unsigned*)(args.p.ws + OFF_BAR); xb_.st = (volatile LAS unsigned*)(lds + 131072 + 16); xb_.x = xb_.st[2]; xcd_barrier(xb_); } } ++ph;

    PHASE_BEGIN
        if (bid == 0) {
            if (tid < 64) ctl[tid] = 0u;
            if (tid < 2) { const float* lv = P.in[I_LAMBDA] + tid * 256; float s0 = 0.f, s1 = 0.f;
                for (int i = 0; i < 64; ++i) { s0 += lv[i] * lv[64 + i]; s1 += lv[128 + i] * lv[192 + i]; }
                const float li = 0.8f - 0.6f * expf(-0.3f * (float)tid);
                misc[tid * 2] = expf(s0) - expf(s1) + li; misc[tid * 2 + 1] = li; }
            for (int i = tid; i < 64 * 16; i += NTHREADS) { const int pos = i >> 4, f = i & 15; const float inv = powf(10000.0f, -(float)f / 16.0f); const float ang = (float)pos * inv;
                ((f32x2*)(ws + OFF_ROPE))[i] = (f32x2){cosf(ang), sinf(ang)}; }
        }
        mod_gemv(lds, P, bid, G);
        conv_win(lds, P, 0, bid, G);
        gen_dft(lds, ws, bid, G, true);
    PHASE_END(true)
    PHASE_BEGIN
        rows_first(P);
    PHASE_END(true)

    for (int l = 0; l < 2; ++l) {
        const int nMt = l == 0 ? 68 : 64;
        PHASE_BEGIN
            RectSched S{(const char*)(ws + OFF_HS), (const char*)(ws + OFF_WINT), (size_t)256 * D * 2, (size_t)256 * D * 2, 16, G, bid, nMt, 15, 64, l == 0 ? 0 : 4, 5};
            EpiInA E{ws, P.in[I_QNORM] + l * 64, P.in[I_KNORM] + l * 64, lds + 131072 + 256, ctl + 32 + 2 * l};
            pg8::gemm_phase(lds, D, D, S, E);
        PHASE_END(true)
        PHASE_BEGIN
            fourier_fold(ws, bid, G);
        PHASE_END(true)
        PHASE_BEGIN
            if (bid < 96) {
                OneSched S; S.have = true; S.u.pm = bid & 15; S.u.pn = bid >> 4; S.u.nt = 64;
                S.u.A = (const char*)(ws + A_DFT) + (size_t)S.u.pm * 256 * 4096 * 2; S.u.B = (const char*)(ws + A_FTF) + (size_t)S.u.pn * 256 * 4096 * 2;
                EpiFourier E{(bf16_t*)(ws + A_BRQ), 0, SEQ, 1.0f / 512.0f};
                pg8::gemm_phase(lds, 4096, 4096, S, E);
            } else if (l == 0 && bid < 102) {
                OneSched S; S.have = true; S.u.pm = 0; S.u.pn = bid - 96; S.u.nt = 8;
                S.u.A = (const char*)(ws + OFF_DFTC); S.u.B = (const char*)(ws + A_FTC) + (size_t)S.u.pn * 256 * 512 * 2;
                EpiFourier E{(bf16_t*)(ws + A_BRQ), MLAT, LC, 1.0f / 128.0f};
                pg8::gemm_phase(lds, 512, 512, S, E);
            }
            {
                const float lam = misc[l * 2], lam_init = misc[l * 2 + 1];
                const int n_diff = 32, n_gqa = 64, n_cd = l == 0 ? 2 : 0, n_cg = l == 0 ? 4 : 0, n_conv = l == 0 ? 34 : 32;
                const int total = n_diff + n_gqa + n_cd + n_cg + n_conv;
                volatile LAS int* slot = (volatile LAS int*)(lds + 131072);
                for (int dx = 0; dx < 8; ++dx) {
                    const int x = (bid + dx) & 7;
                    for (;;) {
                        __syncthreads();
                        if (tid == 0) *slot = (int)atomicAdd(ctl + l * 8 + x, 1u);
                        __syncthreads();
                        int it = *slot;
                        if (it >= total) break;
                        if (it < n_diff) { const int pi = 2 * x + (it >> 4), b = pi >> 2, hd = pi & 3, qb = it & 15; diff_unit(lds, P, l, b, hd, b * SEQ + qb * 256, 0, LKV / 64, lam, lam_init); continue; }
                        it -= n_diff;
                        if (it < n_gqa) { const int b = x >> 1, qh = (x & 1) * 4 + (it >> 4), qb = it & 15; gqa_unit(lds, P, l, b, qh, b * SEQ + qb * 256, 0, LKV / 64); continue; }
                        it -= n_gqa;
                        if (it < n_cd) { const int pi = 2 * x + it, b = pi >> 2, hd = pi & 3; diff_unit(lds, P, l, b, hd, MLAT + b * LC, SEQ, LC / 64, lam, lam_init); continue; }
                        it -= n_cd;
                        if (it < n_cg) { const int b = x >> 1, qh = (x & 1) * 4 + it; gqa_unit(lds, P, l, b, qh, MLAT + b * LC, SEQ, LC / 64); continue; }
                        it -= n_cg;
                        { const int m0 = (x * n_conv + it) * 64; int s0, Ls; if (m0 < MLAT) { s0 = m0 & ~4095; Ls = SEQ; } else { s0 = MLAT + ((m0 - MLAT) & ~255); Ls = LC; }
                          conv_unit(lds, P, l, m0, s0, Ls); }
                    }
                }
                __syncthreads();
            }
        PHASE_END(true)
        PHASE_BEGIN
            {
                bf16_t* wbr = (bf16_t*)(ws + A_WBRT);
                convT(lds, P.in[I_WBRF] + (size_t)l * 384 * D, D, 384, wbr, KBR, D, MapId{0}, bid, G);
                convT(lds, P.in[I_WBRD] + (size_t)l * 512 * D, D, 512, wbr + 384, KBR, D, MapId{0}, (bid + 48) % G, G);
                convT(lds, P.in[I_WBRG] + (size_t)l * 512 * D, D, 512, wbr + 896, KBR, D, MapId{0}, (bid + 112) % G, G);
                convT(lds, P.in[I_WBRC] + (size_t)l * 384 * D, D, 384, wbr + 1408, KBR, D, MapId{0}, (bid + 176) % G, G);
                convT(lds, P.in[I_WOUT] + (size_t)l * D * D, D, D, (bf16_t*)(ws + A_WOUTT), D, D, MapId{0}, (bid + 224) % G, G);
                __syncthreads();
            }
            RectSched S{(const char*)(ws + OFF_HS), (const char*)(ws + OFF_WINT) + (size_t)3840 * D * 2, (size_t)256 * D * 2, (size_t)256 * D * 2, 16, G, bid, nMt, 16, 0, 0, 0};
            EpiBf16<1> E{(bf16_t*)(ws + A_G), 4096};
            pg8::gemm_phase(lds, D, D, S, E);
        PHASE_END(true)
        PHASE_BEGIN
            RectSched S{(const char*)(ws + A_BRQ), (const char*)(ws + A_WBRT), (size_t)256 * KBR * 2, (size_t)256 * KBR * 2, 28, G, bid, nMt, 4, 0, 0, 0};
            EpiBranch E{(const bf16_t*)(ws + A_G), (bf16_t*)(ws + OFF_HS)};
            pg8::gemm_phase(lds, KBR, KBR, S, E);
        PHASE_END(true)
        PHASE_BEGIN
            RectSched S{(const char*)(ws + OFF_HS), (const char*)(ws + A_WOUTT), (size_t)256 * D * 2, (size_t)256 * D * 2, 16, G, bid, nMt, 4, 0, 0, 0};
            EpiBf16<0> E{(bf16_t*)(ws + A_MIXO), D};
            pg8::gemm_phase(lds, D, D, S, E);
        PHASE_END(true)
        PHASE_BEGIN
            rows_update(P, l, 0, l == 0 ? MTOT : MLAT);
            convT(lds, P.in[I_WFF1] + (size_t)l * D * DFF, DFF, D, (bf16_t*)(ws + A_WFF1T), D, DFF, MapId{0}, bid, G);
            convT(lds, P.in[I_WFF2] + (size_t)l * DFF * D, D, DFF, (bf16_t*)(ws + A_WFF2T), DFF, D, MapId{0}, bid, G);
        PHASE_END(true)
        PHASE_BEGIN
            RectSched S{(const char*)(ws + OFF_HS), (const char*)(ws + A_WFF1T), (size_t)256 * D * 2, (size_t)256 * D * 2, 16, G, bid, nMt, 16, 0, 0, 0};
            EpiBf16<2> E{(bf16_t*)(ws + A_FF), DFF};
            pg8::gemm_phase(lds, D, D, S, E);
        PHASE_END(true)
        PHASE_BEGIN
            RectSched S{(const char*)(ws + A_FF), (const char*)(ws + A_WFF2T), (size_t)256 * DFF * 2, (size_t)256 * DFF * 2, 64, G, bid, nMt, 4, 0, 0, 0};
            EpiBf16<0> E{(bf16_t*)(ws + A_MIXO), D};
            pg8::gemm_phase(lds, DFF, DFF, S, E);
        PHASE_END(true)
        PHASE_BEGIN
            rows_update(P, l, 1, l == 0 ? MTOT : MLAT);
            if (l == 0) { conv_win(lds, P, 1, bid, G); gen_dft(lds, ws, bid, G, false); }
        PHASE_END(l == 0)
    }
}

extern "C" void kernel_launch(void* const* d_in, const int* in_sizes, int n_in, void* d_out, int out_size, void* d_ws, size_t ws_size, hipStream_t stream) {
    static int grid = 0;
    if (grid == 0) {
        if (n_in != 26 || ws_size < WS_END) { fprintf(stderr, "kernel_launch: unexpected inputs (%d) or workspace (%zu < %zu)\n", n_in, ws_size, (size_t)WS_END); grid = -1; return; }
        int dev = 0, cus = 0, per_cu = 0;
        (void)hipGetDevice(&dev);
        (void)hipDeviceGetAttribute(&cus, hipDeviceAttributeMultiprocessorCount, dev);
        if (hipFuncSetAttribute((const void*)fwd_mega, hipFuncAttributeMaxDynamicSharedMemorySize, LDS_BYTES) != hipSuccess) { fprintf(stderr, "hipFuncSetAttribute failed\n"); grid = -1; return; }
        if (hipOccupancyMaxActiveBlocksPerMultiprocessor(&per_cu, (const void*)fwd_mega, NTHREADS, LDS_BYTES) != hipSuccess || per_cu < 1) { fprintf(stderr, "occupancy query: %d\n", per_cu); per_cu = 1; }
        (void)hipGetLastError();
        grid = cus * per_cu;
        if (grid > 256) grid = 256;
    }
    if (grid < 0) return;
    KArgs a{};
    for (int i = 0; i < 26; ++i) a.p.in[i] = (const float*)d_in[i];
    a.p.out = (float*)d_out; a.p.ws = (unsigned char*)d_ws;
#ifndef PROBE_RANGES
#define PROBE_RANGES {0, 1000}
#endif
    static const int ranges[][2] = { PROBE_RANGES };
    const int nr = (int)(sizeof(ranges) / sizeof(ranges[0]));
    for (int i = 0; i < nr; ++i) {
        if (i > 0) (void)hipMemsetAsync((char*)d_ws + OFF_CTL, 0, 256, stream);
        (void)hipMemsetAsync((char*)d_ws + OFF_BAR, 0, 16384, stream);
        a.ph_lo = ranges[i][0]; a.ph_hi = ranges[i][1];
        void* kargs[] = {&a};
        hipError_t e = hipLaunchCooperativeKernel((const void*)fwd_mega, dim3(grid), dim3(NTHREADS), kargs, LDS_BYTES, stream);
        if (e != hipSuccess) fprintf(stderr, "cooperative launch failed: %s (grid %d)\n", hipGetErrorString(e), grid);
    }
}
```

```cpp
#include <hip/hip_runtime.h>
#include <hip/hip_cooperative_groups.h>
#include <cstdint>
#include <cstdio>
namespace cg = cooperative_groups;

#define LAS __attribute__((address_space(3)))
#define DI __device__ __forceinline__
typedef unsigned short bf16_t;
typedef short bf16x8 __attribute__((ext_vector_type(8)));
typedef short s16x4 __attribute__((ext_vector_type(4)));
typedef float f32x4 __attribute__((ext_vector_type(4)));
typedef float f32x2 __attribute__((ext_vector_type(2)));
typedef float f32x16 __attribute__((ext_vector_type(16)));
typedef unsigned u32x4 __attribute__((ext_vector_type(4)));
typedef unsigned u32x2 __attribute__((ext_vector_type(2)));
typedef __bf16 bf16x2_t __attribute__((ext_vector_type(2)));

DI unsigned pk2(float lo, float hi) { f32x2 v = {lo, hi}; return __builtin_bit_cast(unsigned, __builtin_convertvector(v, bf16x2_t)); }
DI float bflo(unsigned u) { return __uint_as_float(u << 16); }
DI float bfhi(unsigned u) { return __uint_as_float(u & 0xffff0000u); }
DI float sigmoidf_(float x) { return __builtin_amdgcn_rcpf(1.0f + __builtin_amdgcn_exp2f(-1.44269504f * x)); }
DI int tid_() { int t = threadIdx.x; asm volatile("" : "+v"(t)); return t; }
DI float wave_sum(float v) {
#pragma unroll
    for (int o = 32; o >= 1; o >>= 1) v += __shfl_xor(v, o);
    return v;
}

constexpr int D = 1024, NB = 4, SEQ = 4096, LC = 256, MLAT = NB * SEQ, MCTX = NB * LC, MTOT = MLAT + MCTX, LKV = SEQ + LC;
constexpr int IN_COLS = 7552, NIN = 7936, DFF = 4096, KBR = 1792;
constexpr float EPS = 1e-6f;
constexpr float QSCALE = 0.125f * 1.44269504f;
enum { I_X = 0, I_C, I_CTX, I_CCTX, I_WMOD, I_BMOD, I_GPREMIX, I_GPOSTMIX, I_GPREMLP, I_GPOSTMLP, I_WIN, I_QNORM, I_KNORM, I_LAMBDA, I_SUBLN,
       I_CONVDW, I_CONVB, I_CONVLNG, I_CONVLNB, I_WBRF, I_WBRD, I_WBRG, I_WBRC, I_WOUT, I_WFF1, I_WFF2 };

constexpr size_t OFF_CTL = 0, OFF_MISC = 4096, OFF_MOD = 8192, OFF_ROPE = 253952, OFF_DFTC = 262144, OFF_HS = 524288;
constexpr size_t OFF_WINT = OFF_HS + (size_t)MTOT * D * 2;
constexpr size_t ARENA = OFF_WINT + (size_t)NIN * D * 2;
constexpr size_t A_BRQ = ARENA, A_MIXO = ARENA;
constexpr size_t A_G = ARENA + (size_t)MTOT * KBR * 2;
constexpr size_t A_DFT = A_G;
constexpr size_t A_FTF = A_DFT + (size_t)4096 * 4096 * 2;
constexpr size_t A_FT = A_DFT + (size_t)4096 * 8192 * 2;
constexpr size_t A_FTC = A_FT + (size_t)NB * 384 * 8192 * 2;
constexpr size_t A_DK = A_FTC + (size_t)NB * 384 * 512 * 2;
constexpr size_t A_DV = A_DK + (size_t)MTOT * 512 * 2;
constexpr size_t A_GK = A_DV + (size_t)MTOT * 512 * 2;
constexpr size_t A_GV = A_GK + (size_t)MTOT * 128 * 2;
constexpr size_t A_V = A_GV + (size_t)MTOT * 128 * 2;
constexpr size_t A_VEND = A_V + (size_t)MTOT * 384 * 2;
constexpr size_t A_WBRT = A_G + (size_t)MTOT * 4096 * 2;
constexpr size_t A_WOUTT = A_WBRT + (size_t)D * KBR * 2;
constexpr size_t A_FF = ARENA + (size_t)MTOT * D * 2;
constexpr size_t A_WFF1T = A_FF + (size_t)MTOT * DFF * 2;
constexpr size_t A_WFF2T = A_WFF1T + (size_t)DFF * D * 2;
constexpr size_t A_XC = A_WFF2T + (size_t)DFF * D * 2;
constexpr size_t OFF_BAR = A_VEND;
constexpr size_t WS_END = OFF_BAR + 16384;
static_assert(A_XC + (size_t)MCTX * D * 4 <= A_WBRT, "xc overlaps");
static_assert(A_WOUTT + (size_t)D * D * 2 <= WS_END, "ws end");
static_assert(WS_END <= 268435456ull, "workspace too large");

constexpr int LDS_BYTES = 131072 + 256 + 18432;
constexpr int NTHREADS = 512;

namespace pg8 {
constexpr int BM = 256, BK = 64, HALF = 128, HTB = HALF * BK * 2, NXCD = 8, WGM = 8;
DI int lds_byte(int r, int c) { const int st = (r >> 4) * 2 + (c >> 5), rr = r & 15, cc = c & 31, ob = rr * 64 + cc * 2; return st * 1024 + (ob ^ (((ob >> 9) & 1) << 5)); }
DI void stage_rc(int b, int& R, int& C) { const int st = b / 1024, sb = b % 1024, swz = sb ^ (((sb >> 9) & 1) << 5); R = (st >> 1) * 16 + swz / 64; C = (st & 1) * 32 + (swz % 64) / 2; }
DI int perm32(int rho) { const int n = rho >> 4, i = rho & 15; return 8 * (i >> 2) + 4 * n + (i & 3); }

struct Unit { const char* A; const char* B; int nt, pm, pn; };

DI void rect_map(int L, int nM, int nN, int& pm, int& pn) {
    const int nwg = nM * nN; int wgid = L;
    { const int q = nwg / NXCD, r = nwg % NXCD, xcd = wgid % NXCD, off = wgid / NXCD; wgid = (xcd < r ? xcd * (q + 1) : r * (q + 1) + (xcd - r) * q) + off; }
    const int nig = WGM * nN, gid = wgid / nig, fm = gid * WGM, gsz = (nM - fm) < WGM ? (nM - fm) : WGM;
    pm = fm + ((wgid % nig) % gsz); pn = (wgid % nig) / gsz;
}

template <class Epi, class Sched>
DI void gemm_phase(LAS unsigned char* lds, const int lda, const int ldb, const Sched& S, const Epi& E) {
    int tid = threadIdx.x; asm volatile("" : "+v"(tid));
    const int wid = __builtin_amdgcn_readfirstlane(tid >> 6), lane = tid & 63, wr = wid >> 2, wc = wid & 3, fr = lane & 15, fq = lane >> 4;
    unsigned voffA[2], voffB[2];
#pragma unroll
    for (int i = 0; i < 2; ++i) { int R, C; stage_rc(tid * 16 + i * 8192, R, C); const int Rb = Epi::PERM ? ((R & ~31) + perm32(R & 31)) : R;
        voffA[i] = (unsigned)(R * lda + C) * 2u; voffB[i] = (unsigned)(Rb * ldb + C) * 2u; }
    const size_t kstep = (size_t)(BK * 2);
    const size_t hstepA = (size_t)HALF * lda * 2, hstepB = (size_t)HALF * ldb * 2;
    const unsigned ldsw = (unsigned)wid * 1024u;
    const int aoff = lds_byte(wr * 64 + fr, fq * 8), boff = lds_byte(wc * 32 + fr, fq * 8);
#define PG8_SA(b, h) (((b) * 2 + (h)) * HTB)
#define PG8_SB(b, h) ((4 + (b) * 2 + (h)) * HTB)
#define PG8_STAGE(bufoff, gbase, voff) do { _Pragma("unroll") for (int _i = 0; _i < 2; ++_i) \
        __builtin_amdgcn_global_load_lds((const unsigned*)((const char*)(gbase) + (voff)[_i]), (LAS unsigned*)(lds + (bufoff) + ldsw + _i * 8192), 16, 0, 0); } while (0)
#define PG8_LDA(dst, b, h) do { _Pragma("unroll") for (int m = 0; m < 4; ++m) _Pragma("unroll") for (int k = 0; k < 2; ++k) dst[m][k] = *(const LAS bf16x8*)(lds + PG8_SA(b, h) + aoff + m * 2048 + k * 1024); } while (0)
#define PG8_LDB(dst, b, h) do { _Pragma("unroll") for (int n = 0; n < 2; ++n) _Pragma("unroll") for (int k = 0; k < 2; ++k) dst[n][k] = *(const LAS bf16x8*)(lds + PG8_SB(b, h) + boff + n * 2048 + k * 1024); } while (0)
#define PG8_MMA(ai, bj, At, Bt) do { __builtin_amdgcn_s_setprio(1); _Pragma("unroll") for (int m = 0; m < 4; ++m) _Pragma("unroll") for (int n = 0; n < 2; ++n) _Pragma("unroll") for (int k = 0; k < 2; ++k) \
        acc[ai][bj][m][n] = __builtin_amdgcn_mfma_f32_16x16x32_bf16(Bt[n][k], At[m][k], acc[ai][bj][m][n], 0, 0, 0); __builtin_amdgcn_s_setprio(0); } while (0)
#define PG8_WAIT_V(n) asm volatile("s_waitcnt vmcnt(" #n ")" ::: "memory")
#define PG8_WAIT_L(n) asm volatile("s_waitcnt lgkmcnt(" #n ")" ::: "memory")
#define PG8_BAR __builtin_amdgcn_s_barrier()
#define PG8_SCHED __builtin_amdgcn_sched_barrier(0)
    Unit cur, nxt; int ui = 0;
    if (!S.next(0, cur)) return;
    f32x4 acc[2][2][4][2];
#pragma unroll
    for (int a = 0; a < 2; ++a)
#pragma unroll
        for (int b = 0; b < 2; ++b)
#pragma unroll
            for (int m = 0; m < 4; ++m)
#pragma unroll
                for (int n = 0; n < 2; ++n) acc[a][b][m][n] = (f32x4){0.f, 0.f, 0.f, 0.f};
    bf16x8 At[4][2], B0[2][2], B1[2][2];
    const char* cA = cur.A; const char* cB = cur.B;
    PG8_STAGE(PG8_SB(0, 0), cB, voffB); PG8_STAGE(PG8_SB(0, 1), cB + hstepB, voffB); PG8_STAGE(PG8_SA(0, 0), cA, voffA); PG8_STAGE(PG8_SA(0, 1), cA + hstepA, voffA);
    if (wr == 1) PG8_BAR;
    PG8_WAIT_V(2); PG8_BAR;
    PG8_STAGE(PG8_SB(1, 0), cB + kstep, voffB); PG8_STAGE(PG8_SA(1, 0), cA + kstep, voffA); PG8_STAGE(PG8_SB(1, 1), cB + hstepB + kstep, voffB);
    PG8_WAIT_V(6); PG8_BAR;
    for (;;) {
        const bool has_next = S.next(ui + 1, nxt);
        const char* nA = has_next ? nxt.A : cA; const char* nB = has_next ? nxt.B : cB;
        const int nt = cur.nt;
        for (int t = 0; t < nt; t += 2) {
            if constexpr (Epi::HOOK) { if (t == 6 || t == 14 || t == 22) E.hook(acc, cur, t, wr, wc, fr, fq); }
            const bool last = (t == nt - 2);
            const char* a1 = cA + (size_t)(t + 1) * kstep;
            const char* a2 = last ? nA : cA + (size_t)(t + 2) * kstep; const char* b2 = last ? nB : cB + (size_t)(t + 2) * kstep;
            const char* a3 = a2 + kstep; const char* b3 = b2 + kstep;
            PG8_LDB(B0, 0, 0); PG8_LDB(B1, 0, 1); PG8_SCHED; PG8_LDA(At, 0, 0); PG8_STAGE(PG8_SA(1, 1), a1 + hstepA, voffA);
            PG8_WAIT_V(8); PG8_WAIT_L(0); PG8_BAR; PG8_MMA(0, 0, At, B0); PG8_MMA(0, 1, At, B1); PG8_BAR; PG8_SCHED;
            PG8_LDA(At, 0, 1); PG8_STAGE(PG8_SB(0, 0), b2, voffB); PG8_STAGE(PG8_SB(0, 1), b2 + hstepB, voffB); PG8_STAGE(PG8_SA(0, 0), a2, voffA);
            PG8_WAIT_V(8); PG8_WAIT_L(0); PG8_BAR; PG8_MMA(1, 0, At, B0); PG8_MMA(1, 1, At, B1); PG8_BAR; PG8_SCHED;
            PG8_LDB(B0, 1, 0); PG8_LDB(B1, 1, 1); PG8_SCHED; PG8_LDA(At, 1, 0); PG8_STAGE(PG8_SA(0, 1), a2 + hstepA, voffA);
            PG8_WAIT_V(8); PG8_WAIT_L(0); PG8_BAR; PG8_MMA(0, 0, At, B0); PG8_MMA(0, 1, At, B1); PG8_BAR; PG8_SCHED;
            PG8_LDA(At, 1, 1); PG8_STAGE(PG8_SB(1, 0), b3, voffB); PG8_STAGE(PG8_SB(1, 1), b3 + hstepB, voffB); PG8_STAGE(PG8_SA(1, 0), a3, voffA);
            PG8_WAIT_V(8); PG8_WAIT_L(0); PG8_BAR; PG8_MMA(1, 0, At, B0); PG8_MMA(1, 1, At, B1); PG8_BAR; PG8_SCHED;
        }
        if (wr == 0) PG8_BAR;
        E(acc, cur, wr, wc, fr, fq);
        if (!has_next) break;
#pragma unroll
        for (int a = 0; a < 2; ++a)
#pragma unroll
            for (int b = 0; b < 2; ++b)
#pragma unroll
                for (int m = 0; m < 4; ++m)
#pragma unroll
                    for (int n = 0; n < 2; ++n) acc[a][b][m][n] = (f32x4){0.f, 0.f, 0.f, 0.f};
        cur = nxt; cA = nA; cB = nB; ++ui;
        if (wr == 1) PG8_BAR;
    }
    PG8_WAIT_V(0);
    PG8_BAR;
#undef PG8_SA
#undef PG8_SB
#undef PG8_STAGE
#undef PG8_LDA
#undef PG8_LDB
#undef PG8_MMA
#undef PG8_WAIT_V
#undef PG8_WAIT_L
#undef PG8_BAR
#undef PG8_SCHED
}
}
using pg8::Unit;
typedef f32x4 Acc[2][2][4][2];

struct RectSched {
    const char* A; const char* B; size_t astep, bstep;
    int nt, G, c, nM1, nN1, m2, nM2, nN2;
    DI bool next(int i, Unit& u) const {
        const int L = i * G + c; const int n1 = nM1 * nN1;
        int pm, pn;
        if (L < n1) pg8::rect_map(L, nM1, nN1, pm, pn);
        else if (L < n1 + nM2 * nN2) { pg8::rect_map(L - n1, nM2, nN2, pm, pn); pm += m2; }
        else return false;
        u.pm = pm; u.pn = pn; u.nt = nt; u.A = A + (size_t)pm * astep; u.B = B + (size_t)pn * bstep; return true;
    }
};
struct OneSched {
    Unit u; bool have;
    DI bool next(int i, Unit& o) const { if (i != 0 || !have) return false; o = u; return true; }
};

struct Ptrs {
    const float* in[26]; float* out; unsigned char* ws;
};

struct EpiInA {
    static constexpr bool PERM = true, HOOK = false;
    unsigned char* ws; const float* qn; const float* kn;
    LAS unsigned char* scr;
    unsigned* nrm;
    DI void hook(Acc&, const Unit&, int, int, int, int, int) const {}
    DI void operator()(const Acc& acc, const Unit& u, int wr, int wc, int fr, int fq) const {
        const int pn = u.pn;
        const f32x2* rope = (const f32x2*)(ws + OFF_ROPE);
        bf16_t* BRQ = (bf16_t*)(ws + A_BRQ);
        const bool ctx = u.pm >= 64;
        if (pn <= 1 || pn == 5 || pn == 6) {
            float nmax = 0.f;
#pragma unroll
            for (int ai = 0; ai < 2; ++ai)
#pragma unroll
                for (int m = 0; m < 4; ++m) {
                const int row = u.pm * 256 + ai * 128 + wr * 64 + m * 16 + fr;
                int b, t, kvrow;
                if (!ctx) { b = row >> 12; t = row & 4095; kvrow = b * LKV + t; }
                else { const int j = row - MLAT; b = j >> 8; t = j & 255; kvrow = b * LKV + SEQ + t; }
                const int prow = t >> 6, pcol = t & 63; (void)b; (void)kvrow; (void)prow; (void)pcol;
                    const bool isq = pn >= 5;
                    const int axis = wc & 1; const int pos = axis ? pcol : prow;
                    f32x2 cs[4];
#pragma unroll
                    for (int j = 0; j < 4; ++j) cs[j] = ctx ? (f32x2){1.f, 0.f} : rope[pos * 16 + 4 * fq + j];
#pragma unroll
                    for (int bj = 0; bj < 2; ++bj) {
                        const f32x4 re = acc[ai][bj][m][0], im = acc[ai][bj][m][1];
                        float o0[4], o1[4];
#pragma unroll
                        for (int j = 0; j < 4; ++j) { o0[j] = re[j] * cs[j].x - im[j] * cs[j].y; o1[j] = im[j] * cs[j].x + re[j] * cs[j].y; if (isq) { o0[j] *= QSCALE; o1[j] *= QSCALE; } }
                        const int c = (isq ? (pn - 5) : pn) * 256 + bj * 128 + wc * 32 + 8 * fq;
                        bf16_t* dst = isq ? (BRQ + (size_t)row * KBR + 384 + c) : ((bf16_t*)(ws + A_DK) + (size_t)kvrow * 512 + c);
                        *(u32x4*)dst = (u32x4){pk2(o0[0], o0[1]), pk2(o0[2], o0[3]), pk2(o1[0], o1[1]), pk2(o1[2], o1[3])};
                        float ss = o0[0] * o0[0] + o0[1] * o0[1] + o0[2] * o0[2] + o0[3] * o0[3] + o1[0] * o1[0] + o1[1] * o1[1] + o1[2] * o1[2] + o1[3] * o1[3];
                        ss += __shfl_xor(ss, 16); ss += __shfl_xor(ss, 32); nmax = fmaxf(nmax, ss);
                    }
                }
#pragma unroll
            for (int o = 8; o >= 1; o >>= 1) nmax = fmaxf(nmax, __shfl_xor(nmax, o));
            if (fq == 0 && fr == 0) atomicMax(nrm + (pn >= 5 ? 1 : 0), __float_as_uint(nmax));
        } else if (pn == 2 || pn == 3) {
#pragma unroll
            for (int ai = 0; ai < 2; ++ai)
#pragma unroll
                for (int m = 0; m < 4; ++m) {
                const int row = u.pm * 256 + ai * 128 + wr * 64 + m * 16 + fr;
                int b, t, kvrow;
                if (!ctx) { b = row >> 12; t = row & 4095; kvrow = b * LKV + t; }
                else { const int j = row - MLAT; b = j >> 8; t = j & 255; kvrow = b * LKV + SEQ + t; }
                const int prow = t >> 6, pcol = t & 63; (void)b; (void)kvrow; (void)prow; (void)pcol;
#pragma unroll
                    for (int bj = 0; bj < 2; ++bj)
#pragma unroll
                        for (int n = 0; n < 2; ++n) { const f32x4 v = acc[ai][bj][m][n]; const int c = (pn - 2) * 256 + bj * 128 + wc * 32 + 8 * fq + 4 * n;
                            *(u32x2*)((bf16_t*)(ws + A_DV) + (size_t)kvrow * 512 + c) = (u32x2){pk2(v[0], v[1]), pk2(v[2], v[3])}; }
                }
        } else if (pn == 4 || pn == 7 || pn == 8) {
#pragma unroll
            for (int ai = 0; ai < 2; ++ai)
#pragma unroll
                for (int m = 0; m < 4; ++m) {
                const int row = u.pm * 256 + ai * 128 + wr * 64 + m * 16 + fr;
                int b, t, kvrow;
                if (!ctx) { b = row >> 12; t = row & 4095; kvrow = b * LKV + t; }
                else { const int j = row - MLAT; b = j >> 8; t = j & 255; kvrow = b * LKV + SEQ + t; }
                const int prow = t >> 6, pcol = t & 63; (void)b; (void)kvrow; (void)prow; (void)pcol;
                    const bool isq = pn >= 7; const bool isv = (pn == 4) && wc >= 2;
                    float ss = 0.f;
#pragma unroll
                    for (int bj = 0; bj < 2; ++bj)
#pragma unroll
                        for (int n = 0; n < 2; ++n) { const f32x4 v = acc[ai][bj][m][n]; ss += v[0] * v[0] + v[1] * v[1] + v[2] * v[2] + v[3] * v[3]; }
                    ss += __shfl_xor(ss, 16); ss += __shfl_xor(ss, 32);
                    const float rs = isv ? 1.f : __builtin_amdgcn_rsqf(ss * (1.0f / 64.0f) + EPS);
                    const float* gn = isq ? qn : kn;
                    bf16_t* dst;
                    if (isq) dst = BRQ + (size_t)row * KBR + 896 + ((pn - 7) * 4 + wc) * 64;
                    else if (isv) dst = (bf16_t*)(ws + A_GV) + (size_t)kvrow * 128 + (wc - 2) * 64;
                    else dst = (bf16_t*)(ws + A_GK) + (size_t)kvrow * 128 + wc * 64;
#pragma unroll
                    for (int bj = 0; bj < 2; ++bj) {
                        const int pos = bj ? pcol : prow;
                        float o0[4], o1[4];
#pragma unroll
                        for (int j = 0; j < 4; ++j) {
                            float re = acc[ai][bj][m][0][j], im = acc[ai][bj][m][1][j];
                            if (!isv) { re *= rs * gn[32 * bj + 4 * fq + j]; im *= rs * gn[32 * bj + 16 + 4 * fq + j]; }
                            f32x2 cs = (ctx || isv) ? (f32x2){1.f, 0.f} : rope[pos * 16 + 4 * fq + j];
                            o0[j] = re * cs.x - im * cs.y; o1[j] = im * cs.x + re * cs.y;
                            if (isq) { o0[j] *= QSCALE; o1[j] *= QSCALE; }
                        }
                        *(u32x4*)(dst + 32 * bj + 8 * fq) = (u32x4){pk2(o0[0], o0[1]), pk2(o0[2], o0[3]), pk2(o1[0], o1[1]), pk2(o1[2], o1[3])};
                    }
                }
        } else if (pn <= 11) {
            const int lane = fq * 16 + fr, col = lane >> 2, chunk = lane & 3;
            LAS bf16_t* sw = (LAS bf16_t*)(scr + (wr * 4 + wc) * 2304);
#pragma unroll
            for (int ai = 0; ai < 2; ++ai) {
                const int row0 = u.pm * 256 + ai * 128 + wr * 64;
                int b, t0; if (!ctx) { b = row0 >> 12; t0 = row0 & 4095; } else { const int j = row0 - MLAT; b = j >> 8; t0 = j & 255; }
#pragma unroll
                for (int bj = 0; bj < 2; ++bj)
#pragma unroll
                    for (int n = 0; n < 2; ++n) {
#pragma unroll
                        for (int m = 0; m < 4; ++m) { const f32x4 v = acc[ai][bj][m][n];
#pragma unroll
                            for (int j = 0; j < 4; ++j) sw[(4 * fq + j) * 72 + 16 * m + fr] = (bf16_t)(pk2(v[j], 0.f) & 0xffffu); }
                        asm volatile("s_waitcnt lgkmcnt(0)" ::: "memory");
                        const u32x4 v0 = *(const LAS u32x4*)(sw + col * 72 + chunk * 16), v1 = *(const LAS u32x4*)(sw + col * 72 + chunk * 16 + 8);
                        const int c0 = (pn - 9) * 256 + bj * 128 + wc * 32 + 8 * (col >> 2) + 4 * n + (col & 3); const int part = c0 >= 384 ? 1 : 0; const int ch = c0 - part * 384;
                        bf16_t* dst = ctx ? ((bf16_t*)(ws + A_FTC) + (size_t)(b * 384 + ch) * 512 + part * 256 + t0 + chunk * 16)
                                          : ((bf16_t*)(ws + A_FT) + (size_t)(b * 384 + ch) * 8192 + part * 4096 + t0 + chunk * 16);
                        *(u32x4*)dst = v0; *(u32x4*)(dst + 8) = v1;
                        asm volatile("s_waitcnt lgkmcnt(0)" ::: "memory");
                    }
            }
        } else {
#pragma unroll
            for (int ai = 0; ai < 2; ++ai)
#pragma unroll
                for (int m = 0; m < 4; ++m) {
                const int row = u.pm * 256 + ai * 128 + wr * 64 + m * 16 + fr;
                int b, t, kvrow;
                if (!ctx) { b = row >> 12; t = row & 4095; kvrow = b * LKV + t; }
                else { const int j = row - MLAT; b = j >> 8; t = j & 255; kvrow = b * LKV + SEQ + t; }
                const int prow = t >> 6, pcol = t & 63; (void)b; (void)kvrow; (void)prow; (void)pcol;
#pragma unroll
                    for (int bj = 0; bj < 2; ++bj) {
                        const f32x4 a = acc[ai][bj][m][0], g = acc[ai][bj][m][1];
                        const int ch = ((pn - 12) * 8 + 4 * bj + wc) * 16 + 4 * fq;
                        float o[4];
#pragma unroll
                        for (int j = 0; j < 4; ++j) o[j] = a[j] * sigmoidf_(g[j]);
                        *(u32x2*)((bf16_t*)(ws + A_V) + (size_t)row * 384 + ch) = (u32x2){pk2(o[0], o[1]), pk2(o[2], o[3])};
                    }
                }
        }
    }
};

template <int ACT> struct EpiBf16 {
    static constexpr bool PERM = true, HOOK = false;
    bf16_t* O; int ldc;
    DI void hook(Acc&, const Unit&, int, int, int, int, int) const {}
    DI void operator()(const Acc& acc, const Unit& u, int wr, int wc, int fr, int fq) const {
#pragma unroll
        for (int ai = 0; ai < 2; ++ai)
#pragma unroll
            for (int m = 0; m < 4; ++m) {
                bf16_t* rowp = O + (size_t)(u.pm * 256 + ai * 128 + wr * 64 + m * 16 + fr) * ldc + u.pn * 256 + wc * 32 + 8 * fq;
#pragma unroll
                for (int bj = 0; bj < 2; ++bj) {
                    f32x4 v0 = acc[ai][bj][m][0], v1 = acc[ai][bj][m][1];
                    if (ACT == 1) {
#pragma unroll
                        for (int j = 0; j < 4; ++j) { v0[j] = sigmoidf_(v0[j]); v1[j] = sigmoidf_(v1[j]); }
                    } else if (ACT == 2) {
#pragma unroll
                        for (int j = 0; j < 4; ++j) { float a = fmaxf(v0[j], 0.f), b = fmaxf(v1[j], 0.f); v0[j] = a * a; v1[j] = b * b; }
                    }
                    *(u32x4*)(rowp + bj * 128) = (u32x4){pk2(v0[0], v0[1]), pk2(v0[2], v0[3]), pk2(v1[0], v1[1]), pk2(v1[2], v1[3])};
                }
            }
    }
};

struct EpiBranch {
    static constexpr bool PERM = true, HOOK = true;
    const bf16_t* G; bf16_t* O;
    DI void hook(Acc& acc, const Unit& u, int t, int wr, int wc, int fr_, int fq) const {
        int fr = fr_; asm volatile("" : "+v"(fr));
        const int s = (t == 6) ? 0 : (t == 14 ? 1 : 2);
#pragma unroll
        for (int ai = 0; ai < 2; ++ai) {
            u32x4 ga[4][2], gb[4][2];
#pragma unroll
            for (int m = 0; m < 4; ++m) {
                const bf16_t* gp = G + (size_t)(u.pm * 256 + ai * 128 + wr * 64 + m * 16 + fr) * 4096 + s * 1024 + u.pn * 256 + wc * 32 + 8 * fq;
#pragma unroll
                for (int bj = 0; bj < 2; ++bj) { ga[m][bj] = *(const u32x4*)(gp + bj * 128); gb[m][bj] = *(const u32x4*)(gp + 1024 + bj * 128); }
            }
#pragma unroll
            for (int m = 0; m < 4; ++m)
#pragma unroll
                for (int bj = 0; bj < 2; ++bj)
#pragma unroll
                    for (int q = 0; q < 4; ++q) {
                        const float r0 = bflo(ga[m][bj][q]) * __builtin_amdgcn_rcpf(bflo(gb[m][bj][q])), r1 = bfhi(ga[m][bj][q]) * __builtin_amdgcn_rcpf(bfhi(gb[m][bj][q]));
                        acc[ai][bj][m][q >> 1][(q & 1) * 2] *= r0; acc[ai][bj][m][q >> 1][(q & 1) * 2 + 1] *= r1;
                    }
            asm volatile("" ::: "memory");
        }
    }
    DI void operator()(const Acc& acc, const Unit& u, int wr, int wc, int fr, int fq) const {
#pragma unroll
        for (int ai = 0; ai < 2; ++ai) {
            u32x4 g[4][2];
#pragma unroll
            for (int m = 0; m < 4; ++m)
#pragma unroll
                for (int bj = 0; bj < 2; ++bj) g[m][bj] = *(const u32x4*)(G + (size_t)(u.pm * 256 + ai * 128 + wr * 64 + m * 16 + fr) * 4096 + 3072 + u.pn * 256 + wc * 32 + 8 * fq + bj * 128);
#pragma unroll
            for (int m = 0; m < 4; ++m) {
                const size_t row = (size_t)(u.pm * 256 + ai * 128 + wr * 64 + m * 16 + fr);
                const int c = u.pn * 256 + wc * 32 + 8 * fq;
#pragma unroll
                for (int bj = 0; bj < 2; ++bj) {
                    const u32x4 gg = g[m][bj];
                    const f32x4 v0 = acc[ai][bj][m][0], v1 = acc[ai][bj][m][1];
                    *(u32x4*)(O + row * 1024 + c + bj * 128) = (u32x4){pk2(v0[0] * bflo(gg[0]), v0[1] * bfhi(gg[0])), pk2(v0[2] * bflo(gg[1]), v0[3] * bfhi(gg[1])),
                                                                      pk2(v1[0] * bflo(gg[2]), v1[1] * bfhi(gg[2])), pk2(v1[2] * bflo(gg[3]), v1[3] * bfhi(gg[3]))};
                }
            }
            asm volatile("" ::: "memory");
        }
    }
};

struct EpiFourier {
    static constexpr bool PERM = true, HOOK = false;
    bf16_t* BRQ; int row0, seqlen; float scale;
    DI void hook(Acc&, const Unit&, int, int, int, int, int) const {}
    DI void operator()(const Acc& acc, const Unit& u, int wr, int wc, int fr, int fq) const {
#pragma unroll
        for (int ai = 0; ai < 2; ++ai)
#pragma unroll
            for (int m = 0; m < 4; ++m) {
                const int pos = u.pm * 256 + ai * 128 + wr * 64 + m * 16 + fr;
#pragma unroll
                for (int bj = 0; bj < 2; ++bj) {
                    const int c = u.pn * 256 + bj * 128 + wc * 32 + 8 * fq; const int b = c / 384, ch = c - b * 384;
                    const f32x4 v0 = acc[ai][bj][m][0] * scale, v1 = acc[ai][bj][m][1] * scale;
                    *(u32x4*)(BRQ + (size_t)(row0 + b * seqlen + pos) * KBR + ch) = (u32x4){pk2(v0[0], v0[1]), pk2(v0[2], v0[3]), pk2(v1[0], v1[1]), pk2(v1[2], v1[3])};
                }
            }
    }
};

struct MapId { int off; DI int operator()(int n) const { return n + off; } };
struct MapWin {
    DI static int rp(int lc) { return 16 * ((lc >> 2) & 1) + 4 * (lc >> 3) + (lc & 3); }
    DI int operator()(int n) const {
        if (n < 512) return (n & ~31) + rp(n & 31);
        if (n < 1024) return n;
        if (n < 1280) { const int i = n - 1024, bj = i >> 7, wc = (i >> 5) & 3, lc = i & 31; return wc < 2 ? 1024 + wc * 64 + 32 * bj + rp(lc) : 1152 + (wc - 2) * 64 + 32 * bj + lc; }
        if (n < 1792) { const int i = n - 1280; return 1664 + (i & ~31) + rp(i & 31); }
        if (n < 2304) { const int i = n - 1792, tile = i >> 8, ii = i & 255, bj = ii >> 7, wc = (ii >> 5) & 3, lc = ii & 31; return 2176 + (tile * 4 + wc) * 64 + 32 * bj + rp(lc); }
        if (n < 3072) return -1;
        if (n < 3840) { const int i = n - 3072, grp = i >> 5, lc = i & 31, ch = grp * 16 + 4 * (lc >> 3) + (lc & 3); return ((lc >> 2) & 1) ? 3072 + ch : 2688 + ch; }
        return 3456 + (n - 3840);
    }
};
template <class Map>
DI void convT(LAS unsigned char* lds, const float* src, int sld, int K, bf16_t* dst, int dld, int N, const Map& map, int item0, int nblk) {
    LAS float* tile = (LAS float*)lds;
    const int tid = tid_(); const int tK = K / 128, tN = N / 64;
    for (int it = item0; it < tK * tN; it += nblk) {
        const int tn = it / tK, tk = it % tK;
        const int col = map(tn * 64 + (tid & 63));
        if (map(tn * 64) < 0) continue;
        float v[16];
#pragma unroll
        for (int p = 0; p < 16; ++p) v[p] = src[(size_t)(tk * 128 + p * 8 + (tid >> 6)) * sld + col];
#pragma unroll
        for (int p = 0; p < 16; ++p) tile[(p * 8 + (tid >> 6)) * 65 + (tid & 63)] = v[p];
        __syncthreads();
#pragma unroll
        for (int hh = 0; hh < 2; ++hh) { const int n = tid >> 3, kc = (tid & 7) + 8 * hh; float w[8];
#pragma unroll
          for (int e = 0; e < 8; ++e) w[e] = tile[(kc * 8 + e) * 65 + n];
          *(u32x4*)(dst + (size_t)(tn * 64 + n) * dld + tk * 128 + kc * 8) = (u32x4){pk2(w[0], w[1]), pk2(w[2], w[3]), pk2(w[4], w[5]), pk2(w[6], w[7])}; }
        __syncthreads();
    }
}
DI void conv_fold(LAS unsigned char* lds, const float* win, bf16_t* wint, int item0, int nblk) {
    LAS float* tile = (LAS float*)lds;
    LAS float* tab = (LAS float*)(lds + 64 * 65 * 4);
    LAS bf16_t* outb = (LAS bf16_t*)(lds + 64 * 65 * 4 + 256);
    const int tid = tid_();
    __syncthreads();
    if (tid < 64) tab[tid] = cospif((float)tid / 32.0f);
    for (int it = item0; it < 6 * 16; it += nblk) {
        const int g = it >> 4, tk = it & 15;
        __syncthreads();
#pragma unroll
        for (int p = 0; p < 8; ++p) { const int kk = p * 8 + (tid >> 6); tile[kk * 65 + (tid & 63)] = win[(size_t)(tk * 64 + kk) * IN_COLS + 1280 + g * 64 + (tid & 63)]; }
        __syncthreads();
        const int k = tid & 63, cq = tid >> 6;
        float ac[8], as[8];
#pragma unroll
        for (int e = 0; e < 8; ++e) { ac[e] = 0.f; as[e] = 0.f; }
        for (int c = 0; c < 64; ++c) {
            const float w = tile[k * 65 + c];
#pragma unroll
            for (int e = 0; e < 8; ++e) { const int idx = c * (cq * 8 + e); ac[e] += w * tab[idx & 63]; as[e] += w * tab[(idx - 16) & 63]; }
        }
#pragma unroll
        for (int e = 0; e < 8; ++e) { outb[(cq * 8 + e) * 72 + k] = (bf16_t)(pk2(ac[e], 0.f) & 0xffffu); outb[(64 + cq * 8 + e) * 72 + k] = (bf16_t)(pk2(as[e], 0.f) & 0xffffu); }
        __syncthreads();
        for (int i = tid; i < 128 * 8; i += NTHREADS) { const int rr = i >> 3, ch = i & 7; const int part = rr >> 6, cp = rr & 63;
            *(u32x4*)(wint + (size_t)(2304 + part * 384 + g * 64 + cp) * D + tk * 64 + ch * 8) = *(const LAS u32x4*)(outb + rr * 72 + ch * 8); }
    }
    __syncthreads();
}
DI void conv_win(LAS unsigned char* lds, const Ptrs& P, int l, int item0, int nblk) {
    const float* win = P.in[I_WIN] + (size_t)l * D * IN_COLS;
    convT(lds, win, IN_COLS, D, (bf16_t*)(P.ws + OFF_WINT), D, NIN, MapWin{}, item0, nblk);
    conv_fold(lds, win, (bf16_t*)(P.ws + OFF_WINT), item0, nblk);
}
DI void gen_dft(LAS unsigned char* lds, unsigned char* ws, int item0, int nblk, bool also_small) {
    const int tid = tid_();
    bf16_t* dft = (bf16_t*)(ws + A_DFT);
    for (int it = item0 * NTHREADS + tid; it < 4096 * 512; it += nblk * NTHREADS) {
        const int k = it >> 9, j0 = (it & 511) * 8;
        float v[8];
#pragma unroll
        for (int e = 0; e < 8; ++e) { const int j = j0 + e; const bool sp = j >= 2049; const float fr = (float)((k * (sp ? j - 2048 : j)) & 4095) * (1.0f / 4096.0f); v[e] = sp ? -__builtin_amdgcn_sinf(fr) : __builtin_amdgcn_cosf(fr); }
        *(u32x4*)(dft + (size_t)k * 4096 + j0) = (u32x4){pk2(v[0], v[1]), pk2(v[2], v[3]), pk2(v[4], v[5]), pk2(v[6], v[7])};
    }
    if (also_small) {
        bf16_t* dc = (bf16_t*)(ws + OFF_DFTC);
        for (int it = item0 * NTHREADS + tid; it < 256 * 64; it += nblk * NTHREADS) {
            const int k = it >> 6, j0 = (it & 63) * 8; const int part = j0 >= 256; const int t0 = j0 & 255;
            float v[8];
#pragma unroll
            for (int e = 0; e < 8; ++e) { const float fr = (float)((k * (t0 + e)) & 255) * (1.0f / 256.0f); v[e] = part ? -__builtin_amdgcn_sinf(fr) : __builtin_amdgcn_cosf(fr); }
            *(u32x4*)(dc + (size_t)k * 512 + j0) = (u32x4){pk2(v[0], v[1]), pk2(v[2], v[3]), pk2(v[4], v[5]), pk2(v[6], v[7])};
        }
    }
}
DI void fourier_fold(unsigned char* ws, int item0, int nblk) {
    const int tid = tid_();
    const bf16_t* FT = (const bf16_t*)(ws + A_FT); bf16_t* FTF = (bf16_t*)(ws + A_FTF);
    for (int it = item0 * NTHREADS + tid; it < 1536 * 1024; it += nblk * NTHREADS) {
        const int n = it >> 10, j0 = (it & 1023) * 4;
        const bf16_t* s = FT + (size_t)n * 8192;
        float o[4];
#pragma unroll
        for (int e = 0; e < 4; ++e) { const int j = j0 + e;
            if (j <= 2048) { const float a = bflo((unsigned)s[j]); o[e] = (j == 0 || j == 2048) ? a : a + bflo((unsigned)s[4096 - j]); }
            else { const int t = j - 2048; o[e] = bflo((unsigned)s[4096 + t]) - bflo((unsigned)s[8192 - t]); } }
        *(u32x2*)(FTF + (size_t)n * 4096 + j0) = (u32x2){pk2(o[0], o[1]), pk2(o[2], o[3])};
    }
}

DI void mod_gemv(LAS unsigned char* lds, const Ptrs& P, int item0, int nblk) {
    LAS float* sc = (LAS float*)lds;
    LAS float* red = (LAS float*)(lds + 20480);
    const int tid = tid_();
    __syncthreads();
    for (int i = tid; i < 5 * 1024; i += NTHREADS) { const float v = i < 4096 ? P.in[I_C][i] : P.in[I_CCTX][i - 4096]; sc[i] = v * sigmoidf_(v); }
    __syncthreads();
    float* MOD = (float*)(P.ws + OFF_MOD);
    for (int it = item0; it < 2 * 192; it += nblk) {
        const int l = it / 192, cg32 = it % 192; const int kg = tid >> 5, cl = tid & 31;
        const float* w = P.in[I_WMOD] + (size_t)l * D * 6144 + cg32 * 32 + cl;
        float a[5] = {0.f, 0.f, 0.f, 0.f, 0.f};
        for (int k = kg * 64; k < kg * 64 + 64; ++k) { const float wv = w[(size_t)k * 6144];
#pragma unroll
            for (int r = 0; r < 5; ++r) a[r] += sc[r * 1024 + k] * wv; }
#pragma unroll
        for (int r = 0; r < 5; ++r) red[(kg * 5 + r) * 32 + cl] = a[r];
        __syncthreads();
        if (tid < 160) { const int r = tid >> 5; float s = 0.f;
#pragma unroll
            for (int g = 0; g < 16; ++g) s += red[(g * 5 + r) * 32 + cl];
            MOD[((size_t)l * 5 + r) * 6144 + cg32 * 32 + cl] = s + P.in[I_BMOD][l * 6144 + cg32 * 32 + cl]; }
        __syncthreads();
    }
}

DI void row_mod_store(const f32x4 (&x)[4], float rstd, const float* gain, const float* shift, const float* scale, bf16_t* hrow, int lane) {
#pragma unroll
    for (int i = 0; i < 4; ++i) { const int c = lane * 4 + 256 * i;
        const f32x4 g = *(const f32x4*)(gain + c), sh = *(const f32x4*)(shift + c), sc = *(const f32x4*)(scale + c);
        float o[4];
#pragma unroll
        for (int j = 0; j < 4; ++j) o[j] = x[i][j] * rstd * g[j] * (1.f + sc[j]) + sh[j];
        *(u32x2*)(hrow + c) = (u32x2){pk2(o[0], o[1]), pk2(o[2], o[3])}; }
}
DI float row_rstd(const f32x4 (&x)[4]) {
    float s = 0.f;
#pragma unroll
    for (int i = 0; i < 4; ++i) s += x[i][0] * x[i][0] + x[i][1] * x[i][1] + x[i][2] * x[i][2] + x[i][3] * x[i][3];
    s = wave_sum(s);
    return __builtin_amdgcn_rsqf(s * (1.0f / 1024.0f) + EPS);
}
DI void rows_first(const Ptrs& P) {
    const int tid = tid_(); const int lane = tid & 63, wv = tid >> 6;
    const float* MOD = (const float*)(P.ws + OFF_MOD);
    for (int row = blockIdx.x * 8 + wv; row < MTOT; row += gridDim.x * 8) {
        const float* xr = row < MLAT ? P.in[I_X] + (size_t)row * D : P.in[I_CTX] + (size_t)(row - MLAT) * D;
        const int mr = row < MLAT ? (row >> 12) : 4;
        f32x4 x[4];
#pragma unroll
        for (int i = 0; i < 4; ++i) x[i] = *(const f32x4*)(xr + lane * 4 + 256 * i);
        const float rstd = row_rstd(x);
        const float* mod = MOD + (size_t)mr * 6144;
        row_mod_store(x, rstd, P.in[I_GPREMIX], mod, mod + 1024, (bf16_t*)(P.ws + OFF_HS) + (size_t)row * D, lane);
    }
}
DI void rows_update(const Ptrs& P, int l, int which  , int nrows) {
    const int tid = tid_(); const int lane = tid & 63, wv = tid >> 6;
    const float* MOD = (const float*)(P.ws + OFF_MOD);
    const bf16_t* Y = (const bf16_t*)(P.ws + A_MIXO);
    const float* gpost = P.in[which ? I_GPOSTMLP : I_GPOSTMIX] + l * D;
    const bool do_h = (which == 0) || (l == 0);
    const int ln = which ? l + 1 : l;
    const float* gnext = which ? P.in[I_GPREMIX] + (do_h ? ln : 0) * D : P.in[I_GPREMLP] + l * D;
    for (int row = blockIdx.x * 8 + wv; row < nrows; row += gridDim.x * 8) {
        const bool lat = row < MLAT;
        const float* xin = lat ? ((l == 0 && which == 0) ? P.in[I_X] + (size_t)row * D : P.out + (size_t)row * D)
                               : ((which == 0) ? P.in[I_CTX] + (size_t)(row - MLAT) * D : (const float*)(P.ws + A_XC) + (size_t)(row - MLAT) * D);
        float* xout = lat ? P.out + (size_t)row * D : (float*)(P.ws + A_XC) + (size_t)(row - MLAT) * D;
        const int mr = lat ? (row >> 12) : 4;
        const float* mod = MOD + ((size_t)l * 5 + mr) * 6144;
        const float* gate = mod + (which ? 5 : 2) * 1024;
        f32x4 x[4], y[4];
#pragma unroll
        for (int i = 0; i < 4; ++i) { x[i] = *(const f32x4*)(xin + lane * 4 + 256 * i);
            const u32x2 yb = *(const u32x2*)(Y + (size_t)row * D + lane * 4 + 256 * i); y[i] = (f32x4){bflo(yb[0]), bfhi(yb[0]), bflo(yb[1]), bfhi(yb[1])}; }
        const float ry = row_rstd(y);
#pragma unroll
        for (int i = 0; i < 4; ++i) { const int c = lane * 4 + 256 * i; const f32x4 gp = *(const f32x4*)(gpost + c), gt = *(const f32x4*)(gate + c);
#pragma unroll
            for (int j = 0; j < 4; ++j) x[i][j] += gt[j] * (y[i][j] * ry * gp[j]);
            *(f32x4*)(xout + c) = x[i]; }
        if (do_h) {
            const float rx = row_rstd(x);
            const float* modn = MOD + ((size_t)ln * 5 + mr) * 6144;
            const float* shiftn = which ? modn : modn + 3 * 1024; const float* scalen = which ? modn + 1024 : modn + 4 * 1024;
            row_mod_store(x, rx, gnext, shiftn, scalen, (bf16_t*)(P.ws + OFF_HS) + (size_t)row * D, lane);
        }
    }
}

constexpr int AK_PITCH = 144;
constexpr int AK_BUF = 64 * AK_PITCH;
constexpr int AV_OFF = 2 * AK_BUF;
#define ATT_BAR() do { __builtin_amdgcn_sched_barrier(0); asm volatile("s_waitcnt lgkmcnt(0)" ::: "memory"); __builtin_amdgcn_s_barrier(); asm volatile("" ::: "memory"); __builtin_amdgcn_sched_barrier(0); } while (0)
DI float max3_(float a, float b, float c) { float d; asm("v_max3_f32 %0, %1, %2, %3" : "=v"(d) : "v"(a), "v"(b), "v"(c)); return d; }
template <int NMB, bool NOMAX = false>
DI void flash_pass(LAS unsigned char* lds, const bf16x8 (&qf)[4], const bf16_t* Kg, int ldk, const bf16_t* Vg, int ldv, int ntiles, f32x16 (&O)[NMB], float& lsum) {
    constexpr int VP = NMB == 4 ? 320 : 192;
    constexpr int VBUF = 64 * VP;
    constexpr int VCH = NMB * 4;
    constexpr int VPT = NMB / 2;
    const int tid = tid_(), lane = tid & 63, g = __builtin_amdgcn_readfirstlane(tid >> 8);
    const int r = lane & 31, h = lane >> 5, i16 = lane & 15, q4 = i16 >> 2, p4 = i16 & 3, blk = (lane >> 4) & 1;
    const int kkey = tid >> 3, kch = tid & 7;
    const unsigned kwoff = kkey * AK_PITCH + kch * 16;
    const unsigned vrd = (4 * h + q4) * VP + 32 * blk + 8 * p4;
    const unsigned krd = r * AK_PITCH + 16 * h;
    const bf16_t* kgp = Kg + (size_t)kkey * ldk + kch * 8;
    const unsigned vwoff0 = (tid / VCH) * VP + (tid % VCH) * 16; const bf16_t* vgp0 = Vg + (size_t)(tid / VCH) * ldv + (tid % VCH) * 8;
    constexpr int VKS = NTHREADS / VCH;
#define vwoff_(p) (vwoff0 + (p) * VKS * VP)
#define vgp_(p) (vgp0 + (size_t)(p) * VKS * ldv)
    float m_run = -1e30f; lsum = 0.f;
#pragma unroll
    for (int mb = 0; mb < NMB; ++mb)
#pragma unroll
        for (int i = 0; i < 16; ++i) O[mb][i] = 0.f;
    u32x4 kreg, vreg[VPT];
    {
        const u32x4 k0 = *(const u32x4*)kgp, k1 = *(const u32x4*)(kgp + (size_t)64 * ldk);
#pragma unroll
        for (int p = 0; p < VPT; ++p) vreg[p] = *(const u32x4*)vgp_(p);
        __syncthreads();
        *(LAS u32x4*)(lds + kwoff) = k0; *(LAS u32x4*)(lds + AK_BUF + kwoff) = k1;
#pragma unroll
        for (int p = 0; p < VPT; ++p) *(LAS u32x4*)(lds + AV_OFF + vwoff_(p)) = vreg[p];
    }
    __syncthreads();
    kreg = *(const u32x4*)(kgp + (size_t)(ntiles > 2 ? 128 : 0) * ldk);
#pragma unroll
    for (int p = 0; p < VPT; ++p) vreg[p] = *(const u32x4*)(vgp_(p) + (size_t)64 * ldv);
    f32x16 S0, S1;
#pragma unroll
    for (int i = 0; i < 16; ++i) { S0[i] = 0.f; S1[i] = 0.f; }
#pragma unroll
    for (int c = 0; c < 4; ++c) {
        const bf16x8 a0 = *(const LAS bf16x8*)(lds + krd + 32 * c);
        const bf16x8 a1 = *(const LAS bf16x8*)(lds + krd + 32 * AK_PITCH + 32 * c);
        S0 = __builtin_amdgcn_mfma_f32_32x32x16_bf16(a0, qf[c], S0, 0, 0, 0);
        S1 = __builtin_amdgcn_mfma_f32_32x32x16_bf16(a1, qf[c], S1, 0, 0, 0);
    }
    if (g == 1) ATT_BAR();
    for (int t = 0; t < ntiles; ++t) {
        const int sv = t + g;
        if (sv >= 1) {
            if (sv < ntiles) {
#pragma unroll
                for (int p = 0; p < VPT; ++p) *(LAS u32x4*)(lds + AV_OFF + (sv & 1) * VBUF + vwoff_(p)) = vreg[p]; }
            if (sv + 1 < ntiles) *(LAS u32x4*)(lds + ((sv + 1) & 1) * AK_BUF + kwoff) = kreg;
        }
        if (sv + 1 < ntiles) {
#pragma unroll
            for (int p = 0; p < VPT; ++p) vreg[p] = *(const u32x4*)(vgp_(p) + (size_t)(sv + 1) * 64 * ldv); }
        if (sv + 2 < ntiles) kreg = *(const u32x4*)(kgp + (size_t)(sv + 2) * 64 * ldk);
        if constexpr (!NOMAX) {
        float mx = max3_(S0[0], S1[0], S0[1]), mx2 = max3_(S1[1], S0[2], S1[2]);
#pragma unroll
        for (int i = 3; i < 15; i += 2) { mx = max3_(mx, S0[i], S1[i]); mx2 = max3_(mx2, S0[i + 1], S1[i + 1]); }
        mx = max3_(mx, S0[15], S1[15]);
        mx = max3_(mx, mx2, mx2);
        { const u32x2 sw = __builtin_amdgcn_permlane32_swap(__float_as_uint(mx), __float_as_uint(mx), false, false);
          mx = max3_(__uint_as_float(sw[0]), __uint_as_float(sw[1]), m_run); }
        const float m_new = mx;
        if (__builtin_amdgcn_ballot_w64(m_new > m_run) != 0ull) {
            const float alpha = __builtin_amdgcn_exp2f(m_run - m_new);
            lsum *= alpha;
#pragma unroll
            for (int mb = 0; mb < NMB; ++mb)
#pragma unroll
                for (int i = 0; i < 16; ++i) O[mb][i] *= alpha;
            m_run = m_new;
        }
        }
#pragma unroll
        for (int i = 0; i < 16; ++i) { if constexpr (NOMAX) { S0[i] = __builtin_amdgcn_exp2f(S0[i]); S1[i] = __builtin_amdgcn_exp2f(S1[i]); } else { S0[i] = __builtin_amdgcn_exp2f(S0[i] - m_run); S1[i] = __builtin_amdgcn_exp2f(S1[i] - m_run); } }
        f32x2 ps2 = (f32x2){0.f, 0.f};
#pragma unroll
        for (int i = 0; i < 8; ++i) { ps2 += (f32x2){S0[2 * i], S0[2 * i + 1]}; ps2 += (f32x2){S1[2 * i], S1[2 * i + 1]}; }
        lsum += ps2.x + ps2.y;
        bf16x8 pf[4];
#pragma unroll
        for (int cp = 0; cp < 2; ++cp) {
            u32x4 w0, w1;
#pragma unroll
            for (int q = 0; q < 4; ++q) { w0[q] = pk2(S0[8 * cp + 2 * q], S0[8 * cp + 2 * q + 1]); w1[q] = pk2(S1[8 * cp + 2 * q], S1[8 * cp + 2 * q + 1]); }
            pf[cp] = __builtin_bit_cast(bf16x8, w0); pf[2 + cp] = __builtin_bit_cast(bf16x8, w1);
        }
        ATT_BAR();
        {
            const LAS unsigned char* Vb = lds + AV_OFF + (t & 1) * VBUF + vrd;
            const LAS unsigned char* Kb = lds + ((t + 1) & 1) * AK_BUF + krd;
            const bool qk = t + 1 < ntiles;
            bf16x8 kf[8], va[NMB], vb[NMB];
#define ATT_LDV(dst, kc) do { _Pragma("unroll") for (int mb = 0; mb < NMB; ++mb) { \
                const s16x4 lo_ = __builtin_amdgcn_ds_read_tr16_b64_v4i16((LAS s16x4*)(Vb + (16 * (kc)) * VP + 64 * mb)); \
                const s16x4 hi_ = __builtin_amdgcn_ds_read_tr16_b64_v4i16((LAS s16x4*)(Vb + (16 * (kc) + 8) * VP + 64 * mb)); \
                dst[mb] = __builtin_shufflevector(lo_, hi_, 0, 1, 2, 3, 4, 5, 6, 7); } } while (0)
#define ATT_PV(srcv, kc) do { _Pragma("unroll") for (int mb = 0; mb < NMB; ++mb) O[mb] = __builtin_amdgcn_mfma_f32_32x32x16_bf16(srcv[mb], pf[kc], O[mb], 0, 0, 0); } while (0)
            if (qk) {
#pragma unroll
                for (int c = 0; c < 4; ++c) { kf[2 * c] = *(const LAS bf16x8*)(Kb + 32 * c); kf[2 * c + 1] = *(const LAS bf16x8*)(Kb + 32 * AK_PITCH + 32 * c); }
            }
            ATT_LDV(va, 0);
            __builtin_amdgcn_sched_barrier(0);
            if (qk) {
#pragma unroll
                for (int i = 0; i < 16; ++i) { S0[i] = 0.f; S1[i] = 0.f; }
#pragma unroll
                for (int c = 0; c < 4; ++c) {
                    S0 = __builtin_amdgcn_mfma_f32_32x32x16_bf16(kf[2 * c], qf[c], S0, 0, 0, 0);
                    S1 = __builtin_amdgcn_mfma_f32_32x32x16_bf16(kf[2 * c + 1], qf[c], S1, 0, 0, 0);
                }
            }
            ATT_LDV(vb, 1);
            __builtin_amdgcn_sched_barrier(0);
            ATT_PV(va, 0);
            ATT_LDV(va, 2);
            __builtin_amdgcn_sched_barrier(0);
            ATT_PV(vb, 1);
            ATT_LDV(vb, 3);
            __builtin_amdgcn_sched_barrier(0);
            ATT_PV(va, 2);
            ATT_PV(vb, 3);
#undef ATT_LDV
#undef ATT_PV
        }
        ATT_BAR();
    }
    if (g == 0) ATT_BAR();
    lsum += __shfl_xor(lsum, 32);
}
#undef vwoff_
#undef vgp_

DI void diff_unit(LAS unsigned char* lds, const Ptrs& P, int l, int b, int hd, int qrow0, int key0, int ntiles, float lam, float lam_init) {
    const int tid = tid_(); const int lane = tid & 63, wv = tid >> 6, r = lane & 31, h = lane >> 5;
    bf16_t* BRQ = (bf16_t*)(P.ws + A_BRQ);
    const bf16_t* DK = (const bf16_t*)(P.ws + A_DK) + (size_t)(b * LKV + key0) * 512 + hd * 128;
    const bf16_t* DV = (const bf16_t*)(P.ws + A_DV) + (size_t)(b * LKV + key0) * 512 + hd * 128;
    bf16_t* qp = BRQ + (size_t)(qrow0 + wv * 32 + r) * KBR + 384 + hd * 128;
    bf16x8 q0[4], q1[4];
#pragma unroll
    for (int c = 0; c < 4; ++c) { q0[c] = *(const bf16x8*)(qp + 16 * c + 8 * h); q1[c] = *(const bf16x8*)(qp + 64 + 16 * c + 8 * h); }
    f32x16 O[4]; float l0;
    const unsigned* nrm = (const unsigned*)(P.ws + OFF_CTL) + 32 + 2 * l;
    const float bnd = 2.04f * sqrtf(__uint_as_float(__hip_atomic_load(nrm, __ATOMIC_RELAXED, __HIP_MEMORY_SCOPE_AGENT)) * __uint_as_float(__hip_atomic_load(nrm + 1, __ATOMIC_RELAXED, __HIP_MEMORY_SCOPE_AGENT)));
    const bool small = __builtin_amdgcn_readfirstlane((int)(bnd < 60.0f)) != 0;
    if (small) flash_pass<4, true>(lds, q0, DK, 512, DV, 512, ntiles, O, l0); else
    flash_pass<4>(lds, q0, DK, 512, DV, 512, ntiles, O, l0);
    { const float inv = 1.0f / l0;
#pragma unroll
      for (int mb = 0; mb < 4; ++mb)
#pragma unroll
          for (int g = 0; g < 4; ++g) { const int dv = 32 * mb + 8 * g + 4 * h;
              *(u32x2*)(qp + dv) = (u32x2){pk2(O[mb][4 * g] * inv, O[mb][4 * g + 1] * inv), pk2(O[mb][4 * g + 2] * inv, O[mb][4 * g + 3] * inv)}; } }
    if (small) flash_pass<4, true>(lds, q1, DK + 64, 512, DV, 512, ntiles, O, l0); else
    flash_pass<4>(lds, q1, DK + 64, 512, DV, 512, ntiles, O, l0);
    { const float s1 = lam / l0; float ss = 0.f;
#pragma unroll
      for (int mb = 0; mb < 4; ++mb)
#pragma unroll
          for (int g = 0; g < 4; ++g) { const int dv = 32 * mb + 8 * g + 4 * h; const u32x2 o0 = *(const u32x2*)(qp + dv);
              const float a0 = bflo(o0[0]) - s1 * O[mb][4 * g], a1 = bfhi(o0[0]) - s1 * O[mb][4 * g + 1], a2 = bflo(o0[1]) - s1 * O[mb][4 * g + 2], a3 = bfhi(o0[1]) - s1 * O[mb][4 * g + 3];
              O[mb][4 * g] = a0; O[mb][4 * g + 1] = a1; O[mb][4 * g + 2] = a2; O[mb][4 * g + 3] = a3; ss += a0 * a0 + a1 * a1 + a2 * a2 + a3 * a3; }
      ss += __shfl_xor(ss, 32);
      const float rs = __builtin_amdgcn_rsqf(ss * (1.0f / 128.0f) + EPS) * (1.0f - lam_init);
      const float* sg = P.in[I_SUBLN] + l * 128;
#pragma unroll
      for (int mb = 0; mb < 4; ++mb)
#pragma unroll
          for (int g = 0; g < 4; ++g) { const int dv = 32 * mb + 8 * g + 4 * h; const f32x4 gg = *(const f32x4*)(sg + dv);
              *(u32x2*)(qp + dv) = (u32x2){pk2(O[mb][4 * g] * rs * gg[0], O[mb][4 * g + 1] * rs * gg[1]), pk2(O[mb][4 * g + 2] * rs * gg[2], O[mb][4 * g + 3] * rs * gg[3])}; }
    }
}
DI void gqa_unit(LAS unsigned char* lds, const Ptrs& P, int l, int b, int qh, int qrow0, int key0, int ntiles) {
    const int tid = tid_(); const int lane = tid & 63, wv = tid >> 6, r = lane & 31, h = lane >> 5;
    bf16_t* BRQ = (bf16_t*)(P.ws + A_BRQ);
    const int kvh = qh >> 2;
    const bf16_t* GK = (const bf16_t*)(P.ws + A_GK) + (size_t)(b * LKV + key0) * 128 + kvh * 64;
    const bf16_t* GV = (const bf16_t*)(P.ws + A_GV) + (size_t)(b * LKV + key0) * 128 + kvh * 64;
    bf16_t* qp = BRQ + (size_t)(qrow0 + wv * 32 + r) * KBR + 896 + qh * 64;
    bf16x8 q0[4];
#pragma unroll
    for (int c = 0; c < 4; ++c) q0[c] = *(const bf16x8*)(qp + 16 * c + 8 * h);
    f32x16 O[2]; float l0;
    float mq = fabsf(P.in[I_QNORM][l * 64 + lane]), mk = fabsf(P.in[I_KNORM][l * 64 + lane]);
#pragma unroll
    for (int o = 32; o >= 1; o >>= 1) { mq = fmaxf(mq, __shfl_xor(mq, o)); mk = fmaxf(mk, __shfl_xor(mk, o)); }
    const bool small = __builtin_amdgcn_readfirstlane((int)(64.0f * QSCALE * 1.02f * mq * mk < 60.0f)) != 0;
    if (small) flash_pass<2, true>(lds, q0, GK, 128, GV, 128, ntiles, O, l0);
    else flash_pass<2, false>(lds, q0, GK, 128, GV, 128, ntiles, O, l0);
    const float inv = 1.0f / l0;
#pragma unroll
    for (int mb = 0; mb < 2; ++mb)
#pragma unroll
        for (int g = 0; g < 4; ++g) { const int dv = 32 * mb + 8 * g + 4 * h;
            *(u32x2*)(qp + dv) = (u32x2){pk2(O[mb][4 * g] * inv, O[mb][4 * g + 1] * inv), pk2(O[mb][4 * g + 2] * inv, O[mb][4 * g + 3] * inv)}; }
}

DI void gqa_pair_pass(LAS unsigned char* lds, const bf16x8 (&qf)[2][4], const bf16_t* Kg, const bf16_t* Vg, int ntiles, f32x16 (&O)[2][2], float (&lsum)[2]) {
    constexpr int VP = 192, VBUF = 64 * VP;
    const int tid = tid_(), lane = tid & 63;
    const int r = lane & 31, h = lane >> 5, i16 = lane & 15, q4 = i16 >> 2, p4 = i16 & 3, blk = (lane >> 4) & 1;
    const int kkey = tid >> 3, kch = tid & 7;
    const unsigned kwoff = kkey * AK_PITCH + kch * 16, vwoff = kkey * VP + kch * 16;
    const unsigned vrd = (4 * h + q4) * VP + 32 * blk + 8 * p4, krd = r * AK_PITCH + 16 * h;
    const bf16_t* kgp = Kg + (size_t)kkey * 128 + kch * 8; const bf16_t* vgp = Vg + (size_t)kkey * 128 + kch * 8;
#pragma unroll
    for (int hh = 0; hh < 2; ++hh) { lsum[hh] = 0.f;
#pragma unroll
        for (int mb = 0; mb < 2; ++mb)
#pragma unroll
            for (int i = 0; i < 16; ++i) O[hh][mb][i] = 0.f; }
    u32x4 kreg = *(const u32x4*)kgp, vreg = *(const u32x4*)vgp;
    __syncthreads();
    *(LAS u32x4*)(lds + kwoff) = kreg; *(LAS u32x4*)(lds + AV_OFF + vwoff) = vreg;
    kreg = *(const u32x4*)(kgp + (size_t)64 * 128); vreg = *(const u32x4*)(vgp + (size_t)64 * 128);
    __syncthreads();
    for (int t = 0; t < ntiles; ++t) {
        if (t + 1 < ntiles) { *(LAS u32x4*)(lds + ((t + 1) & 1) * AK_BUF + kwoff) = kreg; *(LAS u32x4*)(lds + AV_OFF + ((t + 1) & 1) * VBUF + vwoff) = vreg; }
        if (t + 2 < ntiles) { kreg = *(const u32x4*)(kgp + (size_t)(t + 2) * 64 * 128); vreg = *(const u32x4*)(vgp + (size_t)(t + 2) * 64 * 128); }
        const LAS unsigned char* Kb = lds + (t & 1) * AK_BUF + krd;
        const LAS unsigned char* Vb = lds + AV_OFF + (t & 1) * VBUF + vrd;
        f32x16 S[2][2];
#pragma unroll
        for (int hh = 0; hh < 2; ++hh)
#pragma unroll
            for (int kb = 0; kb < 2; ++kb)
#pragma unroll
                for (int i = 0; i < 16; ++i) S[hh][kb][i] = 0.f;
#pragma unroll
        for (int cg2 = 0; cg2 < 2; ++cg2) {
            bf16x8 kf[4];
#pragma unroll
            for (int cc = 0; cc < 2; ++cc) { const int c = 2 * cg2 + cc; kf[2 * cc] = *(const LAS bf16x8*)(Kb + 32 * c); kf[2 * cc + 1] = *(const LAS bf16x8*)(Kb + 32 * AK_PITCH + 32 * c); }
#pragma unroll
            for (int cc = 0; cc < 2; ++cc)
#pragma unroll
                for (int hh = 0; hh < 2; ++hh) {
                    S[hh][0] = __builtin_amdgcn_mfma_f32_32x32x16_bf16(kf[2 * cc], qf[hh][2 * cg2 + cc], S[hh][0], 0, 0, 0);
                    S[hh][1] = __builtin_amdgcn_mfma_f32_32x32x16_bf16(kf[2 * cc + 1], qf[hh][2 * cg2 + cc], S[hh][1], 0, 0, 0);
                }
            __builtin_amdgcn_sched_barrier(0);
        }
        __builtin_amdgcn_sched_barrier(0);
        bf16x8 pf[2][4];
#pragma unroll
        for (int hh = 0; hh < 2; ++hh) {
#pragma unroll
            for (int i = 0; i < 16; ++i) { S[hh][0][i] = __builtin_amdgcn_exp2f(S[hh][0][i]); S[hh][1][i] = __builtin_amdgcn_exp2f(S[hh][1][i]); }
            f32x2 ps2 = (f32x2){0.f, 0.f};
#pragma unroll
            for (int i = 0; i < 8; ++i) { ps2 += (f32x2){S[hh][0][2 * i], S[hh][0][2 * i + 1]}; ps2 += (f32x2){S[hh][1][2 * i], S[hh][1][2 * i + 1]}; }
            lsum[hh] += ps2.x + ps2.y;
#pragma unroll
            for (int cp = 0; cp < 2; ++cp) {
                u32x4 w0, w1;
#pragma unroll
                for (int q = 0; q < 4; ++q) { w0[q] = pk2(S[hh][0][8 * cp + 2 * q], S[hh][0][8 * cp + 2 * q + 1]); w1[q] = pk2(S[hh][1][8 * cp + 2 * q], S[hh][1][8 * cp + 2 * q + 1]); }
                pf[hh][cp] = __builtin_bit_cast(bf16x8, w0); pf[hh][2 + cp] = __builtin_bit_cast(bf16x8, w1);
            }
        }
        __builtin_amdgcn_sched_barrier(0);
#pragma unroll
        for (int kc = 0; kc < 4; ++kc)
#pragma unroll
            for (int mb = 0; mb < 2; ++mb) {
                const s16x4 lo = __builtin_amdgcn_ds_read_tr16_b64_v4i16((LAS s16x4*)(Vb + (16 * kc) * VP + 64 * mb));
                const s16x4 hi = __builtin_amdgcn_ds_read_tr16_b64_v4i16((LAS s16x4*)(Vb + (16 * kc + 8) * VP + 64 * mb));
                const bf16x8 a = __builtin_shufflevector(lo, hi, 0, 1, 2, 3, 4, 5, 6, 7);
#pragma unroll
                for (int hh = 0; hh < 2; ++hh) O[hh][mb] = __builtin_amdgcn_mfma_f32_32x32x16_bf16(a, pf[hh][kc], O[hh][mb], 0, 0, 0);
            }
        ATT_BAR();
    }
#pragma unroll
    for (int hh = 0; hh < 2; ++hh) lsum[hh] += __shfl_xor(lsum[hh], 32);
}
DI void gqa_pair_unit(LAS unsigned char* lds, const Ptrs& P, int l, int b, int qh, int qrow0, int key0, int ntiles) {
    const int tid = tid_(); const int lane = tid & 63, wv = tid >> 6, r = lane & 31, h = lane >> 5;
    bf16_t* BRQ = (bf16_t*)(P.ws + A_BRQ);
    const int kvh = qh >> 2;
    const bf16_t* GK = (const bf16_t*)(P.ws + A_GK) + (size_t)(b * LKV + key0) * 128 + kvh * 64;
    const bf16_t* GV = (const bf16_t*)(P.ws + A_GV) + (size_t)(b * LKV + key0) * 128 + kvh * 64;
    bf16_t* qp = BRQ + (size_t)(qrow0 + wv * 32 + r) * KBR + 896 + qh * 64;
    bf16x8 qf[2][4];
#pragma unroll
    for (int hh = 0; hh < 2; ++hh)
#pragma unroll
        for (int c = 0; c < 4; ++c) qf[hh][c] = *(const bf16x8*)(qp + hh * 64 + 16 * c + 8 * h);
    f32x16 O[2][2]; float ls[2];
    gqa_pair_pass(lds, qf, GK, GV, ntiles, O, ls);
#pragma unroll
    for (int hh = 0; hh < 2; ++hh) { const float inv = 1.0f / ls[hh];
#pragma unroll
        for (int mb = 0; mb < 2; ++mb)
#pragma unroll
            for (int g = 0; g < 4; ++g) { const int dv = 32 * mb + 8 * g + 4 * h;
                *(u32x2*)(qp + hh * 64 + dv) = (u32x2){pk2(O[hh][mb][4 * g] * inv, O[hh][mb][4 * g + 1] * inv), pk2(O[hh][mb][4 * g + 2] * inv, O[hh][mb][4 * g + 3] * inv)}; } }
}

DI void conv_unit(LAS unsigned char* lds, const Ptrs& P, int l, int m0, int s0, int Ls) {
    const int tid = tid_(), lane = tid & 63, wv = tid >> 6;
    LAS bf16_t* vs = (LAS bf16_t*)lds;
    LAS float* wsm = (LAS float*)(lds + 94 * 384 * 2);
    const bf16_t* V = (const bf16_t*)(P.ws + A_V);
    __syncthreads();
    for (int idx = tid; idx < 94 * 48; idx += NTHREADS) { const int rr = idx / 48, ch = idx % 48; const int row = m0 - 15 + rr;
        u32x4 v = (u32x4){0u, 0u, 0u, 0u};
        if (row >= s0 && row < s0 + Ls) v = *(const u32x4*)(V + (size_t)row * 384 + ch * 8);
        *(LAS u32x4*)(vs + rr * 384 + ch * 8) = v; }
    const float* dw = P.in[I_CONVDW] + (size_t)l * 31 * 384;
    for (int idx = tid; idx < 31 * 384; idx += NTHREADS) wsm[idx] = dw[idx];
    __syncthreads();
    const float* bias = P.in[I_CONVB] + l * 384; const float* lg = P.in[I_CONVLNG] + l * 384; const float* lb = P.in[I_CONVLNB] + l * 384;
    const int c0 = lane * 6;
    bf16_t* BRQ = (bf16_t*)(P.ws + A_BRQ);
    float a[8][6];
#pragma unroll
    for (int tt = 0; tt < 8; ++tt)
#pragma unroll
        for (int c = 0; c < 6; ++c) a[tt][c] = bias[c0 + c];
    const LAS bf16_t* vbase = vs + (wv * 8) * 384 + c0;
#pragma unroll 1
    for (int j = 0; j < 31; ++j) {
        const LAS float* wp = wsm + j * 384 + c0;
        const f32x2 w01 = *(const LAS f32x2*)wp, w23 = *(const LAS f32x2*)(wp + 2), w45 = *(const LAS f32x2*)(wp + 4);
#pragma unroll
        for (int tt = 0; tt < 8; ++tt) {
            const LAS unsigned* vp = (const LAS unsigned*)(vbase + (tt + j) * 384);
            const unsigned v0 = vp[0], v1 = vp[1], v2 = vp[2];
            a[tt][0] += w01.x * bflo(v0); a[tt][1] += w01.y * bfhi(v0); a[tt][2] += w23.x * bflo(v1); a[tt][3] += w23.y * bfhi(v1); a[tt][4] += w45.x * bflo(v2); a[tt][5] += w45.y * bfhi(v2);
        }
    }
    float lgv[6], lbv[6];
#pragma unroll
    for (int c = 0; c < 6; ++c) { lgv[c] = lg[c0 + c]; lbv[c] = lb[c0 + c]; }
#pragma unroll
    for (int tt = 0; tt < 8; ++tt) {
        float s = a[tt][0] + a[tt][1] + a[tt][2] + a[tt][3] + a[tt][4] + a[tt][5];
        s = wave_sum(s);
        const float mu = s * (1.0f / 384.0f);
        float q = 0.f;
#pragma unroll
        for (int c = 0; c < 6; ++c) { const float d = a[tt][c] - mu; q += d * d; }
        q = wave_sum(q);
        const float rs = __builtin_amdgcn_rsqf(q * (1.0f / 384.0f) + EPS);
        float o[6];
#pragma unroll
        for (int c = 0; c < 6; ++c) { const float y = (a[tt][c] - mu) * rs * lgv[c] + lbv[c]; o[c] = y * sigmoidf_(y); }
        unsigned* dst = (unsigned*)(BRQ + (size_t)(m0 + wv * 8 + tt) * KBR + 1408 + c0);
        dst[0] = pk2(o[0], o[1]); dst[1] = pk2(o[2], o[3]); dst[2] = pk2(o[4], o[5]);
    }
}


#define XB_TMO      128
#define XB_XCNT(j)  (256  + 64 * (j))
#define XB_XSUB(j)  (1280 + 64 * (j))
#define XB_XGEN(j)  (2304 + 64 * (j))
#define XB_TOP      3328
#define XB_TOPGEN   3392
#define XCD_BAR_WORDS 3456
#define XB_SPIN_CAP (1u << 20)
DI unsigned xb_ld(unsigned* p)              { return __hip_atomic_load(p, __ATOMIC_RELAXED, __HIP_MEMORY_SCOPE_AGENT); }
DI unsigned xb_add(unsigned* p, unsigned v) { return __hip_atomic_fetch_add(p, v, __ATOMIC_RELAXED, __HIP_MEMORY_SCOPE_AGENT); }
DI unsigned xb_xcc_id() { return (unsigned)__builtin_amdgcn_s_getreg((3 << 11) | 20) & 0xFu; }
#define XB_SPIN(cond, bar) do { unsigned _sp = 0; while (cond) { __builtin_amdgcn_s_sleep(1); \
    if ((++_sp & 255u) == 0u) { if (xb_ld(&(bar)[XB_TMO])) break; if (_sp > XB_SPIN_CAP) { atomicAdd(&(bar)[XB_TMO], 1u); break; } } } } while (0)
struct XcdBarrier { unsigned* bar; unsigned x; volatile LAS unsigned* st; };
DI XcdBarrier xcd_barrier_post(unsigned* bar, volatile LAS unsigned* st) {
    XcdBarrier b; b.bar = bar; b.x = xb_xcc_id(); b.st = st;
    if (threadIdx.x == 0) (void)xb_add(&bar[XB_XCNT(b.x)], 1u);
    return b;
}
DI void xcd_barrier_complete(unsigned* bar, unsigned x, unsigned& nloc, unsigned& nx) {
    const unsigned G = gridDim.x * gridDim.y * gridDim.z;
    unsigned sum, cnt, mine, sp = 0u;
    for (;;) {
        sum = 0u; cnt = 0u; mine = 0u;
#pragma unroll
        for (unsigned j = 0; j < 16; ++j) { const unsigned c = xb_ld(&bar[XB_XCNT(j)]); sum += c; cnt += (c > 0u) ? 1u : 0u; mine = (j == x) ? c : mine; }
        if (sum == G) break;
        __builtin_amdgcn_s_sleep(1);
        if ((++sp & 255u) == 0u) { if (xb_ld(&bar[XB_TMO])) break; if (sp > XB_SPIN_CAP) { atomicAdd(&bar[XB_TMO], 1u); break; } }
    }
    nloc = mine > 0u ? mine : 1u; nx = cnt > 0u ? cnt : 1u;
}
DI void xcd_barrier(const XcdBarrier& b) {
    asm volatile("s_waitcnt vmcnt(0)" ::: "memory");
    __syncthreads();
    if (threadIdx.x == 0) {
        unsigned* bar = b.bar;
        __builtin_amdgcn_s_waitcnt(0);
        unsigned nloc = b.st[0], nx = b.st[1];
        if (nloc == 0u) { xcd_barrier_complete(bar, b.x, nloc, nx); b.st[0] = nloc; b.st[1] = nx; }
        const unsigned old = xb_add(&bar[XB_XSUB(b.x)], 1u);
        const unsigned gen = old / nloc;
        if (old + 1u == (gen + 1u) * nloc) {
            __builtin_amdgcn_fence(__ATOMIC_RELEASE, "agent");
            asm volatile("s_waitcnt vmcnt(0)" ::: "memory");
            const unsigned og = xb_add(&bar[XB_TOP], 1u);
            const unsigned tg = og / nx;
            if (og + 1u == (tg + 1u) * nx) xb_add(&bar[XB_TOPGEN], 1u);
            else XB_SPIN(xb_ld(&bar[XB_TOPGEN]) == tg, bar);
            __builtin_amdgcn_fence(__ATOMIC_ACQUIRE, "agent");
            xb_add(&bar[XB_XGEN(b.x)], 1u);
            asm volatile("s_waitcnt vmcnt(0)" ::: "memory");
        } else {
            XB_SPIN(xb_ld(&bar[XB_XGEN(b.x)]) == gen, bar);
            __builtin_amdgcn_fence(__ATOMIC_ACQUIRE, "agent");
            asm volatile("s_waitcnt vmcnt(0)" ::: "memory");
        }
    }
    __syncthreads();
}

struct KArgs { Ptrs p; int ph_lo, ph_hi; };

__global__ void __launch_bounds__(NTHREADS, 2) fwd_mega(KArgs args) {
    extern __shared__ __attribute__((aligned(16))) unsigned char lds_raw[];
    LAS unsigned char* lds = (LAS unsigned char*)lds_raw;
    cg::grid_group grid = cg::this_grid();
    const Ptrs& P = args.p;
    unsigned char* ws = P.ws;
    const int tid = threadIdx.x, bid = blockIdx.x, G = gridDim.x;
    unsigned* ctl = (unsigned*)(ws + OFF_CTL);
    float* misc = (float*)(ws + OFF_MISC);
    int ph = 0;
    if (args.ph_hi < 0) grid.sync();
    volatile LAS unsigned* xst = (volatile LAS unsigned*)(lds + 131072 + 16);
    if (tid == 0) { xst[0] = 0u; xst[1] = 0u; }
    __syncthreads();
    { const XcdBarrier xb0 = xcd_barrier_post((unsigned*)(ws + OFF_BAR), xst); if (tid == 0) xst[2] = xb0.x; }
    __syncthreads();
#define PHASE_BEGIN if (ph >= args.ph_lo && ph < args.ph_hi) {
#define PHASE_END(dosync_) if ((dosync_) && ph + 1 < args.ph_hi) { XcdBarrier xb_; xb_.bar = (unsigned*)(args.p.ws + OFF_BAR); xb_.st = (volatile LAS unsigned*)(lds + 131072 + 16); xb_.x = xb_.st[2]; xcd_barrier(xb_); } } ++ph;

    PHASE_BEGIN
        if (bid == 0) {
            if (tid < 64) ctl[tid] = 0u;
            if (tid < 2) { const float* lv = P.in[I_LAMBDA] + tid * 256; float s0 = 0.f, s1 = 0.f;
                for (int i = 0; i < 64; ++i) { s0 += lv[i] * lv[64 + i]; s1 += lv[128 + i] * lv[192 + i]; }
                const float li = 0.8f - 0.6f * expf(-0.3f * (float)tid);
                misc[tid * 2] = expf(s0) - expf(s1) + li; misc[tid * 2 + 1] = li; }
            for (int i = tid; i < 64 * 16; i += NTHREADS) { const int pos = i >> 4, f = i & 15; const float inv = powf(10000.0f, -(float)f / 16.0f); const float ang = (float)pos * inv;
                ((f32x2*)(ws + OFF_ROPE))[i] = (f32x2){cosf(ang), sinf(ang)}; }
        }
        mod_gemv(lds, P, bid, G);
        conv_win(lds, P, 0, bid, G);
        gen_dft(lds, ws, bid, G, true);
    PHASE_END(true)
    PHASE_BEGIN
        rows_first(P);
    PHASE_END(true)

    for (int l = 0; l < 2; ++l) {
        const int nMt = l == 0 ? 68 : 64;
        PHASE_BEGIN
            RectSched S{(const char*)(ws + OFF_HS), (const char*)(ws + OFF_WINT), (size_t)256 * D * 2, (size_t)256 * D * 2, 16, G, bid, nMt, 15, 64, l == 0 ? 0 : 4, 5};
            EpiInA E{ws, P.in[I_QNORM] + l * 64, P.in[I_KNORM] + l * 64, lds + 131072 + 256, ctl + 32 + 2 * l};
            pg8::gemm_phase(lds, D, D, S, E);
        PHASE_END(true)
        PHASE_BEGIN
            fourier_fold(ws, bid, G);
        PHASE_END(true)
        PHASE_BEGIN
            if (bid < 96) {
                OneSched S; S.have = true; S.u.pm = bid & 15; S.u.pn = bid >> 4; S.u.nt = 64;
                S.u.A = (const char*)(ws + A_DFT) + (size_t)S.u.pm * 256 * 4096 * 2; S.u.B = (const char*)(ws + A_FTF) + (size_t)S.u.pn * 256 * 4096 * 2;
                EpiFourier E{(bf16_t*)(ws + A_BRQ), 0, SEQ, 1.0f / 512.0f};
                pg8::gemm_phase(lds, 4096, 4096, S, E);
            } else if (l == 0 && bid < 102) {
                OneSched S; S.have = true; S.u.pm = 0; S.u.pn = bid - 96; S.u.nt = 8;
                S.u.A = (const char*)(ws + OFF_DFTC); S.u.B = (const char*)(ws + A_FTC) + (size_t)S.u.pn * 256 * 512 * 2;
                EpiFourier E{(bf16_t*)(ws + A_BRQ), MLAT, LC, 1.0f / 128.0f};
                pg8::gemm_phase(lds, 512, 512, S, E);
            }
            {
                const float lam = __uint_as_float(__builtin_amdgcn_readfirstlane(__float_as_uint(misc[l * 2]))), lam_init = __uint_as_float(__builtin_amdgcn_readfirstlane(__float_as_uint(misc[l * 2 + 1])));
                bool gsmall;
                { float mq = fabsf(P.in[I_QNORM][l * 64 + (tid & 63)]), mk = fabsf(P.in[I_KNORM][l * 64 + (tid & 63)]);
#pragma unroll
                  for (int o = 32; o >= 1; o >>= 1) { mq = fmaxf(mq, __shfl_xor(mq, o)); mk = fmaxf(mk, __shfl_xor(mk, o)); }
                  gsmall = __builtin_amdgcn_readfirstlane((int)(64.0f * QSCALE * 1.02f * mq * mk < 60.0f)) != 0; }
                const int n_diff = 32, n_gqa = 32, n_cd = l == 0 ? 2 : 0, n_cg = l == 0 ? 2 : 0, n_conv = l == 0 ? 34 : 32;
                const int total = n_diff + n_gqa + n_cd + n_cg + n_conv;
                volatile LAS int* slot = (volatile LAS int*)(lds + 131072);
                for (int dx = 0; dx < 8; ++dx) {
                    const int x = (bid + dx) & 7;
                    for (;;) {
                        __syncthreads();
                        if (tid == 0) *slot = (int)atomicAdd(ctl + l * 8 + x, 1u);
                        __syncthreads();
                        int it = *slot;
                        if (it >= total) break;
                        if (it < n_diff) { const int pi = 2 * x + (it >> 4), b = pi >> 2, hd = pi & 3, qb = it & 15; diff_unit(lds, P, l, b, hd, b * SEQ + qb * 256, 0, LKV / 64, lam, lam_init); continue; }
                        it -= n_diff;
                        if (it < n_gqa) { const int b = x >> 1, qh = (x & 1) * 4 + 2 * (it >> 4), qb = it & 15; if (gsmall) gqa_pair_unit(lds, P, l, b, qh, b * SEQ + qb * 256, 0, LKV / 64);
                            else {
#pragma nounroll
                                for (int hh = 0; hh < 2; ++hh) gqa_unit(lds, P, l, b, qh + hh, b * SEQ + qb * 256, 0, LKV / 64); }
                            continue; }
                        it -= n_gqa;
                        if (it < n_cd) { const int pi = 2 * x + it, b = pi >> 2, hd = pi & 3; diff_unit(lds, P, l, b, hd, MLAT + b * LC, SEQ, LC / 64, lam, lam_init); continue; }
                        it -= n_cd;
                        if (it < n_cg) { const int b = x >> 1, qh = (x & 1) * 4 + 2 * it; if (gsmall) gqa_pair_unit(lds, P, l, b, qh, MLAT + b * LC, SEQ, LC / 64);
                            else {
#pragma nounroll
                                for (int hh = 0; hh < 2; ++hh) gqa_unit(lds, P, l, b, qh + hh, MLAT + b * LC, SEQ, LC / 64); }
                            continue; }
                        it -= n_cg;
                        { const int m0 = (x * n_conv + it) * 64; int s0, Ls; if (m0 < MLAT) { s0 = m0 & ~4095; Ls = SEQ; } else { s0 = MLAT + ((m0 - MLAT) & ~255); Ls = LC; }
                          conv_unit(lds, P, l, m0, s0, Ls); }
                    }
                }
                __syncthreads();
            }
        PHASE_END(true)
        PHASE_BEGIN
            {
                bf16_t* wbr = (bf16_t*)(ws + A_WBRT);
                convT(lds, P.in[I_WBRF] + (size_t)l * 384 * D, D, 384, wbr, KBR, D, MapId{0}, bid, G);
                convT(lds, P.in[I_WBRD] + (size_t)l * 512 * D, D, 512, wbr + 384, KBR, D, MapId{0}, (bid + 48) % G, G);
                convT(lds, P.in[I_WBRG] + (size_t)l * 512 * D, D, 512, wbr + 896, KBR, D, MapId{0}, (bid + 112) % G, G);
                convT(lds, P.in[I_WBRC] + (size_t)l * 384 * D, D, 384, wbr + 1408, KBR, D, MapId{0}, (bid + 176) % G, G);
                convT(lds, P.in[I_WOUT] + (size_t)l * D * D, D, D, (bf16_t*)(ws + A_WOUTT), D, D, MapId{0}, (bid + 224) % G, G);
                __syncthreads();
            }
            RectSched S{(const char*)(ws + OFF_HS), (const char*)(ws + OFF_WINT) + (size_t)3840 * D * 2, (size_t)256 * D * 2, (size_t)256 * D * 2, 16, G, bid, nMt, 16, 0, 0, 0};
            EpiBf16<1> E{(bf16_t*)(ws + A_G), 4096};
            pg8::gemm_phase(lds, D, D, S, E);
        PHASE_END(true)
        PHASE_BEGIN
            RectSched S{(const char*)(ws + A_BRQ), (const char*)(ws + A_WBRT), (size_t)256 * KBR * 2, (size_t)256 * KBR * 2, 28, G, bid, nMt, 4, 0, 0, 0};
            EpiBranch E{(const bf16_t*)(ws + A_G), (bf16_t*)(ws + OFF_HS)};
            pg8::gemm_phase(lds, KBR, KBR, S, E);
        PHASE_END(true)
        PHASE_BEGIN
            RectSched S{(const char*)(ws + OFF_HS), (const char*)(ws + A_WOUTT), (size_t)256 * D * 2, (size_t)256 * D * 2, 16, G, bid, nMt, 4, 0, 0, 0};
            EpiBf16<0> E{(bf16_t*)(ws + A_MIXO), D};
            pg8::gemm_phase(lds, D, D, S, E);
        PHASE_END(true)
        PHASE_BEGIN
            rows_update(P, l, 0, l == 0 ? MTOT : MLAT);
            convT(lds, P.in[I_WFF1] + (size_t)l * D * DFF, DFF, D, (bf16_t*)(ws + A_WFF1T), D, DFF, MapId{0}, bid, G);
            convT(lds, P.in[I_WFF2] + (size_t)l * DFF * D, D, DFF, (bf16_t*)(ws + A_WFF2T), DFF, D, MapId{0}, bid, G);
        PHASE_END(true)
        PHASE_BEGIN
            RectSched S{(const char*)(ws + OFF_HS), (const char*)(ws + A_WFF1T), (size_t)256 * D * 2, (size_t)256 * D * 2, 16, G, bid, nMt, 16, 0, 0, 0};
            EpiBf16<2> E{(bf16_t*)(ws + A_FF), DFF};
            pg8::gemm_phase(lds, D, D, S, E);
        PHASE_END(true)
        PHASE_BEGIN
            RectSched S{(const char*)(ws + A_FF), (const char*)(ws + A_WFF2T), (size_t)256 * DFF * 2, (size_t)256 * DFF * 2, 64, G, bid, nMt, 4, 0, 0, 0};
            EpiBf16<0> E{(bf16_t*)(ws + A_MIXO), D};
            pg8::gemm_phase(lds, DFF, DFF, S, E);
        PHASE_END(true)
        PHASE_BEGIN
            rows_update(P, l, 1, l == 0 ? MTOT : MLAT);
            if (l == 0) { conv_win(lds, P, 1, bid, G); gen_dft(lds, ws, bid, G, false); }
        PHASE_END(l == 0)
    }
}

extern "C" void kernel_launch(void* const* d_in, const int* in_sizes, int n_in, void* d_out, int out_size, void* d_ws, size_t ws_size, hipStream_t stream) {
    static int grid = 0;
    if (grid == 0) {
        if (n_in != 26 || ws_size < WS_END) { fprintf(stderr, "kernel_launch: unexpected inputs (%d) or workspace (%zu < %zu)\n", n_in, ws_size, (size_t)WS_END); grid = -1; return; }
        int dev = 0, cus = 0, per_cu = 0;
        (void)hipGetDevice(&dev);
        (void)hipDeviceGetAttribute(&cus, hipDeviceAttributeMultiprocessorCount, dev);
        if (hipFuncSetAttribute((const void*)fwd_mega, hipFuncAttributeMaxDynamicSharedMemorySize, LDS_BYTES) != hipSuccess) { fprintf(stderr, "hipFuncSetAttribute failed\n"); grid = -1; return; }
        if (hipOccupancyMaxActiveBlocksPerMultiprocessor(&per_cu, (const void*)fwd_mega, NTHREADS, LDS_BYTES) != hipSuccess || per_cu < 1) { fprintf(stderr, "occupancy query: %d\n", per_cu); per_cu = 1; }
        (void)hipGetLastError();
        grid = cus * per_cu;
        if (grid > 256) grid = 256;
    }
    if (grid < 0) return;
    KArgs a{};
    for (int i = 0; i < 26; ++i) a.p.in[i] = (const float*)d_in[i];
    a.p.out = (float*)d_out; a.p.ws = (unsigned char*)d_ws;
#ifndef PROBE_RANGES
#define PROBE_RANGES {0, 1000}
#endif
    static const int ranges[][2] = { PROBE_RANGES };
    const int nr = (int)(sizeof(ranges) / sizeof(ranges[0]));
    for (int i = 0; i < nr; ++i) {
        if (i > 0) (void)hipMemsetAsync((char*)d_ws + OFF_CTL, 0, 256, stream);
        (void)hipMemsetAsync((char*)d_ws + OFF_BAR, 0, 16384, stream);
        a.ph_lo = ranges[i][0]; a.ph_hi = ranges[i][1];
        void* kargs[] = {&a};
        hipError_t e = hipLaunchCooperativeKernel((const void*)fwd_mega, dim3(grid), dim3(NTHREADS), kargs, LDS_BYTES, stream);
        if (e != hipSuccess) fprintf(stderr, "cooperative launch failed: %s (grid %d)\n", hipGetErrorString(e), grid);
    }
}
```

```cpp
#include <hip/hip_runtime.h>
#include <hip/hip_cooperative_groups.h>
#include <cstdint>
#include <cstdio>
namespace cg = cooperative_groups;

#define LAS __attribute__((address_space(3)))
#define DI __device__ __forceinline__
typedef unsigned short bf16_t;
typedef short bf16x8 __attribute__((ext_vector_type(8)));
typedef short s16x4 __attribute__((ext_vector_type(4)));
typedef float f32x4 __attribute__((ext_vector_type(4)));
typedef float f32x2 __attribute__((ext_vector_type(2)));
typedef float f32x16 __attribute__((ext_vector_type(16)));
typedef unsigned u32x4 __attribute__((ext_vector_type(4)));
typedef unsigned u32x2 __attribute__((ext_vector_type(2)));
typedef __bf16 bf16x2_t __attribute__((ext_vector_type(2)));

DI unsigned pk2(float lo, float hi) { f32x2 v = {lo, hi}; return __builtin_bit_cast(unsigned, __builtin_convertvector(v, bf16x2_t)); }
DI float bflo(unsigned u) { return __uint_as_float(u << 16); }
DI float bfhi(unsigned u) { return __uint_as_float(u & 0xffff0000u); }
DI float sigmoidf_(float x) { return __builtin_amdgcn_rcpf(1.0f + __builtin_amdgcn_exp2f(-1.44269504f * x)); }
DI int tid_() { int t = threadIdx.x; asm volatile("" : "+v"(t)); return t; }
DI float wave_sum(float v) {
#pragma unroll
    for (int o = 32; o >= 1; o >>= 1) v += __shfl_xor(v, o);
    return v;
}

constexpr int D = 1024, NB = 4, SEQ = 4096, LC = 256, MLAT = NB * SEQ, MCTX = NB * LC, MTOT = MLAT + MCTX, LKV = SEQ + LC;
constexpr int IN_COLS = 7552, NIN = 7936, DFF = 4096, KBR = 1792;
constexpr float EPS = 1e-6f;
constexpr float QSCALE = 0.125f * 1.44269504f;
enum { I_X = 0, I_C, I_CTX, I_CCTX, I_WMOD, I_BMOD, I_GPREMIX, I_GPOSTMIX, I_GPREMLP, I_GPOSTMLP, I_WIN, I_QNORM, I_KNORM, I_LAMBDA, I_SUBLN,
       I_CONVDW, I_CONVB, I_CONVLNG, I_CONVLNB, I_WBRF, I_WBRD, I_WBRG, I_WBRC, I_WOUT, I_WFF1, I_WFF2 };

constexpr size_t OFF_CTL = 0, OFF_MISC = 4096, OFF_MOD = 8192, OFF_ROPE = 253952, OFF_DFTC = 262144, OFF_HS = 524288;
constexpr size_t OFF_WINT = OFF_HS + (size_t)MTOT * D * 2;
constexpr size_t ARENA = OFF_WINT + (size_t)NIN * D * 2;
constexpr size_t A_BRQ = ARENA, A_MIXO = ARENA;
constexpr size_t A_G = ARENA + (size_t)MTOT * KBR * 2;
constexpr size_t A_DFT = A_G;
constexpr size_t A_FTF = A_DFT + (size_t)4096 * 4096 * 2;
constexpr size_t A_FT = A_DFT + (size_t)4096 * 8192 * 2;
constexpr size_t A_FTC = A_FT + (size_t)NB * 384 * 8192 * 2;
constexpr size_t A_DK = A_FTC + (size_t)NB * 384 * 512 * 2;
constexpr size_t A_DV = A_DK + (size_t)MTOT * 512 * 2;
constexpr size_t A_GK = A_DV + (size_t)MTOT * 512 * 2;
constexpr size_t A_GV = A_GK + (size_t)MTOT * 128 * 2;
constexpr size_t A_V = A_GV + (size_t)MTOT * 128 * 2;
constexpr size_t A_VEND = A_V + (size_t)MTOT * 384 * 2;
constexpr size_t A_WBRT = A_G + (size_t)MTOT * 4096 * 2;
constexpr size_t A_WOUTT = A_WBRT + (size_t)D * KBR * 2;
constexpr size_t A_FF = ARENA + (size_t)MTOT * D * 2;
constexpr size_t A_WFF1T = A_FF + (size_t)MTOT * DFF * 2;
constexpr size_t A_WFF2T = A_WFF1T + (size_t)DFF * D * 2;
constexpr size_t A_XC = A_WFF2T + (size_t)DFF * D * 2;
constexpr size_t OFF_BAR = A_VEND;
constexpr size_t WS_END = OFF_BAR + 16384;
static_assert(A_XC + (size_t)MCTX * D * 4 <= A_WBRT, "xc overlaps");
static_assert(A_WOUTT + (size_t)D * D * 2 <= WS_END, "ws end");
static_assert(WS_END <= 268435456ull, "workspace too large");

constexpr int LDS_BYTES = 131072 + 256 + 18432;
constexpr int NTHREADS = 512;

namespace pg8 {
constexpr int BM = 256, BK = 64, HALF = 128, HTB = HALF * BK * 2, NXCD = 8, WGM = 8;
DI int lds_byte(int r, int c) { const int st = (r >> 4) * 2 + (c >> 5), rr = r & 15, cc = c & 31, ob = rr * 64 + cc * 2; return st * 1024 + (ob ^ (((ob >> 9) & 1) << 5)); }
DI void stage_rc(int b, int& R, int& C) { const int st = b / 1024, sb = b % 1024, swz = sb ^ (((sb >> 9) & 1) << 5); R = (st >> 1) * 16 + swz / 64; C = (st & 1) * 32 + (swz % 64) / 2; }
DI int perm32(int rho) { const int n = rho >> 4, i = rho & 15; return 8 * (i >> 2) + 4 * n + (i & 3); }

struct Unit { const char* A; const char* B; int nt, pm, pn; };

DI void rect_map(int L, int nM, int nN, int& pm, int& pn) {
    const int nwg = nM * nN; int wgid = L;
    { const int q = nwg / NXCD, r = nwg % NXCD, xcd = wgid % NXCD, off = wgid / NXCD; wgid = (xcd < r ? xcd * (q + 1) : r * (q + 1) + (xcd - r) * q) + off; }
    const int nig = WGM * nN, gid = wgid / nig, fm = gid * WGM, gsz = (nM - fm) < WGM ? (nM - fm) : WGM;
    pm = fm + ((wgid % nig) % gsz); pn = (wgid % nig) / gsz;
}

template <class Epi, class Sched>
DI void gemm_phase(LAS unsigned char* lds, const int lda, const int ldb, const Sched& S, const Epi& E) {
    int tid = threadIdx.x; asm volatile("" : "+v"(tid));
    const int wid = __builtin_amdgcn_readfirstlane(tid >> 6), lane = tid & 63, wr = wid >> 2, wc = wid & 3, fr = lane & 15, fq = lane >> 4;
    unsigned voffA[2], voffB[2];
#pragma unroll
    for (int i = 0; i < 2; ++i) { int R, C; stage_rc(tid * 16 + i * 8192, R, C); const int Rb = Epi::PERM ? ((R & ~31) + perm32(R & 31)) : R;
        voffA[i] = (unsigned)(R * lda + C) * 2u; voffB[i] = (unsigned)(Rb * ldb + C) * 2u; }
    const size_t kstep = (size_t)(BK * 2);
    const size_t hstepA = (size_t)HALF * lda * 2, hstepB = (size_t)HALF * ldb * 2;
    const unsigned ldsw = (unsigned)wid * 1024u;
    const int aoff = lds_byte(wr * 64 + fr, fq * 8), boff = lds_byte(wc * 32 + fr, fq * 8);
#define PG8_SA(b, h) (((b) * 2 + (h)) * HTB)
#define PG8_SB(b, h) ((4 + (b) * 2 + (h)) * HTB)
#define PG8_STAGE(bufoff, gbase, voff) do { _Pragma("unroll") for (int _i = 0; _i < 2; ++_i) \
        __builtin_amdgcn_global_load_lds((const unsigned*)((const char*)(gbase) + (voff)[_i]), (LAS unsigned*)(lds + (bufoff) + ldsw + _i * 8192), 16, 0, 0); } while (0)
#define PG8_LDA(dst, b, h) do { _Pragma("unroll") for (int m = 0; m < 4; ++m) _Pragma("unroll") for (int k = 0; k < 2; ++k) dst[m][k] = *(const LAS bf16x8*)(lds + PG8_SA(b, h) + aoff + m * 2048 + k * 1024); } while (0)
#define PG8_LDB(dst, b, h) do { _Pragma("unroll") for (int n = 0; n < 2; ++n) _Pragma("unroll") for (int k = 0; k < 2; ++k) dst[n][k] = *(const LAS bf16x8*)(lds + PG8_SB(b, h) + boff + n * 2048 + k * 1024); } while (0)
#define PG8_MMA(ai, bj, At, Bt) do { __builtin_amdgcn_s_setprio(1); _Pragma("unroll") for (int m = 0; m < 4; ++m) _Pragma("unroll") for (int n = 0; n < 2; ++n) _Pragma("unroll") for (int k = 0; k < 2; ++k) \
        acc[ai][bj][m][n] = __builtin_amdgcn_mfma_f32_16x16x32_bf16(Bt[n][k], At[m][k], acc[ai][bj][m][n], 0, 0, 0); __builtin_amdgcn_s_setprio(0); } while (0)
#define PG8_WAIT_V(n) asm volatile("s_waitcnt vmcnt(" #n ")" ::: "memory")
#define PG8_WAIT_L(n) asm volatile("s_waitcnt lgkmcnt(" #n ")" ::: "memory")
#define PG8_BAR __builtin_amdgcn_s_barrier()
#define PG8_SCHED __builtin_amdgcn_sched_barrier(0)
    Unit cur, nxt; int ui = 0;
    if (!S.next(0, cur)) return;
    f32x4 acc[2][2][4][2];
#pragma unroll
    for (int a = 0; a < 2; ++a)
#pragma unroll
        for (int b = 0; b < 2; ++b)
#pragma unroll
            for (int m = 0; m < 4; ++m)
#pragma unroll
                for (int n = 0; n < 2; ++n) acc[a][b][m][n] = (f32x4){0.f, 0.f, 0.f, 0.f};
    bf16x8 At[4][2], B0[2][2], B1[2][2];
    const char* cA = cur.A; const char* cB = cur.B;
    PG8_STAGE(PG8_SB(0, 0), cB, voffB); PG8_STAGE(PG8_SB(0, 1), cB + hstepB, voffB); PG8_STAGE(PG8_SA(0, 0), cA, voffA); PG8_STAGE(PG8_SA(0, 1), cA + hstepA, voffA);
    if (wr == 1) PG8_BAR;
    PG8_WAIT_V(2); PG8_BAR;
    PG8_STAGE(PG8_SB(1, 0), cB + kstep, voffB); PG8_STAGE(PG8_SA(1, 0), cA + kstep, voffA); PG8_STAGE(PG8_SB(1, 1), cB + hstepB + kstep, voffB);
    PG8_WAIT_V(6); PG8_BAR;
    for (;;) {
        const bool has_next = S.next(ui + 1, nxt);
        const char* nA = has_next ? nxt.A : cA; const char* nB = has_next ? nxt.B : cB;
        const int nt = cur.nt;
        for (int t = 0; t < nt; t += 2) {
            if constexpr (Epi::HOOK) { if (t == 6 || t == 14 || t == 22) E.hook(acc, cur, t, wr, wc, fr, fq); }
            const bool last = (t == nt - 2);
            const char* a1 = cA + (size_t)(t + 1) * kstep;
            const char* a2 = last ? nA : cA + (size_t)(t + 2) * kstep; const char* b2 = last ? nB : cB + (size_t)(t + 2) * kstep;
            const char* a3 = a2 + kstep; const char* b3 = b2 + kstep;
            PG8_LDB(B0, 0, 0); PG8_LDB(B1, 0, 1); PG8_SCHED; PG8_LDA(At, 0, 0); PG8_STAGE(PG8_SA(1, 1), a1 + hstepA, voffA);
            PG8_WAIT_V(8); PG8_WAIT_L(0); PG8_BAR; PG8_MMA(0, 0, At, B0); PG8_MMA(0, 1, At, B1); PG8_BAR; PG8_SCHED;
            PG8_LDA(At, 0, 1); PG8_STAGE(PG8_SB(0, 0), b2, voffB); PG8_STAGE(PG8_SB(0, 1), b2 + hstepB, voffB); PG8_STAGE(PG8_SA(0, 0), a2, voffA);
            PG8_WAIT_V(8); PG8_WAIT_L(0); PG8_BAR; PG8_MMA(1, 0, At, B0); PG8_MMA(1, 1, At, B1); PG8_BAR; PG8_SCHED;
            PG8_LDB(B0, 1, 0); PG8_LDB(B1, 1, 1); PG8_SCHED; PG8_LDA(At, 1, 0); PG8_STAGE(PG8_SA(0, 1), a2 + hstepA, voffA);
            PG8_WAIT_V(8); PG8_WAIT_L(0); PG8_BAR; PG8_MMA(0, 0, At, B0); PG8_MMA(0, 1, At, B1); PG8_BAR; PG8_SCHED;
            PG8_LDA(At, 1, 1); PG8_STAGE(PG8_SB(1, 0), b3, voffB); PG8_STAGE(PG8_SB(1, 1), b3 + hstepB, voffB); PG8_STAGE(PG8_SA(1, 0), a3, voffA);
            PG8_WAIT_V(8); PG8_WAIT_L(0); PG8_BAR; PG8_MMA(1, 0, At, B0); PG8_MMA(1, 1, At, B1); PG8_BAR; PG8_SCHED;
        }
        if (wr == 0) PG8_BAR;
        E(acc, cur, wr, wc, fr, fq);
        if (!has_next) break;
#pragma unroll
        for (int a = 0; a < 2; ++a)
#pragma unroll
            for (int b = 0; b < 2; ++b)
#pragma unroll
                for (int m = 0; m < 4; ++m)
#pragma unroll
                    for (int n = 0; n < 2; ++n) acc[a][b][m][n] = (f32x4){0.f, 0.f, 0.f, 0.f};
        cur = nxt; cA = nA; cB = nB; ++ui;
        if (wr == 1) PG8_BAR;
    }
    PG8_WAIT_V(0);
    PG8_BAR;
#undef PG8_SA
#undef PG8_SB
#undef PG8_STAGE
#undef PG8_LDA
#undef PG8_LDB
#undef PG8_MMA
#undef PG8_WAIT_V
#undef PG8_WAIT_L
#undef PG8_BAR
#undef PG8_SCHED
}
}
using pg8::Unit;
typedef f32x4 Acc[2][2][4][2];

struct RectSched {
    const char* A; const char* B; size_t astep, bstep;
    int nt, G, c, nM1, nN1, m2, nM2, nN2;
    DI bool next(int i, Unit& u) const {
        const int L = i * G + c; const int n1 = nM1 * nN1;
        int pm, pn;
        if (L < n1) pg8::rect_map(L, nM1, nN1, pm, pn);
        else if (L < n1 + nM2 * nN2) { pg8::rect_map(L - n1, nM2, nN2, pm, pn); pm += m2; }
        else return false;
        u.pm = pm; u.pn = pn; u.nt = nt; u.A = A + (size_t)pm * astep; u.B = B + (size_t)pn * bstep; return true;
    }
};
struct OneSched {
    Unit u; bool have;
    DI bool next(int i, Unit& o) const { if (i != 0 || !have) return false; o = u; return true; }
};

struct Ptrs {
    const float* in[26]; float* out; unsigned char* ws;
};

struct EpiInA {
    static constexpr bool PERM = true, HOOK = false;
    unsigned char* ws; const float* qn; const float* kn;
    LAS unsigned char* scr;
    unsigned* nrm;
    DI void hook(Acc&, const Unit&, int, int, int, int, int) const {}
    DI void operator()(const Acc& acc, const Unit& u, int wr, int wc, int fr, int fq) const {
        const int pn = u.pn;
        const f32x2* rope = (const f32x2*)(ws + OFF_ROPE);
        bf16_t* BRQ = (bf16_t*)(ws + A_BRQ);
        const bool ctx = u.pm >= 64;
        if (pn <= 1 || pn == 5 || pn == 6) {
            float nmax = 0.f;
#pragma unroll
            for (int ai = 0; ai < 2; ++ai)
#pragma unroll
                for (int m = 0; m < 4; ++m) {
                const int row = u.pm * 256 + ai * 128 + wr * 64 + m * 16 + fr;
                int b, t, kvrow;
                if (!ctx) { b = row >> 12; t = row & 4095; kvrow = b * LKV + t; }
                else { const int j = row - MLAT; b = j >> 8; t = j & 255; kvrow = b * LKV + SEQ + t; }
                const int prow = t >> 6, pcol = t & 63; (void)b; (void)kvrow; (void)prow; (void)pcol;
                    const bool isq = pn >= 5;
                    const int axis = wc & 1; const int pos = axis ? pcol : prow;
                    f32x2 cs[4];
#pragma unroll
                    for (int j = 0; j < 4; ++j) cs[j] = ctx ? (f32x2){1.f, 0.f} : rope[pos * 16 + 4 * fq + j];
#pragma unroll
                    for (int bj = 0; bj < 2; ++bj) {
                        const f32x4 re = acc[ai][bj][m][0], im = acc[ai][bj][m][1];
                        float o0[4], o1[4];
#pragma unroll
                        for (int j = 0; j < 4; ++j) { o0[j] = re[j] * cs[j].x - im[j] * cs[j].y; o1[j] = im[j] * cs[j].x + re[j] * cs[j].y; if (isq) { o0[j] *= QSCALE; o1[j] *= QSCALE; } }
                        const int c = (isq ? (pn - 5) : pn) * 256 + bj * 128 + wc * 32 + 8 * fq;
                        bf16_t* dst = isq ? (BRQ + (size_t)row * KBR + 384 + c) : ((bf16_t*)(ws + A_DK) + (size_t)kvrow * 512 + c);
                        *(u32x4*)dst = (u32x4){pk2(o0[0], o0[1]), pk2(o0[2], o0[3]), pk2(o1[0], o1[1]), pk2(o1[2], o1[3])};
                        float ss = o0[0] * o0[0] + o0[1] * o0[1] + o0[2] * o0[2] + o0[3] * o0[3] + o1[0] * o1[0] + o1[1] * o1[1] + o1[2] * o1[2] + o1[3] * o1[3];
                        ss += __shfl_xor(ss, 16); ss += __shfl_xor(ss, 32); nmax = fmaxf(nmax, ss);
                    }
                }
#pragma unroll
            for (int o = 8; o >= 1; o >>= 1) nmax = fmaxf(nmax, __shfl_xor(nmax, o));
            if (fq == 0 && fr == 0) atomicMax(nrm + (pn >= 5 ? 1 : 0), __float_as_uint(nmax));
        } else if (pn == 2 || pn == 3) {
#pragma unroll
            for (int ai = 0; ai < 2; ++ai)
#pragma unroll
                for (int m = 0; m < 4; ++m) {
                const int row = u.pm * 256 + ai * 128 + wr * 64 + m * 16 + fr;
                int b, t, kvrow;
                if (!ctx) { b = row >> 12; t = row & 4095; kvrow = b * LKV + t; }
                else { const int j = row - MLAT; b = j >> 8; t = j & 255; kvrow = b * LKV + SEQ + t; }
                const int prow = t >> 6, pcol = t & 63; (void)b; (void)kvrow; (void)prow; (void)pcol;
#pragma unroll
                    for (int bj = 0; bj < 2; ++bj)
#pragma unroll
                        for (int n = 0; n < 2; ++n) { const f32x4 v = acc[ai][bj][m][n]; const int c = (pn - 2) * 256 + bj * 128 + wc * 32 + 8 * fq + 4 * n;
                            *(u32x2*)((bf16_t*)(ws + A_DV) + (size_t)kvrow * 512 + c) = (u32x2){pk2(v[0], v[1]), pk2(v[2], v[3])}; }
                }
        } else if (pn == 4 || pn == 7 || pn == 8) {
#pragma unroll
            for (int ai = 0; ai < 2; ++ai)
#pragma unroll
                for (int m = 0; m < 4; ++m) {
                const int row = u.pm * 256 + ai * 128 + wr * 64 + m * 16 + fr;
                int b, t, kvrow;
                if (!ctx) { b = row >> 12; t = row & 4095; kvrow = b * LKV + t; }
                else { const int j = row - MLAT; b = j >> 8; t = j & 255; kvrow = b * LKV + SEQ + t; }
                const int prow = t >> 6, pcol = t & 63; (void)b; (void)kvrow; (void)prow; (void)pcol;
                    const bool isq = pn >= 7; const bool isv = (pn == 4) && wc >= 2;
                    float ss = 0.f;
#pragma unroll
                    for (int bj = 0; bj < 2; ++bj)
#pragma unroll
                        for (int n = 0; n < 2; ++n) { const f32x4 v = acc[ai][bj][m][n]; ss += v[0] * v[0] + v[1] * v[1] + v[2] * v[2] + v[3] * v[3]; }
                    ss += __shfl_xor(ss, 16); ss += __shfl_xor(ss, 32);
                    const float rs = isv ? 1.f : __builtin_amdgcn_rsqf(ss * (1.0f / 64.0f) + EPS);
                    const float* gn = isq ? qn : kn;
                    bf16_t* dst;
                    if (isq) dst = BRQ + (size_t)row * KBR + 896 + ((pn - 7) * 4 + wc) * 64;
                    else if (isv) dst = (bf16_t*)(ws + A_GV) + (size_t)kvrow * 128 + (wc - 2) * 64;
                    else dst = (bf16_t*)(ws + A_GK) + (size_t)kvrow * 128 + wc * 64;
#pragma unroll
                    for (int bj = 0; bj < 2; ++bj) {
                        const int pos = bj ? pcol : prow;
                        float o0[4], o1[4];
#pragma unroll
                        for (int j = 0; j < 4; ++j) {
                            float re = acc[ai][bj][m][0][j], im = acc[ai][bj][m][1][j];
                            if (!isv) { re *= rs * gn[32 * bj + 4 * fq + j]; im *= rs * gn[32 * bj + 16 + 4 * fq + j]; }
                            f32x2 cs = (ctx || isv) ? (f32x2){1.f, 0.f} : rope[pos * 16 + 4 * fq + j];
                            o0[j] = re * cs.x - im * cs.y; o1[j] = im * cs.x + re * cs.y;
                            if (isq) { o0[j] *= QSCALE; o1[j] *= QSCALE; }
                        }
                        *(u32x4*)(dst + 32 * bj + 8 * fq) = (u32x4){pk2(o0[0], o0[1]), pk2(o0[2], o0[3]), pk2(o1[0], o1[1]), pk2(o1[2], o1[3])};
                    }
                }
        } else if (pn <= 11) {
            const int lane = fq * 16 + fr, col = lane >> 2, chunk = lane & 3;
            LAS bf16_t* sw = (LAS bf16_t*)(scr + (wr * 4 + wc) * 2304);
#pragma unroll
            for (int ai = 0; ai < 2; ++ai) {
                const int row0 = u.pm * 256 + ai * 128 + wr * 64;
                int b, t0; if (!ctx) { b = row0 >> 12; t0 = row0 & 4095; } else { const int j = row0 - MLAT; b = j >> 8; t0 = j & 255; }
#pragma unroll
                for (int bj = 0; bj < 2; ++bj)
#pragma unroll
                    for (int n = 0; n < 2; ++n) {
#pragma unroll
                        for (int m = 0; m < 4; ++m) { const f32x4 v = acc[ai][bj][m][n];
#pragma unroll
                            for (int j = 0; j < 4; ++j) sw[(4 * fq + j) * 72 + 16 * m + fr] = (bf16_t)(pk2(v[j], 0.f) & 0xffffu); }
                        asm volatile("s_waitcnt lgkmcnt(0)" ::: "memory");
                        const u32x4 v0 = *(const LAS u32x4*)(sw + col * 72 + chunk * 16), v1 = *(const LAS u32x4*)(sw + col * 72 + chunk * 16 + 8);
                        const int c0 = (pn - 9) * 256 + bj * 128 + wc * 32 + 8 * (col >> 2) + 4 * n + (col & 3); const int part = c0 >= 384 ? 1 : 0; const int ch = c0 - part * 384;
                        bf16_t* dst = ctx ? ((bf16_t*)(ws + A_FTC) + (size_t)(b * 384 + ch) * 512 + part * 256 + t0 + chunk * 16)
                                          : ((bf16_t*)(ws + A_FT) + (size_t)(b * 384 + ch) * 8192 + part * 4096 + t0 + chunk * 16);
                        *(u32x4*)dst = v0; *(u32x4*)(dst + 8) = v1;
                        asm volatile("s_waitcnt lgkmcnt(0)" ::: "memory");
                    }
            }
        } else {
#pragma unroll
            for (int ai = 0; ai < 2; ++ai)
#pragma unroll
                for (int m = 0; m < 4; ++m) {
                const int row = u.pm * 256 + ai * 128 + wr * 64 + m * 16 + fr;
                int b, t, kvrow;
                if (!ctx) { b = row >> 12; t = row & 4095; kvrow = b * LKV + t; }
                else { const int j = row - MLAT; b = j >> 8; t = j & 255; kvrow = b * LKV + SEQ + t; }
                const int prow = t >> 6, pcol = t & 63; (void)b; (void)kvrow; (void)prow; (void)pcol;
#pragma unroll
                    for (int bj = 0; bj < 2; ++bj) {
                        const f32x4 a = acc[ai][bj][m][0], g = acc[ai][bj][m][1];
                        const int ch = ((pn - 12) * 8 + 4 * bj + wc) * 16 + 4 * fq;
                        float o[4];
#pragma unroll
                        for (int j = 0; j < 4; ++j) o[j] = a[j] * sigmoidf_(g[j]);
                        *(u32x2*)((bf16_t*)(ws + A_V) + (size_t)row * 384 + ch) = (u32x2){pk2(o[0], o[1]), pk2(o[2], o[3])};
                    }
                }
        }
    }
};

template <int ACT> struct EpiBf16 {
    static constexpr bool PERM = true, HOOK = false;
    bf16_t* O; int ldc;
    DI void hook(Acc&, const Unit&, int, int, int, int, int) const {}
    DI void operator()(const Acc& acc, const Unit& u, int wr, int wc, int fr, int fq) const {
#pragma unroll
        for (int ai = 0; ai < 2; ++ai)
#pragma unroll
            for (int m = 0; m < 4; ++m) {
                bf16_t* rowp = O + (size_t)(u.pm * 256 + ai * 128 + wr * 64 + m * 16 + fr) * ldc + u.pn * 256 + wc * 32 + 8 * fq;
#pragma unroll
                for (int bj = 0; bj < 2; ++bj) {
                    f32x4 v0 = acc[ai][bj][m][0], v1 = acc[ai][bj][m][1];
                    if (ACT == 1) {
#pragma unroll
                        for (int j = 0; j < 4; ++j) { v0[j] = sigmoidf_(v0[j]); v1[j] = sigmoidf_(v1[j]); }
                    } else if (ACT == 2) {
#pragma unroll
                        for (int j = 0; j < 4; ++j) { float a = fmaxf(v0[j], 0.f), b = fmaxf(v1[j], 0.f); v0[j] = a * a; v1[j] = b * b; }
                    }
                    *(u32x4*)(rowp + bj * 128) = (u32x4){pk2(v0[0], v0[1]), pk2(v0[2], v0[3]), pk2(v1[0], v1[1]), pk2(v1[2], v1[3])};
                }
            }
    }
};

struct EpiGate {
    static constexpr bool PERM = true, HOOK = false;
    bf16_t* G;
    DI void hook(Acc&, const Unit&, int, int, int, int, int) const {}
    DI void operator()(const Acc& acc, const Unit& u, int wr, int wc, int fr, int fq) const {
#pragma unroll
        for (int ai = 0; ai < 2; ++ai)
#pragma unroll
            for (int m = 0; m < 4; ++m) {
                bf16_t* rowp = G + (size_t)(u.pm * 256 + ai * 128 + wr * 64 + m * 16 + fr) * 4096 + u.pn * 64 + 16 * wc + 4 * fq;
                float r0[4], r1[4], r2[4], g3[4];
#pragma unroll
                for (int j = 0; j < 4; ++j) {
                    const float d0 = 1.0f + __builtin_amdgcn_exp2f(-1.44269504f * acc[ai][0][m][0][j]), d1 = 1.0f + __builtin_amdgcn_exp2f(-1.44269504f * acc[ai][0][m][1][j]);
                    const float d2 = 1.0f + __builtin_amdgcn_exp2f(-1.44269504f * acc[ai][1][m][0][j]), d3 = 1.0f + __builtin_amdgcn_exp2f(-1.44269504f * acc[ai][1][m][1][j]);
                    r0[j] = d1 * __builtin_amdgcn_rcpf(d0); r1[j] = d2 * __builtin_amdgcn_rcpf(d1); r2[j] = d3 * __builtin_amdgcn_rcpf(d2); g3[j] = __builtin_amdgcn_rcpf(d3);
                }
                *(u32x2*)(rowp) = (u32x2){pk2(r0[0], r0[1]), pk2(r0[2], r0[3])};
                *(u32x2*)(rowp + 1024) = (u32x2){pk2(r1[0], r1[1]), pk2(r1[2], r1[3])};
                *(u32x2*)(rowp + 2048) = (u32x2){pk2(r2[0], r2[1]), pk2(r2[2], r2[3])};
                *(u32x2*)(rowp + 3072) = (u32x2){pk2(g3[0], g3[1]), pk2(g3[2], g3[3])};
            }
    }
};

struct EpiBranch {
    static constexpr bool PERM = true, HOOK = true;
    const bf16_t* G; bf16_t* O;
    DI void hook(Acc& acc, const Unit& u, int t, int wr, int wc, int fr_, int fq) const {
        int fr = fr_; asm volatile("" : "+v"(fr));
        const int s = (t == 6) ? 0 : (t == 14 ? 1 : 2);
#pragma unroll
        for (int ai = 0; ai < 2; ++ai) {
            u32x4 ga[4][2];
#pragma unroll
            for (int m = 0; m < 4; ++m) {
                const bf16_t* gp = G + (size_t)(u.pm * 256 + ai * 128 + wr * 64 + m * 16 + fr) * 4096 + s * 1024 + u.pn * 256 + wc * 32 + 8 * fq;
#pragma unroll
                for (int bj = 0; bj < 2; ++bj) ga[m][bj] = *(const u32x4*)(gp + bj * 128);
            }
#pragma unroll
            for (int m = 0; m < 4; ++m)
#pragma unroll
                for (int bj = 0; bj < 2; ++bj)
#pragma unroll
                    for (int q = 0; q < 4; ++q) { acc[ai][bj][m][q >> 1][(q & 1) * 2] *= bflo(ga[m][bj][q]); acc[ai][bj][m][q >> 1][(q & 1) * 2 + 1] *= bfhi(ga[m][bj][q]); }
            asm volatile("" ::: "memory");
        }
    }
    DI void operator()(const Acc& acc, const Unit& u, int wr, int wc, int fr, int fq) const {
#pragma unroll
        for (int ai = 0; ai < 2; ++ai) {
            u32x4 g[4][2];
#pragma unroll
            for (int m = 0; m < 4; ++m)
#pragma unroll
                for (int bj = 0; bj < 2; ++bj) g[m][bj] = *(const u32x4*)(G + (size_t)(u.pm * 256 + ai * 128 + wr * 64 + m * 16 + fr) * 4096 + 3072 + u.pn * 256 + wc * 32 + 8 * fq + bj * 128);
#pragma unroll
            for (int m = 0; m < 4; ++m) {
                const size_t row = (size_t)(u.pm * 256 + ai * 128 + wr * 64 + m * 16 + fr);
                const int c = u.pn * 256 + wc * 32 + 8 * fq;
#pragma unroll
                for (int bj = 0; bj < 2; ++bj) {
                    const u32x4 gg = g[m][bj];
                    const f32x4 v0 = acc[ai][bj][m][0], v1 = acc[ai][bj][m][1];
                    *(u32x4*)(O + row * 1024 + c + bj * 128) = (u32x4){pk2(v0[0] * bflo(gg[0]), v0[1] * bfhi(gg[0])), pk2(v0[2] * bflo(gg[1]), v0[3] * bfhi(gg[1])),
                                                                      pk2(v1[0] * bflo(gg[2]), v1[1] * bfhi(gg[2])), pk2(v1[2] * bflo(gg[3]), v1[3] * bfhi(gg[3]))};
                }
            }
            asm volatile("" ::: "memory");
        }
    }
};

struct EpiFourier {
    static constexpr bool PERM = true, HOOK = false;
    bf16_t* BRQ; int row0, seqlen; float scale;
    DI void hook(Acc&, const Unit&, int, int, int, int, int) const {}
    DI void operator()(const Acc& acc, const Unit& u, int wr, int wc, int fr, int fq) const {
#pragma unroll
        for (int ai = 0; ai < 2; ++ai)
#pragma unroll
            for (int m = 0; m < 4; ++m) {
                const int pos = u.pm * 256 + ai * 128 + wr * 64 + m * 16 + fr;
#pragma unroll
                for (int bj = 0; bj < 2; ++bj) {
                    const int c = u.pn * 256 + bj * 128 + wc * 32 + 8 * fq; const int b = c / 384, ch = c - b * 384;
                    const f32x4 v0 = acc[ai][bj][m][0] * scale, v1 = acc[ai][bj][m][1] * scale;
                    *(u32x4*)(BRQ + (size_t)(row0 + b * seqlen + pos) * KBR + ch) = (u32x4){pk2(v0[0], v0[1]), pk2(v0[2], v0[3]), pk2(v1[0], v1[1]), pk2(v1[2], v1[3])};
                }
            }
    }
};

struct MapId { int off; DI int operator()(int n) const { return n + off; } };
struct MapWin {
    DI static int rp(int lc) { return 16 * ((lc >> 2) & 1) + 4 * (lc >> 3) + (lc & 3); }
    DI int operator()(int n) const {
        if (n < 512) return (n & ~31) + rp(n & 31);
        if (n < 1024) return n;
        if (n < 1280) { const int i = n - 1024, bj = i >> 7, wc = (i >> 5) & 3, lc = i & 31; return wc < 2 ? 1024 + wc * 64 + 32 * bj + rp(lc) : 1152 + (wc - 2) * 64 + 32 * bj + lc; }
        if (n < 1792) { const int i = n - 1280; return 1664 + (i & ~31) + rp(i & 31); }
        if (n < 2304) { const int i = n - 1792, tile = i >> 8, ii = i & 255, bj = ii >> 7, wc = (ii >> 5) & 3, lc = ii & 31; return 2176 + (tile * 4 + wc) * 64 + 32 * bj + rp(lc); }
        if (n < 3072) return -1;
        if (n < 3840) { const int i = n - 3072, grp = i >> 5, lc = i & 31, ch = grp * 16 + 4 * (lc >> 3) + (lc & 3); return ((lc >> 2) & 1) ? 3072 + ch : 2688 + ch; }
        { const int i = n - 3840, t = i >> 8, c = i & 255, bj = c >> 7, wc = (c >> 5) & 3, lc = c & 31;
          return 3456 + (2 * bj + ((lc >> 2) & 1)) * 1024 + 64 * t + 16 * wc + 4 * (lc >> 3) + (lc & 3); }
    }
};
template <class Map>
DI void convT(LAS unsigned char* lds, const float* src, int sld, int K, bf16_t* dst, int dld, int N, const Map& map, int item0, int nblk) {
    LAS float* tile = (LAS float*)lds;
    const int tid = tid_(); const int tK = K / 128, tN = N / 64;
    for (int it = item0; it < tK * tN; it += nblk) {
        const int tn = it / tK, tk = it % tK;
        const int col = map(tn * 64 + (tid & 63));
        if (map(tn * 64) < 0) continue;
        float v[16];
#pragma unroll
        for (int p = 0; p < 16; ++p) v[p] = src[(size_t)(tk * 128 + p * 8 + (tid >> 6)) * sld + col];
#pragma unroll
        for (int p = 0; p < 16; ++p) tile[(p * 8 + (tid >> 6)) * 65 + (tid & 63)] = v[p];
        __syncthreads();
#pragma unroll
        for (int hh = 0; hh < 2; ++hh) { const int n = tid >> 3, kc = (tid & 7) + 8 * hh; float w[8];
#pragma unroll
          for (int e = 0; e < 8; ++e) w[e] = tile[(kc * 8 + e) * 65 + n];
          *(u32x4*)(dst + (size_t)(tn * 64 + n) * dld + tk * 128 + kc * 8) = (u32x4){pk2(w[0], w[1]), pk2(w[2], w[3]), pk2(w[4], w[5]), pk2(w[6], w[7])}; }
        __syncthreads();
    }
}
DI void conv_fold(LAS unsigned char* lds, const float* win, bf16_t* wint, int item0, int nblk) {
    LAS float* tile = (LAS float*)lds;
    LAS float* tab = (LAS float*)(lds + 64 * 65 * 4);
    LAS bf16_t* outb = (LAS bf16_t*)(lds + 64 * 65 * 4 + 256);
    const int tid = tid_();
    __syncthreads();
    if (tid < 64) tab[tid] = cospif((float)tid / 32.0f);
    for (int it = item0; it < 6 * 16; it += nblk) {
        const int g = it >> 4, tk = it & 15;
        __syncthreads();
#pragma unroll
        for (int p = 0; p < 8; ++p) { const int kk = p * 8 + (tid >> 6); tile[kk * 65 + (tid & 63)] = win[(size_t)(tk * 64 + kk) * IN_COLS + 1280 + g * 64 + (tid & 63)]; }
        __syncthreads();
        const int k = tid & 63, cq = tid >> 6;
        float ac[8], as[8];
#pragma unroll
        for (int e = 0; e < 8; ++e) { ac[e] = 0.f; as[e] = 0.f; }
        for (int c = 0; c < 64; ++c) {
            const float w = tile[k * 65 + c];
#pragma unroll
            for (int e = 0; e < 8; ++e) { const int idx = c * (cq * 8 + e); ac[e] += w * tab[idx & 63]; as[e] += w * tab[(idx - 16) & 63]; }
        }
#pragma unroll
        for (int e = 0; e < 8; ++e) { outb[(cq * 8 + e) * 72 + k] = (bf16_t)(pk2(ac[e], 0.f) & 0xffffu); outb[(64 + cq * 8 + e) * 72 + k] = (bf16_t)(pk2(as[e], 0.f) & 0xffffu); }
        __syncthreads();
        for (int i = tid; i < 128 * 8; i += NTHREADS) { const int rr = i >> 3, ch = i & 7; const int part = rr >> 6, cp = rr & 63;
            *(u32x4*)(wint + (size_t)(2304 + part * 384 + g * 64 + cp) * D + tk * 64 + ch * 8) = *(const LAS u32x4*)(outb + rr * 72 + ch * 8); }
    }
    __syncthreads();
}
DI void conv_win(LAS unsigned char* lds, const Ptrs& P, int l, int item0, int nblk) {
    const float* win = P.in[I_WIN] + (size_t)l * D * IN_COLS;
    convT(lds, win, IN_COLS, D, (bf16_t*)(P.ws + OFF_WINT), D, NIN, MapWin{}, item0, nblk);
    conv_fold(lds, win, (bf16_t*)(P.ws + OFF_WINT), item0, nblk);
}
DI void gen_dft(LAS unsigned char* lds, unsigned char* ws, int item0, int nblk, bool also_small) {
    const int tid = tid_();
    bf16_t* dft = (bf16_t*)(ws + A_DFT);
    for (int it = item0 * NTHREADS + tid; it < 4096 * 512; it += nblk * NTHREADS) {
        const int k = it >> 9, j0 = (it & 511) * 8;
        float v[8];
#pragma unroll
        for (int e = 0; e < 8; ++e) { const int j = j0 + e; const bool sp = j >= 2049; const float fr = (float)((k * (sp ? j - 2048 : j)) & 4095) * (1.0f / 4096.0f); v[e] = sp ? -__builtin_amdgcn_sinf(fr) : __builtin_amdgcn_cosf(fr); }
        *(u32x4*)(dft + (size_t)k * 4096 + j0) = (u32x4){pk2(v[0], v[1]), pk2(v[2], v[3]), pk2(v[4], v[5]), pk2(v[6], v[7])};
    }
    if (also_small) {
        bf16_t* dc = (bf16_t*)(ws + OFF_DFTC);
        for (int it = item0 * NTHREADS + tid; it < 256 * 64; it += nblk * NTHREADS) {
            const int k = it >> 6, j0 = (it & 63) * 8; const int part = j0 >= 256; const int t0 = j0 & 255;
            float v[8];
#pragma unroll
            for (int e = 0; e < 8; ++e) { const float fr = (float)((k * (t0 + e)) & 255) * (1.0f / 256.0f); v[e] = part ? -__builtin_amdgcn_sinf(fr) : __builtin_amdgcn_cosf(fr); }
            *(u32x4*)(dc + (size_t)k * 512 + j0) = (u32x4){pk2(v[0], v[1]), pk2(v[2], v[3]), pk2(v[4], v[5]), pk2(v[6], v[7])};
        }
    }
}
DI void fourier_fold(unsigned char* ws, int item0, int nblk) {
    const int tid = tid_();
    const bf16_t* FT = (const bf16_t*)(ws + A_FT); bf16_t* FTF = (bf16_t*)(ws + A_FTF);
    for (int it = item0 * NTHREADS + tid; it < 1536 * 1024; it += nblk * NTHREADS) {
        const int n = it >> 10, j0 = (it & 1023) * 4;
        const bf16_t* s = FT + (size_t)n * 8192;
        float o[4];
#pragma unroll
        for (int e = 0; e < 4; ++e) { const int j = j0 + e;
            if (j <= 2048) { const float a = bflo((unsigned)s[j]); o[e] = (j == 0 || j == 2048) ? a : a + bflo((unsigned)s[4096 - j]); }
            else { const int t = j - 2048; o[e] = bflo((unsigned)s[4096 + t]) - bflo((unsigned)s[8192 - t]); } }
        *(u32x2*)(FTF + (size_t)n * 4096 + j0) = (u32x2){pk2(o[0], o[1]), pk2(o[2], o[3])};
    }
}

DI void mod_gemv(LAS unsigned char* lds, const Ptrs& P, int item0, int nblk) {
    LAS float* sc = (LAS float*)lds;
    LAS float* red = (LAS float*)(lds + 20480);
    const int tid = tid_();
    __syncthreads();
    for (int i = tid; i < 5 * 1024; i += NTHREADS) { const float v = i < 4096 ? P.in[I_C][i] : P.in[I_CCTX][i - 4096]; sc[i] = v * sigmoidf_(v); }
    __syncthreads();
    float* MOD = (float*)(P.ws + OFF_MOD);
    for (int it = item0; it < 2 * 192; it += nblk) {
        const int l = it / 192, cg32 = it % 192; const int kg = tid >> 5, cl = tid & 31;
        const float* w = P.in[I_WMOD] + (size_t)l * D * 6144 + cg32 * 32 + cl;
        float a[5] = {0.f, 0.f, 0.f, 0.f, 0.f};
        for (int k = kg * 64; k < kg * 64 + 64; ++k) { const float wv = w[(size_t)k * 6144];
#pragma unroll
            for (int r = 0; r < 5; ++r) a[r] += sc[r * 1024 + k] * wv; }
#pragma unroll
        for (int r = 0; r < 5; ++r) red[(kg * 5 + r) * 32 + cl] = a[r];
        __syncthreads();
        if (tid < 160) { const int r = tid >> 5; float s = 0.f;
#pragma unroll
            for (int g = 0; g < 16; ++g) s += red[(g * 5 + r) * 32 + cl];
            MOD[((size_t)l * 5 + r) * 6144 + cg32 * 32 + cl] = s + P.in[I_BMOD][l * 6144 + cg32 * 32 + cl]; }
        __syncthreads();
    }
}

DI void row_mod_store(const f32x4 (&x)[4], float rstd, const float* gain, const float* shift, const float* scale, bf16_t* hrow, int lane) {
#pragma unroll
    for (int i = 0; i < 4; ++i) { const int c = lane * 4 + 256 * i;
        const f32x4 g = *(const f32x4*)(gain + c), sh = *(const f32x4*)(shift + c), sc = *(const f32x4*)(scale + c);
        float o[4];
#pragma unroll
        for (int j = 0; j < 4; ++j) o[j] = x[i][j] * rstd * g[j] * (1.f + sc[j]) + sh[j];
        *(u32x2*)(hrow + c) = (u32x2){pk2(o[0], o[1]), pk2(o[2], o[3])}; }
}
DI float row_rstd(const f32x4 (&x)[4]) {
    float s = 0.f;
#pragma unroll
    for (int i = 0; i < 4; ++i) s += x[i][0] * x[i][0] + x[i][1] * x[i][1] + x[i][2] * x[i][2] + x[i][3] * x[i][3];
    s = wave_sum(s);
    return __builtin_amdgcn_rsqf(s * (1.0f / 1024.0f) + EPS);
}
DI void rows_first(const Ptrs& P) {
    const int tid = tid_(); const int lane = tid & 63, wv = tid >> 6;
    const float* MOD = (const float*)(P.ws + OFF_MOD);
    for (int row = blockIdx.x * 8 + wv; row < MTOT; row += gridDim.x * 8) {
        const float* xr = row < MLAT ? P.in[I_X] + (size_t)row * D : P.in[I_CTX] + (size_t)(row - MLAT) * D;
        const int mr = row < MLAT ? (row >> 12) : 4;
        f32x4 x[4];
#pragma unroll
        for (int i = 0; i < 4; ++i) x[i] = *(const f32x4*)(xr + lane * 4 + 256 * i);
        const float rstd = row_rstd(x);
        const float* mod = MOD + (size_t)mr * 6144;
        row_mod_store(x, rstd, P.in[I_GPREMIX], mod, mod + 1024, (bf16_t*)(P.ws + OFF_HS) + (size_t)row * D, lane);
    }
}
DI void rows_update(const Ptrs& P, int l, int which  , int nrows) {
    const int tid = tid_(); const int lane = tid & 63, wv = tid >> 6;
    const float* MOD = (const float*)(P.ws + OFF_MOD);
    const bf16_t* Y = (const bf16_t*)(P.ws + A_MIXO);
    const float* gpost = P.in[which ? I_GPOSTMLP : I_GPOSTMIX] + l * D;
    const bool do_h = (which == 0) || (l == 0);
    const int ln = which ? l + 1 : l;
    const float* gnext = which ? P.in[I_GPREMIX] + (do_h ? ln : 0) * D : P.in[I_GPREMLP] + l * D;
    for (int row = blockIdx.x * 8 + wv; row < nrows; row += gridDim.x * 8) {
        const bool lat = row < MLAT;
        const float* xin = lat ? ((l == 0 && which == 0) ? P.in[I_X] + (size_t)row * D : P.out + (size_t)row * D)
                               : ((which == 0) ? P.in[I_CTX] + (size_t)(row - MLAT) * D : (const float*)(P.ws + A_XC) + (size_t)(row - MLAT) * D);
        float* xout = lat ? P.out + (size_t)row * D : (float*)(P.ws + A_XC) + (size_t)(row - MLAT) * D;
        const int mr = lat ? (row >> 12) : 4;
        const float* mod = MOD + ((size_t)l * 5 + mr) * 6144;
        const float* gate = mod + (which ? 5 : 2) * 1024;
        f32x4 x[4], y[4];
#pragma unroll
        for (int i = 0; i < 4; ++i) { x[i] = *(const f32x4*)(xin + lane * 4 + 256 * i);
            const u32x2 yb = *(const u32x2*)(Y + (size_t)row * D + lane * 4 + 256 * i); y[i] = (f32x4){bflo(yb[0]), bfhi(yb[0]), bflo(yb[1]), bfhi(yb[1])}; }
        const float ry = row_rstd(y);
#pragma unroll
        for (int i = 0; i < 4; ++i) { const int c = lane * 4 + 256 * i; const f32x4 gp = *(const f32x4*)(gpost + c), gt = *(const f32x4*)(gate + c);
#pragma unroll
            for (int j = 0; j < 4; ++j) x[i][j] += gt[j] * (y[i][j] * ry * gp[j]);
            *(f32x4*)(xout + c) = x[i]; }
        if (do_h) {
            const float rx = row_rstd(x);
            const float* modn = MOD + ((size_t)ln * 5 + mr) * 6144;
            const float* shiftn = which ? modn : modn + 3 * 1024; const float* scalen = which ? modn + 1024 : modn + 4 * 1024;
            row_mod_store(x, rx, gnext, shiftn, scalen, (bf16_t*)(P.ws + OFF_HS) + (size_t)row * D, lane);
        }
    }
}

constexpr int AK_PITCH = 144;
constexpr int AK_BUF = 64 * AK_PITCH;
constexpr int AV_OFF = 2 * AK_BUF;
#define ATT_BAR() do { __builtin_amdgcn_sched_barrier(0); asm volatile("s_waitcnt lgkmcnt(0)" ::: "memory"); __builtin_amdgcn_s_barrier(); asm volatile("" ::: "memory"); __builtin_amdgcn_sched_barrier(0); } while (0)
DI float max3_(float a, float b, float c) { float d; asm("v_max3_f32 %0, %1, %2, %3" : "=v"(d) : "v"(a), "v"(b), "v"(c)); return d; }
template <int NMB, bool NOMAX = false>
DI void flash_pass(LAS unsigned char* lds, const bf16x8 (&qf)[4], const bf16_t* Kg, int ldk, const bf16_t* Vg, int ldv, int ntiles, f32x16 (&O)[NMB], float& lsum) {
    constexpr int VP = NMB == 4 ? 320 : 192;
    constexpr int VBUF = 64 * VP;
    constexpr int VCH = NMB * 4;
    constexpr int VPT = NMB / 2;
    const int tid = tid_(), lane = tid & 63, g = __builtin_amdgcn_readfirstlane(tid >> 8);
    const int r = lane & 31, h = lane >> 5, i16 = lane & 15, q4 = i16 >> 2, p4 = i16 & 3, blk = (lane >> 4) & 1;
    const int kkey = tid >> 3, kch = tid & 7;
    const unsigned kwoff = kkey * AK_PITCH + kch * 16;
    const unsigned vrd = (4 * h + q4) * VP + 32 * blk + 8 * p4;
    const unsigned krd = r * AK_PITCH + 16 * h;
    const bf16_t* kgp = Kg + (size_t)kkey * ldk + kch * 8;
    const unsigned vwoff0 = (tid / VCH) * VP + (tid % VCH) * 16; const bf16_t* vgp0 = Vg + (size_t)(tid / VCH) * ldv + (tid % VCH) * 8;
    constexpr int VKS = NTHREADS / VCH;
#define vwoff_(p) (vwoff0 + (p) * VKS * VP)
#define vgp_(p) (vgp0 + (size_t)(p) * VKS * ldv)
    float m_run = -1e30f; lsum = 0.f;
#pragma unroll
    for (int mb = 0; mb < NMB; ++mb)
#pragma unroll
        for (int i = 0; i < 16; ++i) O[mb][i] = 0.f;
    u32x4 kreg, vreg[VPT];
    {
        const u32x4 k0 = *(const u32x4*)kgp, k1 = *(const u32x4*)(kgp + (size_t)64 * ldk);
#pragma unroll
        for (int p = 0; p < VPT; ++p) vreg[p] = *(const u32x4*)vgp_(p);
        __syncthreads();
        *(LAS u32x4*)(lds + kwoff) = k0; *(LAS u32x4*)(lds + AK_BUF + kwoff) = k1;
#pragma unroll
        for (int p = 0; p < VPT; ++p) *(LAS u32x4*)(lds + AV_OFF + vwoff_(p)) = vreg[p];
    }
    __syncthreads();
    kreg = *(const u32x4*)(kgp + (size_t)(ntiles > 2 ? 128 : 0) * ldk);
#pragma unroll
    for (int p = 0; p < VPT; ++p) vreg[p] = *(const u32x4*)(vgp_(p) + (size_t)64 * ldv);
    f32x16 S0, S1;
#pragma unroll
    for (int i = 0; i < 16; ++i) { S0[i] = 0.f; S1[i] = 0.f; }
#pragma unroll
    for (int c = 0; c < 4; ++c) {
        const bf16x8 a0 = *(const LAS bf16x8*)(lds + krd + 32 * c);
        const bf16x8 a1 = *(const LAS bf16x8*)(lds + krd + 32 * AK_PITCH + 32 * c);
        S0 = __builtin_amdgcn_mfma_f32_32x32x16_bf16(a0, qf[c], S0, 0, 0, 0);
        S1 = __builtin_amdgcn_mfma_f32_32x32x16_bf16(a1, qf[c], S1, 0, 0, 0);
    }
    if (g == 1) ATT_BAR();
    for (int t = 0; t < ntiles; ++t) {
        const int sv = t + g;
        if (sv >= 1) {
            if (sv < ntiles) {
#pragma unroll
                for (int p = 0; p < VPT; ++p) *(LAS u32x4*)(lds + AV_OFF + (sv & 1) * VBUF + vwoff_(p)) = vreg[p]; }
            if (sv + 1 < ntiles) *(LAS u32x4*)(lds + ((sv + 1) & 1) * AK_BUF + kwoff) = kreg;
        }
        if (sv + 1 < ntiles) {
#pragma unroll
            for (int p = 0; p < VPT; ++p) vreg[p] = *(const u32x4*)(vgp_(p) + (size_t)(sv + 1) * 64 * ldv); }
        if (sv + 2 < ntiles) kreg = *(const u32x4*)(kgp + (size_t)(sv + 2) * 64 * ldk);
        if constexpr (!NOMAX) {
        float mx = max3_(S0[0], S1[0], S0[1]), mx2 = max3_(S1[1], S0[2], S1[2]);
#pragma unroll
        for (int i = 3; i < 15; i += 2) { mx = max3_(mx, S0[i], S1[i]); mx2 = max3_(mx2, S0[i + 1], S1[i + 1]); }
        mx = max3_(mx, S0[15], S1[15]);
        mx = max3_(mx, mx2, mx2);
        { const u32x2 sw = __builtin_amdgcn_permlane32_swap(__float_as_uint(mx), __float_as_uint(mx), false, false);
          mx = max3_(__uint_as_float(sw[0]), __uint_as_float(sw[1]), m_run); }
        const float m_new = mx;
        if (__builtin_amdgcn_ballot_w64(m_new > m_run) != 0ull) {
            const float alpha = __builtin_amdgcn_exp2f(m_run - m_new);
            lsum *= alpha;
#pragma unroll
            for (int mb = 0; mb < NMB; ++mb)
#pragma unroll
                for (int i = 0; i < 16; ++i) O[mb][i] *= alpha;
            m_run = m_new;
        }
        }
#pragma unroll
        for (int i = 0; i < 16; ++i) { if constexpr (NOMAX) { S0[i] = __builtin_amdgcn_exp2f(S0[i]); S1[i] = __builtin_amdgcn_exp2f(S1[i]); } else { S0[i] = __builtin_amdgcn_exp2f(S0[i] - m_run); S1[i] = __builtin_amdgcn_exp2f(S1[i] - m_run); } }
        f32x2 ps2 = (f32x2){0.f, 0.f};
#pragma unroll
        for (int i = 0; i < 8; ++i) { ps2 += (f32x2){S0[2 * i], S0[2 * i + 1]}; ps2 += (f32x2){S1[2 * i], S1[2 * i + 1]}; }
        lsum += ps2.x + ps2.y;
        bf16x8 pf[4];
#pragma unroll
        for (int cp = 0; cp < 2; ++cp) {
            u32x4 w0, w1;
#pragma unroll
            for (int q = 0; q < 4; ++q) { w0[q] = pk2(S0[8 * cp + 2 * q], S0[8 * cp + 2 * q + 1]); w1[q] = pk2(S1[8 * cp + 2 * q], S1[8 * cp + 2 * q + 1]); }
            pf[cp] = __builtin_bit_cast(bf16x8, w0); pf[2 + cp] = __builtin_bit_cast(bf16x8, w1);
        }
        ATT_BAR();
        {
            const LAS unsigned char* Vb = lds + AV_OFF + (t & 1) * VBUF + vrd;
            const LAS unsigned char* Kb = lds + ((t + 1) & 1) * AK_BUF + krd;
            const bool qk = t + 1 < ntiles;
            bf16x8 kf[8], va[NMB], vb[NMB];
#define ATT_LDV(dst, kc) do { _Pragma("unroll") for (int mb = 0; mb < NMB; ++mb) { \
                const s16x4 lo_ = __builtin_amdgcn_ds_read_tr16_b64_v4i16((LAS s16x4*)(Vb + (16 * (kc)) * VP + 64 * mb)); \
                const s16x4 hi_ = __builtin_amdgcn_ds_read_tr16_b64_v4i16((LAS s16x4*)(Vb + (16 * (kc) + 8) * VP + 64 * mb)); \
                dst[mb] = __builtin_shufflevector(lo_, hi_, 0, 1, 2, 3, 4, 5, 6, 7); } } while (0)
#define ATT_PV(srcv, kc) do { _Pragma("unroll") for (int mb = 0; mb < NMB; ++mb) O[mb] = __builtin_amdgcn_mfma_f32_32x32x16_bf16(srcv[mb], pf[kc], O[mb], 0, 0, 0); } while (0)
            if (qk) {
#pragma unroll
                for (int c = 0; c < 4; ++c) { kf[2 * c] = *(const LAS bf16x8*)(Kb + 32 * c); kf[2 * c + 1] = *(const LAS bf16x8*)(Kb + 32 * AK_PITCH + 32 * c); }
            }
            ATT_LDV(va, 0);
            __builtin_amdgcn_sched_barrier(0);
            if (qk) {
#pragma unroll
                for (int i = 0; i < 16; ++i) { S0[i] = 0.f; S1[i] = 0.f; }
#pragma unroll
                for (int c = 0; c < 4; ++c) {
                    S0 = __builtin_amdgcn_mfma_f32_32x32x16_bf16(kf[2 * c], qf[c], S0, 0, 0, 0);
                    S1 = __builtin_amdgcn_mfma_f32_32x32x16_bf16(kf[2 * c + 1], qf[c], S1, 0, 0, 0);
                }
            }
            ATT_LDV(vb, 1);
            __builtin_amdgcn_sched_barrier(0);
            ATT_PV(va, 0);
            ATT_LDV(va, 2);
            __builtin_amdgcn_sched_barrier(0);
            ATT_PV(vb, 1);
            ATT_LDV(vb, 3);
            __builtin_amdgcn_sched_barrier(0);
            ATT_PV(va, 2);
            ATT_PV(vb, 3);
#undef ATT_LDV
#undef ATT_PV
        }
        ATT_BAR();
    }
    if (g == 0) ATT_BAR();
    lsum += __shfl_xor(lsum, 32);
}
#undef vwoff_
#undef vgp_

DI void diff_unit(LAS unsigned char* lds, const Ptrs& P, int l, int b, int hd, int qrow0, int key0, int ntiles, float lam, float lam_init) {
    const int tid = tid_(); const int lane = tid & 63, wv = tid >> 6, r = lane & 31, h = lane >> 5;
    bf16_t* BRQ = (bf16_t*)(P.ws + A_BRQ);
    const bf16_t* DK = (const bf16_t*)(P.ws + A_DK) + (size_t)(b * LKV + key0) * 512 + hd * 128;
    const bf16_t* DV = (const bf16_t*)(P.ws + A_DV) + (size_t)(b * LKV + key0) * 512 + hd * 128;
    bf16_t* qp = BRQ + (size_t)(qrow0 + wv * 32 + r) * KBR + 384 + hd * 128;
    bf16x8 q0[4], q1[4];
#pragma unroll
    for (int c = 0; c < 4; ++c) { q0[c] = *(const bf16x8*)(qp + 16 * c + 8 * h); q1[c] = *(const bf16x8*)(qp + 64 + 16 * c + 8 * h); }
    f32x16 O[4]; float l0;
    const unsigned* nrm = (const unsigned*)(P.ws + OFF_CTL) + 32 + 2 * l;
    const float bnd = 2.04f * sqrtf(__uint_as_float(__hip_atomic_load(nrm, __ATOMIC_RELAXED, __HIP_MEMORY_SCOPE_AGENT)) * __uint_as_float(__hip_atomic_load(nrm + 1, __ATOMIC_RELAXED, __HIP_MEMORY_SCOPE_AGENT)));
    const bool small = __builtin_amdgcn_readfirstlane((int)(bnd < 60.0f)) != 0;
    if (small) flash_pass<4, true>(lds, q0, DK, 512, DV, 512, ntiles, O, l0); else
    flash_pass<4>(lds, q0, DK, 512, DV, 512, ntiles, O, l0);
    { const float inv = 1.0f / l0;
#pragma unroll
      for (int mb = 0; mb < 4; ++mb)
#pragma unroll
          for (int g = 0; g < 4; ++g) { const int dv = 32 * mb + 8 * g + 4 * h;
              *(u32x2*)(qp + dv) = (u32x2){pk2(O[mb][4 * g] * inv, O[mb][4 * g + 1] * inv), pk2(O[mb][4 * g + 2] * inv, O[mb][4 * g + 3] * inv)}; } }
    if (small) flash_pass<4, true>(lds, q1, DK + 64, 512, DV, 512, ntiles, O, l0); else
    flash_pass<4>(lds, q1, DK + 64, 512, DV, 512, ntiles, O, l0);
    { const float s1 = lam / l0; float ss = 0.f;
#pragma unroll
      for (int mb = 0; mb < 4; ++mb)
#pragma unroll
          for (int g = 0; g < 4; ++g) { const int dv = 32 * mb + 8 * g + 4 * h; const u32x2 o0 = *(const u32x2*)(qp + dv);
              const float a0 = bflo(o0[0]) - s1 * O[mb][4 * g], a1 = bfhi(o0[0]) - s1 * O[mb][4 * g + 1], a2 = bflo(o0[1]) - s1 * O[mb][4 * g + 2], a3 = bfhi(o0[1]) - s1 * O[mb][4 * g + 3];
              O[mb][4 * g] = a0; O[mb][4 * g + 1] = a1; O[mb][4 * g + 2] = a2; O[mb][4 * g + 3] = a3; ss += a0 * a0 + a1 * a1 + a2 * a2 + a3 * a3; }
      ss += __shfl_xor(ss, 32);
      const float rs = __builtin_amdgcn_rsqf(ss * (1.0f / 128.0f) + EPS) * (1.0f - lam_init);
      const float* sg = P.in[I_SUBLN] + l * 128;
#pragma unroll
      for (int mb = 0; mb < 4; ++mb)
#pragma unroll
          for (int g = 0; g < 4; ++g) { const int dv = 32 * mb + 8 * g + 4 * h; const f32x4 gg = *(const f32x4*)(sg + dv);
              *(u32x2*)(qp + dv) = (u32x2){pk2(O[mb][4 * g] * rs * gg[0], O[mb][4 * g + 1] * rs * gg[1]), pk2(O[mb][4 * g + 2] * rs * gg[2], O[mb][4 * g + 3] * rs * gg[3])}; }
    }
}
DI void gqa_unit(LAS unsigned char* lds, const Ptrs& P, int l, int b, int qh, int qrow0, int key0, int ntiles) {
    const int tid = tid_(); const int lane = tid & 63, wv = tid >> 6, r = lane & 31, h = lane >> 5;
    bf16_t* BRQ = (bf16_t*)(P.ws + A_BRQ);
    const int kvh = qh >> 2;
    const bf16_t* GK = (const bf16_t*)(P.ws + A_GK) + (size_t)(b * LKV + key0) * 128 + kvh * 64;
    const bf16_t* GV = (const bf16_t*)(P.ws + A_GV) + (size_t)(b * LKV + key0) * 128 + kvh * 64;
    bf16_t* qp = BRQ + (size_t)(qrow0 + wv * 32 + r) * KBR + 896 + qh * 64;
    bf16x8 q0[4];
#pragma unroll
    for (int c = 0; c < 4; ++c) q0[c] = *(const bf16x8*)(qp + 16 * c + 8 * h);
    f32x16 O[2]; float l0;
    float mq = fabsf(P.in[I_QNORM][l * 64 + lane]), mk = fabsf(P.in[I_KNORM][l * 64 + lane]);
#pragma unroll
    for (int o = 32; o >= 1; o >>= 1) { mq = fmaxf(mq, __shfl_xor(mq, o)); mk = fmaxf(mk, __shfl_xor(mk, o)); }
    const bool small = __builtin_amdgcn_readfirstlane((int)(64.0f * QSCALE * 1.02f * mq * mk < 60.0f)) != 0;
    if (small) flash_pass<2, true>(lds, q0, GK, 128, GV, 128, ntiles, O, l0);
    else flash_pass<2, false>(lds, q0, GK, 128, GV, 128, ntiles, O, l0);
    const float inv = 1.0f / l0;
#pragma unroll
    for (int mb = 0; mb < 2; ++mb)
#pragma unroll
        for (int g = 0; g < 4; ++g) { const int dv = 32 * mb + 8 * g + 4 * h;
            *(u32x2*)(qp + dv) = (u32x2){pk2(O[mb][4 * g] * inv, O[mb][4 * g + 1] * inv), pk2(O[mb][4 * g + 2] * inv, O[mb][4 * g + 3] * inv)}; }
}

DI void gqa_pair_pass(LAS unsigned char* lds, const bf16x8 (&qf)[2][4], const bf16_t* Kg, const bf16_t* Vg, int ntiles, f32x16 (&O)[2][2], float (&lsum)[2]) {
    constexpr int VP = 192, VBUF = 64 * VP;
    const int tid = tid_(), lane = tid & 63;
    const int r = lane & 31, h = lane >> 5, i16 = lane & 15, q4 = i16 >> 2, p4 = i16 & 3, blk = (lane >> 4) & 1;
    const int kkey = tid >> 3, kch = tid & 7;
    const unsigned kwoff = kkey * AK_PITCH + kch * 16, vwoff = kkey * VP + kch * 16;
    const unsigned vrd = (4 * h + q4) * VP + 32 * blk + 8 * p4, krd = r * AK_PITCH + 16 * h;
    const bf16_t* kgp = Kg + (size_t)kkey * 128 + kch * 8; const bf16_t* vgp = Vg + (size_t)kkey * 128 + kch * 8;
#pragma unroll
    for (int hh = 0; hh < 2; ++hh) { lsum[hh] = 0.f;
#pragma unroll
        for (int mb = 0; mb < 2; ++mb)
#pragma unroll
            for (int i = 0; i < 16; ++i) O[hh][mb][i] = 0.f; }
    u32x4 kreg = *(const u32x4*)kgp, vreg = *(const u32x4*)vgp;
    __syncthreads();
    *(LAS u32x4*)(lds + kwoff) = kreg; *(LAS u32x4*)(lds + AV_OFF + vwoff) = vreg;
    kreg = *(const u32x4*)(kgp + (size_t)64 * 128); vreg = *(const u32x4*)(vgp + (size_t)64 * 128);
    __syncthreads();
    for (int t = 0; t < ntiles; ++t) {
        if (t + 1 < ntiles) { *(LAS u32x4*)(lds + ((t + 1) & 1) * AK_BUF + kwoff) = kreg; *(LAS u32x4*)(lds + AV_OFF + ((t + 1) & 1) * VBUF + vwoff) = vreg; }
        if (t + 2 < ntiles) { kreg = *(const u32x4*)(kgp + (size_t)(t + 2) * 64 * 128); vreg = *(const u32x4*)(vgp + (size_t)(t + 2) * 64 * 128); }
        const LAS unsigned char* Kb = lds + (t & 1) * AK_BUF + krd;
        const LAS unsigned char* Vb = lds + AV_OFF + (t & 1) * VBUF + vrd;
        f32x16 S[2][2];
#pragma unroll
        for (int hh = 0; hh < 2; ++hh)
#pragma unroll
            for (int kb = 0; kb < 2; ++kb)
#pragma unroll
                for (int i = 0; i < 16; ++i) S[hh][kb][i] = 0.f;
#pragma unroll
        for (int cg2 = 0; cg2 < 2; ++cg2) {
            bf16x8 kf[4];
#pragma unroll
            for (int cc = 0; cc < 2; ++cc) { const int c = 2 * cg2 + cc; kf[2 * cc] = *(const LAS bf16x8*)(Kb + 32 * c); kf[2 * cc + 1] = *(const LAS bf16x8*)(Kb + 32 * AK_PITCH + 32 * c); }
#pragma unroll
            for (int cc = 0; cc < 2; ++cc)
#pragma unroll
                for (int hh = 0; hh < 2; ++hh) {
                    S[hh][0] = __builtin_amdgcn_mfma_f32_32x32x16_bf16(kf[2 * cc], qf[hh][2 * cg2 + cc], S[hh][0], 0, 0, 0);
                    S[hh][1] = __builtin_amdgcn_mfma_f32_32x32x16_bf16(kf[2 * cc + 1], qf[hh][2 * cg2 + cc], S[hh][1], 0, 0, 0);
                }
            __builtin_amdgcn_sched_barrier(0);
        }
        __builtin_amdgcn_sched_barrier(0);
        bf16x8 pf[2][4];
#pragma unroll
        for (int hh = 0; hh < 2; ++hh) {
#pragma unroll
            for (int i = 0; i < 16; ++i) { S[hh][0][i] = __builtin_amdgcn_exp2f(S[hh][0][i]); S[hh][1][i] = __builtin_amdgcn_exp2f(S[hh][1][i]); }
            f32x2 ps2 = (f32x2){0.f, 0.f};
#pragma unroll
            for (int i = 0; i < 8; ++i) { ps2 += (f32x2){S[hh][0][2 * i], S[hh][0][2 * i + 1]}; ps2 += (f32x2){S[hh][1][2 * i], S[hh][1][2 * i + 1]}; }
            lsum[hh] += ps2.x + ps2.y;
#pragma unroll
            for (int cp = 0; cp < 2; ++cp) {
                u32x4 w0, w1;
#pragma unroll
                for (int q = 0; q < 4; ++q) { w0[q] = pk2(S[hh][0][8 * cp + 2 * q], S[hh][0][8 * cp + 2 * q + 1]); w1[q] = pk2(S[hh][1][8 * cp + 2 * q], S[hh][1][8 * cp + 2 * q + 1]); }
                pf[hh][cp] = __builtin_bit_cast(bf16x8, w0); pf[hh][2 + cp] = __builtin_bit_cast(bf16x8, w1);
            }
        }
        __builtin_amdgcn_sched_barrier(0);
#pragma unroll
        for (int kc = 0; kc < 4; ++kc)
#pragma unroll
            for (int mb = 0; mb < 2; ++mb) {
                const s16x4 lo = __builtin_amdgcn_ds_read_tr16_b64_v4i16((LAS s16x4*)(Vb + (16 * kc) * VP + 64 * mb));
                const s16x4 hi = __builtin_amdgcn_ds_read_tr16_b64_v4i16((LAS s16x4*)(Vb + (16 * kc + 8) * VP + 64 * mb));
                const bf16x8 a = __builtin_shufflevector(lo, hi, 0, 1, 2, 3, 4, 5, 6, 7);
#pragma unroll
                for (int hh = 0; hh < 2; ++hh) O[hh][mb] = __builtin_amdgcn_mfma_f32_32x32x16_bf16(a, pf[hh][kc], O[hh][mb], 0, 0, 0);
            }
        ATT_BAR();
    }
#pragma unroll
    for (int hh = 0; hh < 2; ++hh) lsum[hh] += __shfl_xor(lsum[hh], 32);
}
DI void gqa_pair_unit(LAS unsigned char* lds, const Ptrs& P, int l, int b, int qh, int qrow0, int key0, int ntiles) {
    const int tid = tid_(); const int lane = tid & 63, wv = tid >> 6, r = lane & 31, h = lane >> 5;
    bf16_t* BRQ = (bf16_t*)(P.ws + A_BRQ);
    const int kvh = qh >> 2;
    const bf16_t* GK = (const bf16_t*)(P.ws + A_GK) + (size_t)(b * LKV + key0) * 128 + kvh * 64;
    const bf16_t* GV = (const bf16_t*)(P.ws + A_GV) + (size_t)(b * LKV + key0) * 128 + kvh * 64;
    bf16_t* qp = BRQ + (size_t)(qrow0 + wv * 32 + r) * KBR + 896 + qh * 64;
    bf16x8 qf[2][4];
#pragma unroll
    for (int hh = 0; hh < 2; ++hh)
#pragma unroll
        for (int c = 0; c < 4; ++c) qf[hh][c] = *(const bf16x8*)(qp + hh * 64 + 16 * c + 8 * h);
    f32x16 O[2][2]; float ls[2];
    gqa_pair_pass(lds, qf, GK, GV, ntiles, O, ls);
#pragma unroll
    for (int hh = 0; hh < 2; ++hh) { const float inv = 1.0f / ls[hh];
#pragma unroll
        for (int mb = 0; mb < 2; ++mb)
#pragma unroll
            for (int g = 0; g < 4; ++g) { const int dv = 32 * mb + 8 * g + 4 * h;
                *(u32x2*)(qp + hh * 64 + dv) = (u32x2){pk2(O[hh][mb][4 * g] * inv, O[hh][mb][4 * g + 1] * inv), pk2(O[hh][mb][4 * g + 2] * inv, O[hh][mb][4 * g + 3] * inv)}; } }
}

DI void conv_unit(LAS unsigned char* lds, const Ptrs& P, int l, int m0, int s0, int Ls) {
    const int tid = tid_(), lane = tid & 63, wv = tid >> 6;
    LAS bf16_t* vs = (LAS bf16_t*)lds;
    LAS float* wsm = (LAS float*)(lds + 94 * 384 * 2);
    const bf16_t* V = (const bf16_t*)(P.ws + A_V);
    __syncthreads();
    for (int idx = tid; idx < 94 * 48; idx += NTHREADS) { const int rr = idx / 48, ch = idx % 48; const int row = m0 - 15 + rr;
        u32x4 v = (u32x4){0u, 0u, 0u, 0u};
        if (row >= s0 && row < s0 + Ls) v = *(const u32x4*)(V + (size_t)row * 384 + ch * 8);
        *(LAS u32x4*)(vs + rr * 384 + ch * 8) = v; }
    const float* dw = P.in[I_CONVDW] + (size_t)l * 31 * 384;
    for (int idx = tid; idx < 31 * 384; idx += NTHREADS) wsm[idx] = dw[idx];
    __syncthreads();
    const float* bias = P.in[I_CONVB] + l * 384; const float* lg = P.in[I_CONVLNG] + l * 384; const float* lb = P.in[I_CONVLNB] + l * 384;
    const int c0 = lane * 6;
    bf16_t* BRQ = (bf16_t*)(P.ws + A_BRQ);
    float a[8][6];
#pragma unroll
    for (int tt = 0; tt < 8; ++tt)
#pragma unroll
        for (int c = 0; c < 6; ++c) a[tt][c] = bias[c0 + c];
    const LAS bf16_t* vbase = vs + (wv * 8) * 384 + c0;
#pragma unroll 1
    for (int j = 0; j < 31; ++j) {
        const LAS float* wp = wsm + j * 384 + c0;
        const f32x2 w01 = *(const LAS f32x2*)wp, w23 = *(const LAS f32x2*)(wp + 2), w45 = *(const LAS f32x2*)(wp + 4);
#pragma unroll
        for (int tt = 0; tt < 8; ++tt) {
            const LAS unsigned* vp = (const LAS unsigned*)(vbase + (tt + j) * 384);
            const unsigned v0 = vp[0], v1 = vp[1], v2 = vp[2];
            a[tt][0] += w01.x * bflo(v0); a[tt][1] += w01.y * bfhi(v0); a[tt][2] += w23.x * bflo(v1); a[tt][3] += w23.y * bfhi(v1); a[tt][4] += w45.x * bflo(v2); a[tt][5] += w45.y * bfhi(v2);
        }
    }
    float lgv[6], lbv[6];
#pragma unroll
    for (int c = 0; c < 6; ++c) { lgv[c] = lg[c0 + c]; lbv[c] = lb[c0 + c]; }
#pragma unroll
    for (int tt = 0; tt < 8; ++tt) {
        float s = a[tt][0] + a[tt][1] + a[tt][2] + a[tt][3] + a[tt][4] + a[tt][5];
        s = wave_sum(s);
        const float mu = s * (1.0f / 384.0f);
        float q = 0.f;
#pragma unroll
        for (int c = 0; c < 6; ++c) { const float d = a[tt][c] - mu; q += d * d; }
        q = wave_sum(q);
        const float rs = __builtin_amdgcn_rsqf(q * (1.0f / 384.0f) + EPS);
        float o[6];
#pragma unroll
        for (int c = 0; c < 6; ++c) { const float y = (a[tt][c] - mu) * rs * lgv[c] + lbv[c]; o[c] = y * sigmoidf_(y); }
        unsigned* dst = (unsigned*)(BRQ + (size_t)(m0 + wv * 8 + tt) * KBR + 1408 + c0);
        dst[0] = pk2(o[0], o[1]); dst[1] = pk2(o[2], o[3]); dst[2] = pk2(o[4], o[5]);
    }
}


#define XB_TMO      128
#define XB_XCNT(j)  (256  + 64 * (j))
#define XB_XSUB(j)  (1280 + 64 * (j))
#define XB_XGEN(j)  (2304 + 64 * (j))
#define XB_TOP      3328
#define XB_TOPGEN   3392
#define XCD_BAR_WORDS 3456
#define XB_SPIN_CAP (1u << 20)
DI unsigned xb_ld(unsigned* p)              { return __hip_atomic_load(p, __ATOMIC_RELAXED, __HIP_MEMORY_SCOPE_AGENT); }
DI unsigned xb_add(unsigned* p, unsigned v) { return __hip_atomic_fetch_add(p, v, __ATOMIC_RELAXED, __HIP_MEMORY_SCOPE_AGENT); }
DI unsigned xb_xcc_id() { return (unsigned)__builtin_amdgcn_s_getreg((3 << 11) | 20) & 0xFu; }
#define XB_SPIN(cond, bar) do { unsigned _sp = 0; while (cond) { __builtin_amdgcn_s_sleep(1); \
    if ((++_sp & 255u) == 0u) { if (xb_ld(&(bar)[XB_TMO])) break; if (_sp > XB_SPIN_CAP) { atomicAdd(&(bar)[XB_TMO], 1u); break; } } } } while (0)
struct XcdBarrier { unsigned* bar; unsigned x; volatile LAS unsigned* st; };
DI XcdBarrier xcd_barrier_post(unsigned* bar, volatile LAS unsigned* st) {
    XcdBarrier b; b.bar = bar; b.x = xb_xcc_id(); b.st = st;
    if (threadIdx.x == 0) (void)xb_add(&bar[XB_XCNT(b.x)], 1u);
    return b;
}
DI void xcd_barrier_complete(unsigned* bar, unsigned x, unsigned& nloc, unsigned& nx) {
    const unsigned G = gridDim.x * gridDim.y * gridDim.z;
    unsigned sum, cnt, mine, sp = 0u;
    for (;;) {
        sum = 0u; cnt = 0u; mine = 0u;
#pragma unroll
        for (unsigned j = 0; j < 16; ++j) { const unsigned c = xb_ld(&bar[XB_XCNT(j)]); sum += c; cnt += (c > 0u) ? 1u : 0u; mine = (j == x) ? c : mine; }
        if (sum == G) break;
        __builtin_amdgcn_s_sleep(1);
        if ((++sp & 255u) == 0u) { if (xb_ld(&bar[XB_TMO])) break; if (sp > XB_SPIN_CAP) { atomicAdd(&bar[XB_TMO], 1u); break; } }
    }
    nloc = mine > 0u ? mine : 1u; nx = cnt > 0u ? cnt : 1u;
}
DI void xcd_barrier(const XcdBarrier& b) {
    asm volatile("s_waitcnt vmcnt(0)" ::: "memory");
    __syncthreads();
    if (threadIdx.x == 0) {
        unsigned* bar = b.bar;
        __builtin_amdgcn_s_waitcnt(0);
        unsigned nloc = b.st[0], nx = b.st[1];
        if (nloc == 0u) { xcd_barrier_complete(bar, b.x, nloc, nx); b.st[0] = nloc; b.st[1] = nx; }
        const unsigned old = xb_add(&bar[XB_XSUB(b.x)], 1u);
        const unsigned gen = old / nloc;
        if (old + 1u == (gen + 1u) * nloc) {
            __builtin_amdgcn_fence(__ATOMIC_RELEASE, "agent");
            asm volatile("s_waitcnt vmcnt(0)" ::: "memory");
            const unsigned og = xb_add(&bar[XB_TOP], 1u);
            const unsigned tg = og / nx;
            if (og + 1u == (tg + 1u) * nx) xb_add(&bar[XB_TOPGEN], 1u);
            else XB_SPIN(xb_ld(&bar[XB_TOPGEN]) == tg, bar);
            __builtin_amdgcn_fence(__ATOMIC_ACQUIRE, "agent");
            xb_add(&bar[XB_XGEN(b.x)], 1u);
            asm volatile("s_waitcnt vmcnt(0)" ::: "memory");
        } else {
            XB_SPIN(xb_ld(&bar[XB_XGEN(b.x)]) == gen, bar);
            __builtin_amdgcn_fence(__ATOMIC_ACQUIRE, "agent");
            asm volatile("s_waitcnt vmcnt(0)" ::: "memory");
        }
    }
    __syncthreads();
}

struct KArgs { Ptrs p; int ph_lo, ph_hi; };

__global__ void __launch_bounds__(NTHREADS, 2) fwd_mega(KArgs args) {
    extern __shared__ __attribute__((aligned(16))) unsigned char lds_raw[];
    LAS unsigned char* lds = (LAS unsigned char*)lds_raw;
    cg::grid_group grid = cg::this_grid();
    const Ptrs& P = args.p;
    unsigned char* ws = P.ws;
    const int tid = threadIdx.x, bid = blockIdx.x, G = gridDim.x;
    unsigned* ctl = (unsigned*)(ws + OFF_CTL);
    float* misc = (float*)(ws + OFF_MISC);
    int ph = 0;
    if (args.ph_hi < 0) grid.sync();
    volatile LAS unsigned* xst = (volatile LAS unsigned*)(lds + 131072 + 16);
    if (tid == 0) { xst[0] = 0u; xst[1] = 0u; }
    __syncthreads();
    { const XcdBarrier xb0 = xcd_barrier_post((unsigned*)(ws + OFF_BAR), xst); if (tid == 0) xst[2] = xb0.x; }
    __syncthreads();
#define PHASE_BEGIN if (ph >= args.ph_lo && ph < args.ph_hi) {
#define PHASE_END(dosync_) if ((dosync_) && ph + 1 < args.ph_hi) { XcdBarrier xb_; xb_.bar = (unsigned*)(args.p.ws + OFF_BAR); xb_.st = (volatile LAS unsigned*)(lds + 131072 + 16); xb_.x = xb_.st[2]; xcd_barrier(xb_); } } ++ph;

    PHASE_BEGIN
        if (bid == 0) {
            if (tid < 64) ctl[tid] = 0u;
            if (tid < 2) { const float* lv = P.in[I_LAMBDA] + tid * 256; float s0 = 0.f, s1 = 0.f;
                for (int i = 0; i < 64; ++i) { s0 += lv[i] * lv[64 + i]; s1 += lv[128 + i] * lv[192 + i]; }
                const float li = 0.8f - 0.6f * expf(-0.3f * (float)tid);
                misc[tid * 2] = expf(s0) - expf(s1) + li; misc[tid * 2 + 1] = li; }
            for (int i = tid; i < 64 * 16; i += NTHREADS) { const int pos = i >> 4, f = i & 15; const float inv = powf(10000.0f, -(float)f / 16.0f); const float ang = (float)pos * inv;
                ((f32x2*)(ws + OFF_ROPE))[i] = (f32x2){cosf(ang), sinf(ang)}; }
        }
        mod_gemv(lds, P, bid, G);
        conv_win(lds, P, 0, bid, G);
        gen_dft(lds, ws, bid, G, true);
    PHASE_END(true)
    PHASE_BEGIN
        rows_first(P);
    PHASE_END(true)

    for (int l = 0; l < 2; ++l) {
        const int nMt = l == 0 ? 68 : 64;
        PHASE_BEGIN
            RectSched S{(const char*)(ws + OFF_HS), (const char*)(ws + OFF_WINT), (size_t)256 * D * 2, (size_t)256 * D * 2, 16, G, bid, nMt, 15, 64, l == 0 ? 0 : 4, 5};
            EpiInA E{ws, P.in[I_QNORM] + l * 64, P.in[I_KNORM] + l * 64, lds + 131072 + 256, ctl + 32 + 2 * l};
            pg8::gemm_phase(lds, D, D, S, E);
        PHASE_END(true)
        PHASE_BEGIN
            fourier_fold(ws, bid, G);
        PHASE_END(true)
        PHASE_BEGIN
            if (bid < 96) {
                OneSched S; S.have = true; S.u.pm = bid & 15; S.u.pn = bid >> 4; S.u.nt = 64;
                S.u.A = (const char*)(ws + A_DFT) + (size_t)S.u.pm * 256 * 4096 * 2; S.u.B = (const char*)(ws + A_FTF) + (size_t)S.u.pn * 256 * 4096 * 2;
                EpiFourier E{(bf16_t*)(ws + A_BRQ), 0, SEQ, 1.0f / 512.0f};
                pg8::gemm_phase(lds, 4096, 4096, S, E);
            } else if (l == 0 && bid < 102) {
                OneSched S; S.have = true; S.u.pm = 0; S.u.pn = bid - 96; S.u.nt = 8;
                S.u.A = (const char*)(ws + OFF_DFTC); S.u.B = (const char*)(ws + A_FTC) + (size_t)S.u.pn * 256 * 512 * 2;
                EpiFourier E{(bf16_t*)(ws + A_BRQ), MLAT, LC, 1.0f / 128.0f};
                pg8::gemm_phase(lds, 512, 512, S, E);
            }
            {
                const float lam = __uint_as_float(__builtin_amdgcn_readfirstlane(__float_as_uint(misc[l * 2]))), lam_init = __uint_as_float(__builtin_amdgcn_readfirstlane(__float_as_uint(misc[l * 2 + 1])));
                bool gsmall;
                { float mq = fabsf(P.in[I_QNORM][l * 64 + (tid & 63)]), mk = fabsf(P.in[I_KNORM][l * 64 + (tid & 63)]);
#pragma unroll
                  for (int o = 32; o >= 1; o >>= 1) { mq = fmaxf(mq, __shfl_xor(mq, o)); mk = fmaxf(mk, __shfl_xor(mk, o)); }
                  gsmall = __builtin_amdgcn_readfirstlane((int)(64.0f * QSCALE * 1.02f * mq * mk < 60.0f)) != 0; }
                const int n_diff = 32, n_gqa = 32, n_cd = l == 0 ? 2 : 0, n_cg = l == 0 ? 2 : 0, n_conv = l == 0 ? 34 : 32;
                const int total = n_diff + n_gqa + n_cd + n_cg + n_conv;
                volatile LAS int* slot = (volatile LAS int*)(lds + 131072);
                for (int dx = 0; dx < 8; ++dx) {
                    const int x = (bid + dx) & 7;
                    for (;;) {
                        __syncthreads();
                        if (tid == 0) *slot = (int)atomicAdd(ctl + l * 8 + x, 1u);
                        __syncthreads();
                        int it = *slot;
                        if (it >= total) break;
                        if (it < n_diff) { const int pi = 2 * x + (it >> 4), b = pi >> 2, hd = pi & 3, qb = it & 15; diff_unit(lds, P, l, b, hd, b * SEQ + qb * 256, 0, LKV / 64, lam, lam_init); continue; }
                        it -= n_diff;
                        if (it < n_gqa) { const int b = x >> 1, qh = (x & 1) * 4 + 2 * (it >> 4), qb = it & 15; if (gsmall) gqa_pair_unit(lds, P, l, b, qh, b * SEQ + qb * 256, 0, LKV / 64);
                            else {
#pragma nounroll
                                for (int hh = 0; hh < 2; ++hh) gqa_unit(lds, P, l, b, qh + hh, b * SEQ + qb * 256, 0, LKV / 64); }
                            continue; }
                        it -= n_gqa;
                        if (it < n_cd) { const int pi = 2 * x + it, b = pi >> 2, hd = pi & 3; diff_unit(lds, P, l, b, hd, MLAT + b * LC, SEQ, LC / 64, lam, lam_init); continue; }
                        it -= n_cd;
                        if (it < n_cg) { const int b = x >> 1, qh = (x & 1) * 4 + 2 * it; if (gsmall) gqa_pair_unit(lds, P, l, b, qh, MLAT + b * LC, SEQ, LC / 64);
                            else {
#pragma nounroll
                                for (int hh = 0; hh < 2; ++hh) gqa_unit(lds, P, l, b, qh + hh, MLAT + b * LC, SEQ, LC / 64); }
                            continue; }
                        it -= n_cg;
                        { const int m0 = (x * n_conv + it) * 64; int s0, Ls; if (m0 < MLAT) { s0 = m0 & ~4095; Ls = SEQ; } else { s0 = MLAT + ((m0 - MLAT) & ~255); Ls = LC; }
                          conv_unit(lds, P, l, m0, s0, Ls); }
                    }
                }
                __syncthreads();
            }
        PHASE_END(true)
        PHASE_BEGIN
            {
                bf16_t* wbr = (bf16_t*)(ws + A_WBRT);
                convT(lds, P.in[I_WBRF] + (size_t)l * 384 * D, D, 384, wbr, KBR, D, MapId{0}, bid, G);
                convT(lds, P.in[I_WBRD] + (size_t)l * 512 * D, D, 512, wbr + 384, KBR, D, MapId{0}, (bid + 48) % G, G);
                convT(lds, P.in[I_WBRG] + (size_t)l * 512 * D, D, 512, wbr + 896, KBR, D, MapId{0}, (bid + 112) % G, G);
                convT(lds, P.in[I_WBRC] + (size_t)l * 384 * D, D, 384, wbr + 1408, KBR, D, MapId{0}, (bid + 176) % G, G);
                convT(lds, P.in[I_WOUT] + (size_t)l * D * D, D, D, (bf16_t*)(ws + A_WOUTT), D, D, MapId{0}, (bid + 224) % G, G);
                __syncthreads();
            }
            RectSched S{(const char*)(ws + OFF_HS), (const char*)(ws + OFF_WINT) + (size_t)3840 * D * 2, (size_t)256 * D * 2, (size_t)256 * D * 2, 16, G, bid, nMt, 16, 0, 0, 0};
            EpiGate E{(bf16_t*)(ws + A_G)};
            pg8::gemm_phase(lds, D, D, S, E);
        PHASE_END(true)
        PHASE_BEGIN
            RectSched S{(const char*)(ws + A_BRQ), (const char*)(ws + A_WBRT), (size_t)256 * KBR * 2, (size_t)256 * KBR * 2, 28, G, bid, nMt, 4, 0, 0, 0};
            EpiBranch E{(const bf16_t*)(ws + A_G), (bf16_t*)(ws + OFF_HS)};
            pg8::gemm_phase(lds, KBR, KBR, S, E);
        PHASE_END(true)
        PHASE_BEGIN
            RectSched S{(const char*)(ws + OFF_HS), (const char*)(ws + A_WOUTT), (size_t)256 * D * 2, (size_t)256 * D * 2, 16, G, bid, nMt, 4, 0, 0, 0};
            EpiBf16<0> E{(bf16_t*)(ws + A_MIXO), D};
            pg8::gemm_phase(lds, D, D, S, E);
        PHASE_END(true)
        PHASE_BEGIN
            rows_update(P, l, 0, l == 0 ? MTOT : MLAT);
            convT(lds, P.in[I_WFF1] + (size_t)l * D * DFF, DFF, D, (bf16_t*)(ws + A_WFF1T), D, DFF, MapId{0}, bid, G);
            convT(lds, P.in[I_WFF2] + (size_t)l * DFF * D, D, DFF, (bf16_t*)(ws + A_WFF2T), DFF, D, MapId{0}, bid, G);
        PHASE_END(true)
        PHASE_BEGIN
            RectSched S{(const char*)(ws + OFF_HS), (const char*)(ws + A_WFF1T), (size_t)256 * D * 2, (size_t)256 * D * 2, 16, G, bid, nMt, 16, 0, 0, 0};
            EpiBf16<2> E{(bf16_t*)(ws + A_FF), DFF};
            pg8::gemm_phase(lds, D, D, S, E);
        PHASE_END(true)
        PHASE_BEGIN
            RectSched S{(const char*)(ws + A_FF), (const char*)(ws + A_WFF2T), (size_t)256 * DFF * 2, (size_t)256 * DFF * 2, 64, G, bid, nMt, 4, 0, 0, 0};
            EpiBf16<0> E{(bf16_t*)(ws + A_MIXO), D};
            pg8::gemm_phase(lds, DFF, DFF, S, E);
        PHASE_END(true)
        PHASE_BEGIN
            rows_update(P, l, 1, l == 0 ? MTOT : MLAT);
            if (l == 0) { conv_win(lds, P, 1, bid, G); gen_dft(lds, ws, bid, G, false); }
        PHASE_END(l == 0)
    }
}

extern "C" void kernel_launch(void* const* d_in, const int* in_sizes, int n_in, void* d_out, int out_size, void* d_ws, size_t ws_size, hipStream_t stream) {
    static int grid = 0;
    if (grid == 0) {
        if (n_in != 26 || ws_size < WS_END) { fprintf(stderr, "kernel_launch: unexpected inputs (%d) or workspace (%zu < %zu)\n", n_in, ws_size, (size_t)WS_END); grid = -1; return; }
        int dev = 0, cus = 0, per_cu = 0;
        (void)hipGetDevice(&dev);
        (void)hipDeviceGetAttribute(&cus, hipDeviceAttributeMultiprocessorCount, dev);
        if (hipFuncSetAttribute((const void*)fwd_mega, hipFuncAttributeMaxDynamicSharedMemorySize, LDS_BYTES) != hipSuccess) { fprintf(stderr, "hipFuncSetAttribute failed\n"); grid = -1; return; }
        if (hipOccupancyMaxActiveBlocksPerMultiprocessor(&per_cu, (const void*)fwd_mega, NTHREADS, LDS_BYTES) != hipSuccess || per_cu < 1) { fprintf(stderr, "occupancy query: %d\n", per_cu); per_cu = 1; }
        (void)hipGetLastError();
        grid = cus * per_cu;
        if (grid > 256) grid = 256;
    }
    if (grid < 0) return;
    KArgs a{};
    for (int i = 0; i < 26; ++i) a.p.in[i] = (const float*)d_in[i];
    a.p.out = (float*)d_out; a.p.ws = (unsigned char*)d_ws;
#ifndef PROBE_RANGES
#define PROBE_RANGES {0, 1000}
#endif
    static const int ranges[][2] = { PROBE_RANGES };
    const int nr = (int)(sizeof(ranges) / sizeof(ranges[0]));
    for (int i = 0; i < nr; ++i) {
        if (i > 0) (void)hipMemsetAsync((char*)d_ws + OFF_CTL, 0, 256, stream);
        (void)hipMemsetAsync((char*)d_ws + OFF_BAR, 0, 16384, stream);
        a.ph_lo = ranges[i][0]; a.ph_hi = ranges[i][1];
        void* kargs[] = {&a};
        hipError_t e = hipLaunchCooperativeKernel((const void*)fwd_mega, dim3(grid), dim3(NTHREADS), kargs, LDS_BYTES, stream);
        if (e != hipSuccess) fprintf(stderr, "cooperative launch failed: %s (grid %d)\n", hipGetErrorString(e), grid);
    }
}
```

```cpp
#include <hip/hip_runtime.h>
#include <hip/hip_cooperative_groups.h>
#include <cstdint>
#include <cstdio>
namespace cg = cooperative_groups;

#define LAS __attribute__((address_space(3)))
#define DI __device__ __forceinline__
typedef unsigned short bf16_t;
typedef short bf16x8 __attribute__((ext_vector_type(8)));
typedef short s16x4 __attribute__((ext_vector_type(4)));
typedef float f32x4 __attribute__((ext_vector_type(4)));
typedef float f32x2 __attribute__((ext_vector_type(2)));
typedef float f32x16 __attribute__((ext_vector_type(16)));
typedef unsigned u32x4 __attribute__((ext_vector_type(4)));
typedef unsigned u32x2 __attribute__((ext_vector_type(2)));
typedef __bf16 bf16x2_t __attribute__((ext_vector_type(2)));

DI unsigned pk2(float lo, float hi) { f32x2 v = {lo, hi}; return __builtin_bit_cast(unsigned, __builtin_convertvector(v, bf16x2_t)); }
DI float bflo(unsigned u) { return __uint_as_float(u << 16); }
DI float bfhi(unsigned u) { return __uint_as_float(u & 0xffff0000u); }
DI float sigmoidf_(float x) { return __builtin_amdgcn_rcpf(1.0f + __builtin_amdgcn_exp2f(-1.44269504f * x)); }
DI int tid_() { int t = threadIdx.x; asm volatile("" : "+v"(t)); return t; }
#define SWZ(v, O) __int_as_float(__builtin_amdgcn_ds_swizzle(__float_as_int(v), 0x1F | ((O) << 10)))
DI float add_x32(float v) { const u32x2 s = __builtin_amdgcn_permlane32_swap(__float_as_uint(v), __float_as_uint(v), false, false); return __uint_as_float(s[0]) + __uint_as_float(s[1]); }
DI float max_x32(float v) { const u32x2 s = __builtin_amdgcn_permlane32_swap(__float_as_uint(v), __float_as_uint(v), false, false); return fmaxf(__uint_as_float(s[0]), __uint_as_float(s[1])); }
DI float wave_sum(float v) { v += SWZ(v, 1); v += SWZ(v, 2); v += SWZ(v, 4); v += SWZ(v, 8); v += SWZ(v, 16); return add_x32(v); }
DI float wave_max(float v) { v = fmaxf(v, SWZ(v, 1)); v = fmaxf(v, SWZ(v, 2)); v = fmaxf(v, SWZ(v, 4)); v = fmaxf(v, SWZ(v, 8)); v = fmaxf(v, SWZ(v, 16)); return max_x32(v); }

constexpr int D = 1024, NB = 4, SEQ = 4096, LC = 256, MLAT = NB * SEQ, MCTX = NB * LC, MTOT = MLAT + MCTX, LKV = SEQ + LC;
constexpr int IN_COLS = 7552, NIN = 7936, DFF = 4096, KBR = 1792;
constexpr float EPS = 1e-6f;
constexpr float QSCALE = 0.125f * 1.44269504f;
enum { I_X = 0, I_C, I_CTX, I_CCTX, I_WMOD, I_BMOD, I_GPREMIX, I_GPOSTMIX, I_GPREMLP, I_GPOSTMLP, I_WIN, I_QNORM, I_KNORM, I_LAMBDA, I_SUBLN,
       I_CONVDW, I_CONVB, I_CONVLNG, I_CONVLNB, I_WBRF, I_WBRD, I_WBRG, I_WBRC, I_WOUT, I_WFF1, I_WFF2 };

constexpr size_t OFF_CTL = 0, OFF_MISC = 4096, OFF_MOD = 8192, OFF_ROPE = 253952, OFF_DFTC = 262144, OFF_HS = 524288;
constexpr size_t OFF_WINT = OFF_HS + (size_t)MTOT * D * 2;
constexpr size_t ARENA = OFF_WINT + (size_t)NIN * D * 2;
constexpr size_t A_BRQ = ARENA, A_MIXO = ARENA;
constexpr size_t A_G = ARENA + (size_t)MTOT * KBR * 2;
constexpr size_t A_DFT = A_G;
constexpr size_t A_FTF = A_DFT + (size_t)4096 * 4096 * 2;
constexpr size_t A_FT = A_DFT + (size_t)4096 * 8192 * 2;
constexpr size_t A_FTC = A_FT + (size_t)NB * 384 * 8192 * 2;
constexpr size_t A_DK = A_FTC + (size_t)NB * 384 * 512 * 2;
constexpr size_t A_DV = A_DK + (size_t)MTOT * 512 * 2;
constexpr size_t A_GK = A_DV + (size_t)MTOT * 512 * 2;
constexpr size_t A_GV = A_GK + (size_t)MTOT * 128 * 2;
constexpr size_t A_V = A_GV + (size_t)MTOT * 128 * 2;
constexpr size_t A_VEND = A_V + (size_t)MTOT * 384 * 2;
constexpr size_t A_WBRT = A_G + (size_t)MTOT * 4096 * 2;
constexpr size_t A_WOUTT = A_WBRT + (size_t)D * KBR * 2;
constexpr size_t A_FF = ARENA + (size_t)MTOT * D * 2;
constexpr size_t A_WFF1T = A_FF + (size_t)MTOT * DFF * 2;
constexpr size_t A_WFF2T = A_WFF1T + (size_t)DFF * D * 2;
constexpr size_t A_XC = A_WFF2T + (size_t)DFF * D * 2;
constexpr size_t OFF_BAR = A_VEND;
constexpr size_t WS_END = OFF_BAR + 16384;
static_assert(A_XC + (size_t)MCTX * D * 4 <= A_WBRT, "xc overlaps");
static_assert(A_WOUTT + (size_t)D * D * 2 <= WS_END, "ws end");
static_assert(WS_END <= 268435456ull, "workspace too large");

constexpr int LDS_BYTES = 131072 + 256 + 18432;
constexpr int NTHREADS = 512;

namespace pg8 {
constexpr int BM = 256, BK = 64, HALF = 128, HTB = HALF * BK * 2, NXCD = 8, WGM = 8;
DI int lds_byte(int r, int c) { const int st = (r >> 4) * 2 + (c >> 5), rr = r & 15, cc = c & 31, ob = rr * 64 + cc * 2; return st * 1024 + (ob ^ (((ob >> 9) & 1) << 5)); }
DI void stage_rc(int b, int& R, int& C) { const int st = b / 1024, sb = b % 1024, swz = sb ^ (((sb >> 9) & 1) << 5); R = (st >> 1) * 16 + swz / 64; C = (st & 1) * 32 + (swz % 64) / 2; }
DI int perm32(int rho) { const int n = rho >> 4, i = rho & 15; return 8 * (i >> 2) + 4 * n + (i & 3); }

struct Unit { const char* A; const char* B; int nt, pm, pn; };

DI void rect_map(int L, int nM, int nN, int& pm, int& pn) {
    const int nwg = nM * nN; int wgid = L;
    { const int q = nwg / NXCD, r = nwg % NXCD, xcd = wgid % NXCD, off = wgid / NXCD; wgid = (xcd < r ? xcd * (q + 1) : r * (q + 1) + (xcd - r) * q) + off; }
    const int nig = WGM * nN, gid = wgid / nig, fm = gid * WGM, gsz = (nM - fm) < WGM ? (nM - fm) : WGM;
    pm = fm + ((wgid % nig) % gsz); pn = (wgid % nig) / gsz;
}

template <class Epi, class Sched>
DI void gemm_phase(LAS unsigned char* lds, const int lda, const int ldb, const Sched& S, const Epi& E) {
    int tid = threadIdx.x; asm volatile("" : "+v"(tid));
    const int wid = __builtin_amdgcn_readfirstlane(tid >> 6), lane = tid & 63, wr = wid >> 2, wc = wid & 3, fr = lane & 15, fq = lane >> 4;
    unsigned voffA[2], voffB[2];
#pragma unroll
    for (int i = 0; i < 2; ++i) { int R, C; stage_rc(tid * 16 + i * 8192, R, C); const int Rb = Epi::PERM ? ((R & ~31) + perm32(R & 31)) : R;
        voffA[i] = (unsigned)(R * lda + C) * 2u; voffB[i] = (unsigned)(Rb * ldb + C) * 2u; }
    const size_t kstep = (size_t)(BK * 2);
    const size_t hstepA = (size_t)HALF * lda * 2, hstepB = (size_t)HALF * ldb * 2;
    const unsigned ldsw = (unsigned)wid * 1024u;
    const int aoff = lds_byte(wr * 64 + fr, fq * 8), boff = lds_byte(wc * 32 + fr, fq * 8);
#define PG8_SA(b, h) (((b) * 2 + (h)) * HTB)
#define PG8_SB(b, h) ((4 + (b) * 2 + (h)) * HTB)
#define PG8_STAGE(bufoff, gbase, voff) do { _Pragma("unroll") for (int _i = 0; _i < 2; ++_i) \
        __builtin_amdgcn_global_load_lds((const unsigned*)((const char*)(gbase) + (voff)[_i]), (LAS unsigned*)(lds + (bufoff) + ldsw + _i * 8192), 16, 0, 0); } while (0)
#define PG8_LDA(dst, b, h) do { _Pragma("unroll") for (int m = 0; m < 4; ++m) _Pragma("unroll") for (int k = 0; k < 2; ++k) dst[m][k] = *(const LAS bf16x8*)(lds + PG8_SA(b, h) + aoff + m * 2048 + k * 1024); } while (0)
#define PG8_LDB(dst, b, h) do { _Pragma("unroll") for (int n = 0; n < 2; ++n) _Pragma("unroll") for (int k = 0; k < 2; ++k) dst[n][k] = *(const LAS bf16x8*)(lds + PG8_SB(b, h) + boff + n * 2048 + k * 1024); } while (0)
#define PG8_MMA(ai, bj, At, Bt) do { __builtin_amdgcn_s_setprio(1); _Pragma("unroll") for (int m = 0; m < 4; ++m) _Pragma("unroll") for (int n = 0; n < 2; ++n) _Pragma("unroll") for (int k = 0; k < 2; ++k) \
        acc[ai][bj][m][n] = __builtin_amdgcn_mfma_f32_16x16x32_bf16(Bt[n][k], At[m][k], acc[ai][bj][m][n], 0, 0, 0); __builtin_amdgcn_s_setprio(0); } while (0)
#define PG8_WAIT_V(n) asm volatile("s_waitcnt vmcnt(" #n ")" ::: "memory")
#define PG8_WAIT_L(n) asm volatile("s_waitcnt lgkmcnt(" #n ")" ::: "memory")
#define PG8_BAR __builtin_amdgcn_s_barrier()
#define PG8_SCHED __builtin_amdgcn_sched_barrier(0)
    Unit cur, nxt; int ui = 0;
    if (!S.next(0, cur)) return;
    f32x4 acc[2][2][4][2];
#pragma unroll
    for (int a = 0; a < 2; ++a)
#pragma unroll
        for (int b = 0; b < 2; ++b)
#pragma unroll
            for (int m = 0; m < 4; ++m)
#pragma unroll
                for (int n = 0; n < 2; ++n) acc[a][b][m][n] = (f32x4){0.f, 0.f, 0.f, 0.f};
    bf16x8 At[4][2], B0[2][2], B1[2][2];
    const char* cA = cur.A; const char* cB = cur.B;
    PG8_STAGE(PG8_SB(0, 0), cB, voffB); PG8_STAGE(PG8_SB(0, 1), cB + hstepB, voffB); PG8_STAGE(PG8_SA(0, 0), cA, voffA); PG8_STAGE(PG8_SA(0, 1), cA + hstepA, voffA);
    if (wr == 1) PG8_BAR;
    PG8_WAIT_V(2); PG8_BAR;
    PG8_STAGE(PG8_SB(1, 0), cB + kstep, voffB); PG8_STAGE(PG8_SA(1, 0), cA + kstep, voffA); PG8_STAGE(PG8_SB(1, 1), cB + hstepB + kstep, voffB);
    PG8_WAIT_V(6); PG8_BAR;
    for (;;) {
        const bool has_next = S.next(ui + 1, nxt);
        const char* nA = has_next ? nxt.A : cA; const char* nB = has_next ? nxt.B : cB;
        const int nt = cur.nt;
        for (int t = 0; t < nt; t += 2) {
            if constexpr (Epi::HOOK) { if (t == 6 || t == 14 || t == 22) E.hook(acc, cur, t, wr, wc, fr, fq); }
            const bool last = (t == nt - 2);
            const char* a1 = cA + (size_t)(t + 1) * kstep;
            const char* a2 = last ? nA : cA + (size_t)(t + 2) * kstep; const char* b2 = last ? nB : cB + (size_t)(t + 2) * kstep;
            const char* a3 = a2 + kstep; const char* b3 = b2 + kstep;
            PG8_LDB(B0, 0, 0); PG8_LDB(B1, 0, 1); PG8_SCHED; PG8_LDA(At, 0, 0); PG8_STAGE(PG8_SA(1, 1), a1 + hstepA, voffA);
            PG8_WAIT_V(8); PG8_WAIT_L(0); PG8_BAR; PG8_MMA(0, 0, At, B0); PG8_MMA(0, 1, At, B1); PG8_BAR; PG8_SCHED;
            PG8_LDA(At, 0, 1); PG8_STAGE(PG8_SB(0, 0), b2, voffB); PG8_STAGE(PG8_SB(0, 1), b2 + hstepB, voffB); PG8_STAGE(PG8_SA(0, 0), a2, voffA);
            PG8_WAIT_V(8); PG8_WAIT_L(0); PG8_BAR; PG8_MMA(1, 0, At, B0); PG8_MMA(1, 1, At, B1); PG8_BAR; PG8_SCHED;
            PG8_LDB(B0, 1, 0); PG8_LDB(B1, 1, 1); PG8_SCHED; PG8_LDA(At, 1, 0); PG8_STAGE(PG8_SA(0, 1), a2 + hstepA, voffA);
            PG8_WAIT_V(8); PG8_WAIT_L(0); PG8_BAR; PG8_MMA(0, 0, At, B0); PG8_MMA(0, 1, At, B1); PG8_BAR; PG8_SCHED;
            PG8_LDA(At, 1, 1); PG8_STAGE(PG8_SB(1, 0), b3, voffB); PG8_STAGE(PG8_SB(1, 1), b3 + hstepB, voffB); PG8_STAGE(PG8_SA(1, 0), a3, voffA);
            PG8_WAIT_V(8); PG8_WAIT_L(0); PG8_BAR; PG8_MMA(1, 0, At, B0); PG8_MMA(1, 1, At, B1); PG8_BAR; PG8_SCHED;
        }
        if (wr == 0) PG8_BAR;
        E(acc, cur, wr, wc, fr, fq);
        if (!has_next) break;
#pragma unroll
        for (int a = 0; a < 2; ++a)
#pragma unroll
            for (int b = 0; b < 2; ++b)
#pragma unroll
                for (int m = 0; m < 4; ++m)
#pragma unroll
                    for (int n = 0; n < 2; ++n) acc[a][b][m][n] = (f32x4){0.f, 0.f, 0.f, 0.f};
        cur = nxt; cA = nA; cB = nB; ++ui;
        if (wr == 1) PG8_BAR;
    }
    PG8_WAIT_V(0);
    PG8_BAR;
#undef PG8_SA
#undef PG8_SB
#undef PG8_STAGE
#undef PG8_LDA
#undef PG8_LDB
#undef PG8_MMA
#undef PG8_WAIT_V
#undef PG8_WAIT_L
#undef PG8_BAR
#undef PG8_SCHED
}
}
using pg8::Unit;
typedef f32x4 Acc[2][2][4][2];

struct RectSched {
    const char* A; const char* B; size_t astep, bstep;
    int nt, G, c, nM1, nN1, m2, nM2, nN2;
    DI bool next(int i, Unit& u) const {
        const int L = i * G + c; const int n1 = nM1 * nN1;
        int pm, pn;
        if (L < n1) pg8::rect_map(L, nM1, nN1, pm, pn);
        else if (L < n1 + nM2 * nN2) { pg8::rect_map(L - n1, nM2, nN2, pm, pn); pm += m2; }
        else return false;
        u.pm = pm; u.pn = pn; u.nt = nt; u.A = A + (size_t)pm * astep; u.B = B + (size_t)pn * bstep; return true;
    }
};
struct OneSched {
    Unit u; bool have;
    DI bool next(int i, Unit& o) const { if (i != 0 || !have) return false; o = u; return true; }
};

struct Ptrs {
    const float* in[26]; float* out; unsigned char* ws;
};

struct EpiInA {
    static constexpr bool PERM = true, HOOK = false;
    unsigned char* ws; const float* qn; const float* kn;
    LAS unsigned char* scr;
    unsigned* nrm;
    DI void hook(Acc&, const Unit&, int, int, int, int, int) const {}
    DI void operator()(const Acc& acc, const Unit& u, int wr, int wc, int fr, int fq) const {
        const int pn = u.pn;
        const f32x2* rope = (const f32x2*)(ws + OFF_ROPE);
        bf16_t* BRQ = (bf16_t*)(ws + A_BRQ);
        const bool ctx = u.pm >= 64;
        if (pn <= 1 || pn == 5 || pn == 6) {
            float nmax = 0.f;
#pragma unroll
            for (int ai = 0; ai < 2; ++ai)
#pragma unroll
                for (int m = 0; m < 4; ++m) {
                const int row = u.pm * 256 + ai * 128 + wr * 64 + m * 16 + fr;
                int b, t, kvrow;
                if (!ctx) { b = row >> 12; t = row & 4095; kvrow = b * LKV + t; }
                else { const int j = row - MLAT; b = j >> 8; t = j & 255; kvrow = b * LKV + SEQ + t; }
                const int prow = t >> 6, pcol = t & 63; (void)b; (void)kvrow; (void)prow; (void)pcol;
                    const bool isq = pn >= 5;
                    const int axis = wc & 1; const int pos = axis ? pcol : prow;
                    f32x2 cs[4];
#pragma unroll
                    for (int j = 0; j < 4; ++j) cs[j] = ctx ? (f32x2){1.f, 0.f} : rope[pos * 16 + 4 * fq + j];
#pragma unroll
                    for (int bj = 0; bj < 2; ++bj) {
                        const f32x4 re = acc[ai][bj][m][0], im = acc[ai][bj][m][1];
                        float o0[4], o1[4];
#pragma unroll
                        for (int j = 0; j < 4; ++j) { o0[j] = re[j] * cs[j].x - im[j] * cs[j].y; o1[j] = im[j] * cs[j].x + re[j] * cs[j].y; if (isq) { o0[j] *= QSCALE; o1[j] *= QSCALE; } }
                        const int c = (isq ? (pn - 5) : pn) * 256 + bj * 128 + wc * 32 + 8 * fq;
                        bf16_t* dst = isq ? (BRQ + (size_t)row * KBR + 384 + c) : ((bf16_t*)(ws + A_DK) + (size_t)kvrow * 512 + c);
                        *(u32x4*)dst = (u32x4){pk2(o0[0], o0[1]), pk2(o0[2], o0[3]), pk2(o1[0], o1[1]), pk2(o1[2], o1[3])};
                        float ss = o0[0] * o0[0] + o0[1] * o0[1] + o0[2] * o0[2] + o0[3] * o0[3] + o1[0] * o1[0] + o1[1] * o1[1] + o1[2] * o1[2] + o1[3] * o1[3];
                        ss += SWZ(ss, 16); ss = add_x32(ss); nmax = fmaxf(nmax, ss);
                    }
                }
            nmax = fmaxf(nmax, SWZ(nmax, 8)); nmax = fmaxf(nmax, SWZ(nmax, 4)); nmax = fmaxf(nmax, SWZ(nmax, 2)); nmax = fmaxf(nmax, SWZ(nmax, 1));
            if (fq == 0 && fr == 0) atomicMax(nrm + (pn >= 5 ? 1 : 0), __float_as_uint(nmax));
        } else if (pn == 2 || pn == 3) {
#pragma unroll
            for (int ai = 0; ai < 2; ++ai)
#pragma unroll
                for (int m = 0; m < 4; ++m) {
                const int row = u.pm * 256 + ai * 128 + wr * 64 + m * 16 + fr;
                int b, t, kvrow;
                if (!ctx) { b = row >> 12; t = row & 4095; kvrow = b * LKV + t; }
                else { const int j = row - MLAT; b = j >> 8; t = j & 255; kvrow = b * LKV + SEQ + t; }
                const int prow = t >> 6, pcol = t & 63; (void)b; (void)kvrow; (void)prow; (void)pcol;
#pragma unroll
                    for (int bj = 0; bj < 2; ++bj)
#pragma unroll
                        for (int n = 0; n < 2; ++n) { const f32x4 v = acc[ai][bj][m][n]; const int c = (pn - 2) * 256 + bj * 128 + wc * 32 + 8 * fq + 4 * n;
                            *(u32x2*)((bf16_t*)(ws + A_DV) + (size_t)kvrow * 512 + c) = (u32x2){pk2(v[0], v[1]), pk2(v[2], v[3])}; }
                }
        } else if (pn == 4 || pn == 7 || pn == 8) {
#pragma unroll
            for (int ai = 0; ai < 2; ++ai)
#pragma unroll
                for (int m = 0; m < 4; ++m) {
                const int row = u.pm * 256 + ai * 128 + wr * 64 + m * 16 + fr;
                int b, t, kvrow;
                if (!ctx) { b = row >> 12; t = row & 4095; kvrow = b * LKV + t; }
                else { const int j = row - MLAT; b = j >> 8; t = j & 255; kvrow = b * LKV + SEQ + t; }
                const int prow = t >> 6, pcol = t & 63; (void)b; (void)kvrow; (void)prow; (void)pcol;
                    const bool isq = pn >= 7; const bool isv = (pn == 4) && wc >= 2;
                    float ss = 0.f;
#pragma unroll
                    for (int bj = 0; bj < 2; ++bj)
#pragma unroll
                        for (int n = 0; n < 2; ++n) { const f32x4 v = acc[ai][bj][m][n]; ss += v[0] * v[0] + v[1] * v[1] + v[2] * v[2] + v[3] * v[3]; }
                    ss += SWZ(ss, 16); ss = add_x32(ss);
                    const float rs = isv ? 1.f : __builtin_amdgcn_rsqf(ss * (1.0f / 64.0f) + EPS);
                    const float* gn = isq ? qn : kn;
                    bf16_t* dst;
                    if (isq) dst = BRQ + (size_t)row * KBR + 896 + ((pn - 7) * 4 + wc) * 64;
                    else if (isv) dst = (bf16_t*)(ws + A_GV) + (size_t)kvrow * 128 + (wc - 2) * 64;
                    else dst = (bf16_t*)(ws + A_GK) + (size_t)kvrow * 128 + wc * 64;
#pragma unroll
                    for (int bj = 0; bj < 2; ++bj) {
                        const int pos = bj ? pcol : prow;
                        float o0[4], o1[4];
#pragma unroll
                        for (int j = 0; j < 4; ++j) {
                            float re = acc[ai][bj][m][0][j], im = acc[ai][bj][m][1][j];
                            if (!isv) { re *= rs * gn[32 * bj + 4 * fq + j]; im *= rs * gn[32 * bj + 16 + 4 * fq + j]; }
                            f32x2 cs = (ctx || isv) ? (f32x2){1.f, 0.f} : rope[pos * 16 + 4 * fq + j];
                            o0[j] = re * cs.x - im * cs.y; o1[j] = im * cs.x + re * cs.y;
                            if (isq) { o0[j] *= QSCALE; o1[j] *= QSCALE; }
                        }
                        *(u32x4*)(dst + 32 * bj + 8 * fq) = (u32x4){pk2(o0[0], o0[1]), pk2(o0[2], o0[3]), pk2(o1[0], o1[1]), pk2(o1[2], o1[3])};
                    }
                }
        } else if (pn <= 11) {
            const int lane = fq * 16 + fr, col = lane >> 2, chunk = lane & 3;
            LAS bf16_t* sw = (LAS bf16_t*)(scr + (wr * 4 + wc) * 2304);
#pragma unroll
            for (int ai = 0; ai < 2; ++ai) {
                const int row0 = u.pm * 256 + ai * 128 + wr * 64;
                int b, t0; if (!ctx) { b = row0 >> 12; t0 = row0 & 4095; } else { const int j = row0 - MLAT; b = j >> 8; t0 = j & 255; }
#pragma unroll
                for (int bj = 0; bj < 2; ++bj)
#pragma unroll
                    for (int n = 0; n < 2; ++n) {
#pragma unroll
                        for (int m = 0; m < 4; ++m) { const f32x4 v = acc[ai][bj][m][n];
#pragma unroll
                            for (int j = 0; j < 4; ++j) sw[(4 * fq + j) * 72 + 16 * m + fr] = (bf16_t)(pk2(v[j], 0.f) & 0xffffu); }
                        asm volatile("s_waitcnt lgkmcnt(0)" ::: "memory");
                        const u32x4 v0 = *(const LAS u32x4*)(sw + col * 72 + chunk * 16), v1 = *(const LAS u32x4*)(sw + col * 72 + chunk * 16 + 8);
                        const int c0 = (pn - 9) * 256 + bj * 128 + wc * 32 + 8 * (col >> 2) + 4 * n + (col & 3); const int part = c0 >= 384 ? 1 : 0; const int ch = c0 - part * 384;
                        bf16_t* dst = ctx ? ((bf16_t*)(ws + A_FTC) + (size_t)(b * 384 + ch) * 512 + part * 256 + t0 + chunk * 16)
                                          : ((bf16_t*)(ws + A_FT) + (size_t)(b * 384 + ch) * 8192 + part * 4096 + t0 + chunk * 16);
                        *(u32x4*)dst = v0; *(u32x4*)(dst + 8) = v1;
                        asm volatile("s_waitcnt lgkmcnt(0)" ::: "memory");
                    }
            }
        } else {
#pragma unroll
            for (int ai = 0; ai < 2; ++ai)
#pragma unroll
                for (int m = 0; m < 4; ++m) {
                const int row = u.pm * 256 + ai * 128 + wr * 64 + m * 16 + fr;
                int b, t, kvrow;
                if (!ctx) { b = row >> 12; t = row & 4095; kvrow = b * LKV + t; }
                else { const int j = row - MLAT; b = j >> 8; t = j & 255; kvrow = b * LKV + SEQ + t; }
                const int prow = t >> 6, pcol = t & 63; (void)b; (void)kvrow; (void)prow; (void)pcol;
#pragma unroll
                    for (int bj = 0; bj < 2; ++bj) {
                        const f32x4 a = acc[ai][bj][m][0], g = acc[ai][bj][m][1];
                        const int ch = ((pn - 12) * 8 + 4 * bj + wc) * 16 + 4 * fq;
                        float o[4];
#pragma unroll
                        for (int j = 0; j < 4; ++j) o[j] = a[j] * sigmoidf_(g[j]);
                        *(u32x2*)((bf16_t*)(ws + A_V) + (size_t)row * 384 + ch) = (u32x2){pk2(o[0], o[1]), pk2(o[2], o[3])};
                    }
                }
        }
    }
};

template <int ACT> struct EpiBf16 {
    static constexpr bool PERM = true, HOOK = false;
    bf16_t* O; int ldc;
    DI void hook(Acc&, const Unit&, int, int, int, int, int) const {}
    DI void operator()(const Acc& acc, const Unit& u, int wr, int wc, int fr, int fq) const {
#pragma unroll
        for (int ai = 0; ai < 2; ++ai)
#pragma unroll
            for (int m = 0; m < 4; ++m) {
                bf16_t* rowp = O + (size_t)(u.pm * 256 + ai * 128 + wr * 64 + m * 16 + fr) * ldc + u.pn * 256 + wc * 32 + 8 * fq;
#pragma unroll
                for (int bj = 0; bj < 2; ++bj) {
                    f32x4 v0 = acc[ai][bj][m][0], v1 = acc[ai][bj][m][1];
                    if (ACT == 1) {
#pragma unroll
                        for (int j = 0; j < 4; ++j) { v0[j] = sigmoidf_(v0[j]); v1[j] = sigmoidf_(v1[j]); }
                    } else if (ACT == 2) {
#pragma unroll
                        for (int j = 0; j < 4; ++j) { float a = fmaxf(v0[j], 0.f), b = fmaxf(v1[j], 0.f); v0[j] = a * a; v1[j] = b * b; }
                    }
                    *(u32x4*)(rowp + bj * 128) = (u32x4){pk2(v0[0], v0[1]), pk2(v0[2], v0[3]), pk2(v1[0], v1[1]), pk2(v1[2], v1[3])};
                }
            }
    }
};

struct EpiGate {
    static constexpr bool PERM = true, HOOK = false;
    bf16_t* G;
    DI void hook(Acc&, const Unit&, int, int, int, int, int) const {}
    DI void operator()(const Acc& acc, const Unit& u, int wr, int wc, int fr, int fq) const {
#pragma unroll
        for (int ai = 0; ai < 2; ++ai)
#pragma unroll
            for (int m = 0; m < 4; ++m) {
                bf16_t* rowp = G + (size_t)(u.pm * 256 + ai * 128 + wr * 64 + m * 16 + fr) * 4096 + u.pn * 64 + 16 * wc + 4 * fq;
                float r0[4], r1[4], r2[4], g3[4];
#pragma unroll
                for (int j = 0; j < 4; ++j) {
                    const float d0 = 1.0f + __builtin_amdgcn_exp2f(-1.44269504f * acc[ai][0][m][0][j]), d1 = 1.0f + __builtin_amdgcn_exp2f(-1.44269504f * acc[ai][0][m][1][j]);
                    const float d2 = 1.0f + __builtin_amdgcn_exp2f(-1.44269504f * acc[ai][1][m][0][j]), d3 = 1.0f + __builtin_amdgcn_exp2f(-1.44269504f * acc[ai][1][m][1][j]);
                    r0[j] = d1 * __builtin_amdgcn_rcpf(d0); r1[j] = d2 * __builtin_amdgcn_rcpf(d1); r2[j] = d3 * __builtin_amdgcn_rcpf(d2); g3[j] = __builtin_amdgcn_rcpf(d3);
                }
                *(u32x2*)(rowp) = (u32x2){pk2(r0[0], r0[1]), pk2(r0[2], r0[3])};
                *(u32x2*)(rowp + 1024) = (u32x2){pk2(r1[0], r1[1]), pk2(r1[2], r1[3])};
                *(u32x2*)(rowp + 2048) = (u32x2){pk2(r2[0], r2[1]), pk2(r2[2], r2[3])};
                *(u32x2*)(rowp + 3072) = (u32x2){pk2(g3[0], g3[1]), pk2(g3[2], g3[3])};
            }
    }
};

struct EpiBranch {
    static constexpr bool PERM = true, HOOK = true;
    const bf16_t* G; bf16_t* O;
    DI void hook(Acc& acc, const Unit& u, int t, int wr, int wc, int fr_, int fq) const {
        int fr = fr_; asm volatile("" : "+v"(fr));
        const int s = (t == 6) ? 0 : (t == 14 ? 1 : 2);
#pragma unroll
        for (int ai = 0; ai < 2; ++ai) {
            u32x4 ga[4][2];
#pragma unroll
            for (int m = 0; m < 4; ++m) {
                const bf16_t* gp = G + (size_t)(u.pm * 256 + ai * 128 + wr * 64 + m * 16 + fr) * 4096 + s * 1024 + u.pn * 256 + wc * 32 + 8 * fq;
#pragma unroll
                for (int bj = 0; bj < 2; ++bj) ga[m][bj] = *(const u32x4*)(gp + bj * 128);
            }
#pragma unroll
            for (int m = 0; m < 4; ++m)
#pragma unroll
                for (int bj = 0; bj < 2; ++bj)
#pragma unroll
                    for (int q = 0; q < 4; ++q) { acc[ai][bj][m][q >> 1][(q & 1) * 2] *= bflo(ga[m][bj][q]); acc[ai][bj][m][q >> 1][(q & 1) * 2 + 1] *= bfhi(ga[m][bj][q]); }
            asm volatile("" ::: "memory");
        }
    }
    DI void operator()(const Acc& acc, const Unit& u, int wr, int wc, int fr, int fq) const {
#pragma unroll
        for (int ai = 0; ai < 2; ++ai) {
            u32x4 g[4][2];
#pragma unroll
            for (int m = 0; m < 4; ++m)
#pragma unroll
                for (int bj = 0; bj < 2; ++bj) g[m][bj] = *(const u32x4*)(G + (size_t)(u.pm * 256 + ai * 128 + wr * 64 + m * 16 + fr) * 4096 + 3072 + u.pn * 256 + wc * 32 + 8 * fq + bj * 128);
#pragma unroll
            for (int m = 0; m < 4; ++m) {
                const size_t row = (size_t)(u.pm * 256 + ai * 128 + wr * 64 + m * 16 + fr);
                const int c = u.pn * 256 + wc * 32 + 8 * fq;
#pragma unroll
                for (int bj = 0; bj < 2; ++bj) {
                    const u32x4 gg = g[m][bj];
                    const f32x4 v0 = acc[ai][bj][m][0], v1 = acc[ai][bj][m][1];
                    *(u32x4*)(O + row * 1024 + c + bj * 128) = (u32x4){pk2(v0[0] * bflo(gg[0]), v0[1] * bfhi(gg[0])), pk2(v0[2] * bflo(gg[1]), v0[3] * bfhi(gg[1])),
                                                                      pk2(v1[0] * bflo(gg[2]), v1[1] * bfhi(gg[2])), pk2(v1[2] * bflo(gg[3]), v1[3] * bfhi(gg[3]))};
                }
            }
            asm volatile("" ::: "memory");
        }
    }
};

struct EpiFourier {
    static constexpr bool PERM = true, HOOK = false;
    bf16_t* BRQ; int row0, seqlen; float scale;
    DI void hook(Acc&, const Unit&, int, int, int, int, int) const {}
    DI void operator()(const Acc& acc, const Unit& u, int wr, int wc, int fr, int fq) const {
#pragma unroll
        for (int ai = 0; ai < 2; ++ai)
#pragma unroll
            for (int m = 0; m < 4; ++m) {
                const int pos = u.pm * 256 + ai * 128 + wr * 64 + m * 16 + fr;
#pragma unroll
                for (int bj = 0; bj < 2; ++bj) {
                    const int c = u.pn * 256 + bj * 128 + wc * 32 + 8 * fq; const int b = c / 384, ch = c - b * 384;
                    const f32x4 v0 = acc[ai][bj][m][0] * scale, v1 = acc[ai][bj][m][1] * scale;
                    *(u32x4*)(BRQ + (size_t)(row0 + b * seqlen + pos) * KBR + ch) = (u32x4){pk2(v0[0], v0[1]), pk2(v0[2], v0[3]), pk2(v1[0], v1[1]), pk2(v1[2], v1[3])};
                }
            }
    }
};

struct MapId { int off; DI int operator()(int n) const { return n + off; } };
struct MapWin {
    DI static int rp(int lc) { return 16 * ((lc >> 2) & 1) + 4 * (lc >> 3) + (lc & 3); }
    DI int operator()(int n) const {
        if (n < 512) return (n & ~31) + rp(n & 31);
        if (n < 1024) return n;
        if (n < 1280) { const int i = n - 1024, bj = i >> 7, wc = (i >> 5) & 3, lc = i & 31; return wc < 2 ? 1024 + wc * 64 + 32 * bj + rp(lc) : 1152 + (wc - 2) * 64 + 32 * bj + lc; }
        if (n < 1792) { const int i = n - 1280; return 1664 + (i & ~31) + rp(i & 31); }
        if (n < 2304) { const int i = n - 1792, tile = i >> 8, ii = i & 255, bj = ii >> 7, wc = (ii >> 5) & 3, lc = ii & 31; return 2176 + (tile * 4 + wc) * 64 + 32 * bj + rp(lc); }
        if (n < 3072) return -1;
        if (n < 3840) { const int i = n - 3072, grp = i >> 5, lc = i & 31, ch = grp * 16 + 4 * (lc >> 3) + (lc & 3); return ((lc >> 2) & 1) ? 3072 + ch : 2688 + ch; }
        { const int i = n - 3840, t = i >> 8, c = i & 255, bj = c >> 7, wc = (c >> 5) & 3, lc = c & 31;
          return 3456 + (2 * bj + ((lc >> 2) & 1)) * 1024 + 64 * t + 16 * wc + 4 * (lc >> 3) + (lc & 3); }
    }
};
template <class Map>
DI void convT(LAS unsigned char* lds, const float* src, int sld, int K, bf16_t* dst, int dld, int N, const Map& map, int item0, int nblk) {
    LAS float* tile = (LAS float*)lds;
    const int tid = tid_(); const int tK = K / 128, tN = N / 64;
    for (int it = item0; it < tK * tN; it += nblk) {
        const int tn = it / tK, tk = it % tK;
        const int col = map(tn * 64 + (tid & 63));
        if (map(tn * 64) < 0) continue;
        float v[16];
#pragma unroll
        for (int p = 0; p < 16; ++p) v[p] = src[(size_t)(tk * 128 + p * 8 + (tid >> 6)) * sld + col];
#pragma unroll
        for (int p = 0; p < 16; ++p) tile[(p * 8 + (tid >> 6)) * 65 + (tid & 63)] = v[p];
        __syncthreads();
#pragma unroll
        for (int hh = 0; hh < 2; ++hh) { const int n = tid >> 3, kc = (tid & 7) + 8 * hh; float w[8];
#pragma unroll
          for (int e = 0; e < 8; ++e) w[e] = tile[(kc * 8 + e) * 65 + n];
          *(u32x4*)(dst + (size_t)(tn * 64 + n) * dld + tk * 128 + kc * 8) = (u32x4){pk2(w[0], w[1]), pk2(w[2], w[3]), pk2(w[4], w[5]), pk2(w[6], w[7])}; }
        __syncthreads();
    }
}
DI void conv_fold(LAS unsigned char* lds, const float* win, bf16_t* wint, int item0, int nblk) {
    LAS float* tile = (LAS float*)lds;
    LAS float* tab = (LAS float*)(lds + 64 * 65 * 4);
    LAS bf16_t* outb = (LAS bf16_t*)(lds + 64 * 65 * 4 + 256);
    const int tid = tid_();
    __syncthreads();
    if (tid < 64) tab[tid] = cospif((float)tid / 32.0f);
    for (int it = item0; it < 6 * 16; it += nblk) {
        const int g = it >> 4, tk = it & 15;
        __syncthreads();
#pragma unroll
        for (int p = 0; p < 8; ++p) { const int kk = p * 8 + (tid >> 6); tile[kk * 65 + (tid & 63)] = win[(size_t)(tk * 64 + kk) * IN_COLS + 1280 + g * 64 + (tid & 63)]; }
        __syncthreads();
        const int k = tid & 63, cq = tid >> 6;
        float ac[8], as[8];
#pragma unroll
        for (int e = 0; e < 8; ++e) { ac[e] = 0.f; as[e] = 0.f; }
        for (int c = 0; c < 64; ++c) {
            const float w = tile[k * 65 + c];
#pragma unroll
            for (int e = 0; e < 8; ++e) { const int idx = c * (cq * 8 + e); ac[e] += w * tab[idx & 63]; as[e] += w * tab[(idx - 16) & 63]; }
        }
#pragma unroll
        for (int e = 0; e < 8; ++e) { outb[(cq * 8 + e) * 72 + k] = (bf16_t)(pk2(ac[e], 0.f) & 0xffffu); outb[(64 + cq * 8 + e) * 72 + k] = (bf16_t)(pk2(as[e], 0.f) & 0xffffu); }
        __syncthreads();
        for (int i = tid; i < 128 * 8; i += NTHREADS) { const int rr = i >> 3, ch = i & 7; const int part = rr >> 6, cp = rr & 63;
            *(u32x4*)(wint + (size_t)(2304 + part * 384 + g * 64 + cp) * D + tk * 64 + ch * 8) = *(const LAS u32x4*)(outb + rr * 72 + ch * 8); }
    }
    __syncthreads();
}
DI void conv_win(LAS unsigned char* lds, const Ptrs& P, int l, int item0, int nblk) {
    const float* win = P.in[I_WIN] + (size_t)l * D * IN_COLS;
    convT(lds, win, IN_COLS, D, (bf16_t*)(P.ws + OFF_WINT), D, NIN, MapWin{}, item0, nblk);
    conv_fold(lds, win, (bf16_t*)(P.ws + OFF_WINT), item0, nblk);
}
DI void gen_dft(LAS unsigned char* lds, unsigned char* ws, int item0, int nblk, bool also_small) {
    const int tid = tid_();
    bf16_t* dft = (bf16_t*)(ws + A_DFT);
    for (int it = item0 * NTHREADS + tid; it < 4096 * 512; it += nblk * NTHREADS) {
        const int k = it >> 9, j0 = (it & 511) * 8;
        float v[8];
#pragma unroll
        for (int e = 0; e < 8; ++e) { const int j = j0 + e; const bool sp = j >= 2049; const float fr = (float)((k * (sp ? j - 2048 : j)) & 4095) * (1.0f / 4096.0f); v[e] = sp ? -__builtin_amdgcn_sinf(fr) : __builtin_amdgcn_cosf(fr); }
        *(u32x4*)(dft + (size_t)k * 4096 + j0) = (u32x4){pk2(v[0], v[1]), pk2(v[2], v[3]), pk2(v[4], v[5]), pk2(v[6], v[7])};
    }
    if (also_small) {
        bf16_t* dc = (bf16_t*)(ws + OFF_DFTC);
        for (int it = item0 * NTHREADS + tid; it < 256 * 64; it += nblk * NTHREADS) {
            const int k = it >> 6, j0 = (it & 63) * 8; const int part = j0 >= 256; const int t0 = j0 & 255;
            float v[8];
#pragma unroll
            for (int e = 0; e < 8; ++e) { const float fr = (float)((k * (t0 + e)) & 255) * (1.0f / 256.0f); v[e] = part ? -__builtin_amdgcn_sinf(fr) : __builtin_amdgcn_cosf(fr); }
            *(u32x4*)(dc + (size_t)k * 512 + j0) = (u32x4){pk2(v[0], v[1]), pk2(v[2], v[3]), pk2(v[4], v[5]), pk2(v[6], v[7])};
        }
    }
}
DI void fourier_fold(unsigned char* ws, int item0, int nblk) {
    const int tid = tid_();
    const bf16_t* FT = (const bf16_t*)(ws + A_FT); bf16_t* FTF = (bf16_t*)(ws + A_FTF);
    for (int it = item0 * NTHREADS + tid; it < 1536 * 1024; it += nblk * NTHREADS) {
        const int n = it >> 10, j0 = (it & 1023) * 4;
        const bf16_t* s = FT + (size_t)n * 8192;
        float o[4];
#pragma unroll
        for (int e = 0; e < 4; ++e) { const int j = j0 + e;
            if (j <= 2048) { const float a = bflo((unsigned)s[j]); o[e] = (j == 0 || j == 2048) ? a : a + bflo((unsigned)s[4096 - j]); }
            else { const int t = j - 2048; o[e] = bflo((unsigned)s[4096 + t]) - bflo((unsigned)s[8192 - t]); } }
        *(u32x2*)(FTF + (size_t)n * 4096 + j0) = (u32x2){pk2(o[0], o[1]), pk2(o[2], o[3])};
    }
}

DI void mod_gemv(LAS unsigned char* lds, const Ptrs& P, int item0, int nblk) {
    LAS float* sc = (LAS float*)lds;
    LAS float* red = (LAS float*)(lds + 20480);
    const int tid = tid_();
    __syncthreads();
    for (int i = tid; i < 5 * 1024; i += NTHREADS) { const float v = i < 4096 ? P.in[I_C][i] : P.in[I_CCTX][i - 4096]; sc[i] = v * sigmoidf_(v); }
    __syncthreads();
    float* MOD = (float*)(P.ws + OFF_MOD);
    for (int it = item0; it < 2 * 192; it += nblk) {
        const int l = it / 192, cg32 = it % 192; const int kg = tid >> 5, cl = tid & 31;
        const float* w = P.in[I_WMOD] + (size_t)l * D * 6144 + cg32 * 32 + cl;
        float a[5] = {0.f, 0.f, 0.f, 0.f, 0.f};
        for (int k = kg * 64; k < kg * 64 + 64; ++k) { const float wv = w[(size_t)k * 6144];
#pragma unroll
            for (int r = 0; r < 5; ++r) a[r] += sc[r * 1024 + k] * wv; }
#pragma unroll
        for (int r = 0; r < 5; ++r) red[(kg * 5 + r) * 32 + cl] = a[r];
        __syncthreads();
        if (tid < 160) { const int r = tid >> 5; float s = 0.f;
#pragma unroll
            for (int g = 0; g < 16; ++g) s += red[(g * 5 + r) * 32 + cl];
            MOD[((size_t)l * 5 + r) * 6144 + cg32 * 32 + cl] = s + P.in[I_BMOD][l * 6144 + cg32 * 32 + cl]; }
        __syncthreads();
    }
}

DI void row_mod_store(const f32x4 (&x)[4], float rstd, const float* gain, const float* shift, const float* scale, bf16_t* hrow, int lane) {
#pragma unroll
    for (int i = 0; i < 4; ++i) { const int c = lane * 4 + 256 * i;
        const f32x4 g = *(const f32x4*)(gain + c), sh = *(const f32x4*)(shift + c), sc = *(const f32x4*)(scale + c);
        float o[4];
#pragma unroll
        for (int j = 0; j < 4; ++j) o[j] = x[i][j] * rstd * g[j] * (1.f + sc[j]) + sh[j];
        *(u32x2*)(hrow + c) = (u32x2){pk2(o[0], o[1]), pk2(o[2], o[3])}; }
}
DI float row_rstd(const f32x4 (&x)[4]) {
    float s = 0.f;
#pragma unroll
    for (int i = 0; i < 4; ++i) s += x[i][0] * x[i][0] + x[i][1] * x[i][1] + x[i][2] * x[i][2] + x[i][3] * x[i][3];
    s = wave_sum(s);
    return __builtin_amdgcn_rsqf(s * (1.0f / 1024.0f) + EPS);
}
DI void rows_first(const Ptrs& P) {
    const int tid = tid_(); const int lane = tid & 63, wv = tid >> 6;
    const float* MOD = (const float*)(P.ws + OFF_MOD);
    for (int row = blockIdx.x * 8 + wv; row < MTOT; row += gridDim.x * 8) {
        const float* xr = row < MLAT ? P.in[I_X] + (size_t)row * D : P.in[I_CTX] + (size_t)(row - MLAT) * D;
        const int mr = row < MLAT ? (row >> 12) : 4;
        f32x4 x[4];
#pragma unroll
        for (int i = 0; i < 4; ++i) x[i] = *(const f32x4*)(xr + lane * 4 + 256 * i);
        const float rstd = row_rstd(x);
        const float* mod = MOD + (size_t)mr * 6144;
        row_mod_store(x, rstd, P.in[I_GPREMIX], mod, mod + 1024, (bf16_t*)(P.ws + OFF_HS) + (size_t)row * D, lane);
    }
}
DI void rows_update(const Ptrs& P, int l, int which  , int nrows) {
    const int tid = tid_(); const int lane = tid & 63, wv = tid >> 6;
    const float* MOD = (const float*)(P.ws + OFF_MOD);
    const bf16_t* Y = (const bf16_t*)(P.ws + A_MIXO);
    const float* gpost = P.in[which ? I_GPOSTMLP : I_GPOSTMIX] + l * D;
    const bool do_h = (which == 0) || (l == 0);
    const int ln = which ? l + 1 : l;
    const float* gnext = which ? P.in[I_GPREMIX] + (do_h ? ln : 0) * D : P.in[I_GPREMLP] + l * D;
    for (int row = blockIdx.x * 8 + wv; row < nrows; row += gridDim.x * 8) {
        const bool lat = row < MLAT;
        const float* xin = lat ? ((l == 0 && which == 0) ? P.in[I_X] + (size_t)row * D : P.out + (size_t)row * D)
                               : ((which == 0) ? P.in[I_CTX] + (size_t)(row - MLAT) * D : (const float*)(P.ws + A_XC) + (size_t)(row - MLAT) * D);
        float* xout = lat ? P.out + (size_t)row * D : (float*)(P.ws + A_XC) + (size_t)(row - MLAT) * D;
        const int mr = lat ? (row >> 12) : 4;
        const float* mod = MOD + ((size_t)l * 5 + mr) * 6144;
        const float* gate = mod + (which ? 5 : 2) * 1024;
        f32x4 x[4], y[4];
#pragma unroll
        for (int i = 0; i < 4; ++i) { x[i] = *(const f32x4*)(xin + lane * 4 + 256 * i);
            const u32x2 yb = *(const u32x2*)(Y + (size_t)row * D + lane * 4 + 256 * i); y[i] = (f32x4){bflo(yb[0]), bfhi(yb[0]), bflo(yb[1]), bfhi(yb[1])}; }
        const float ry = row_rstd(y);
#pragma unroll
        for (int i = 0; i < 4; ++i) { const int c = lane * 4 + 256 * i; const f32x4 gp = *(const f32x4*)(gpost + c), gt = *(const f32x4*)(gate + c);
#pragma unroll
            for (int j = 0; j < 4; ++j) x[i][j] += gt[j] * (y[i][j] * ry * gp[j]);
            *(f32x4*)(xout + c) = x[i]; }
        if (do_h) {
            const float rx = row_rstd(x);
            const float* modn = MOD + ((size_t)ln * 5 + mr) * 6144;
            const float* shiftn = which ? modn : modn + 3 * 1024; const float* scalen = which ? modn + 1024 : modn + 4 * 1024;
            row_mod_store(x, rx, gnext, shiftn, scalen, (bf16_t*)(P.ws + OFF_HS) + (size_t)row * D, lane);
        }
    }
}

constexpr int AK_PITCH = 144;
constexpr int AK_BUF = 64 * AK_PITCH;
constexpr int AV_OFF = 2 * AK_BUF;
#define ATT_BAR() do { __builtin_amdgcn_sched_barrier(0); asm volatile("s_waitcnt lgkmcnt(0)" ::: "memory"); __builtin_amdgcn_s_barrier(); asm volatile("" ::: "memory"); __builtin_amdgcn_sched_barrier(0); } while (0)
DI float max3_(float a, float b, float c) { float d; asm("v_max3_f32 %0, %1, %2, %3" : "=v"(d) : "v"(a), "v"(b), "v"(c)); return d; }
template <int NMB, bool NOMAX = false>
DI void flash_pass(LAS unsigned char* lds, const bf16x8 (&qf)[4], const bf16_t* Kg, int ldk, const bf16_t* Vg, int ldv, int ntiles, f32x16 (&O)[NMB], float& lsum) {
    constexpr int VP = NMB == 4 ? 320 : 192;
    constexpr int VBUF = 64 * VP;
    constexpr int VCH = NMB * 4;
    constexpr int VPT = NMB / 2;
    const int tid = tid_(), lane = tid & 63, g = __builtin_amdgcn_readfirstlane(tid >> 8);
    const int r = lane & 31, h = lane >> 5, i16 = lane & 15, q4 = i16 >> 2, p4 = i16 & 3, blk = (lane >> 4) & 1;
    const int kkey = tid >> 3, kch = tid & 7;
    const unsigned kwoff = kkey * AK_PITCH + kch * 16;
    const unsigned vrd = (4 * h + q4) * VP + 32 * blk + 8 * p4;
    const unsigned krd = r * AK_PITCH + 16 * h;
    const bf16_t* kgp = Kg + (size_t)kkey * ldk + kch * 8;
    const unsigned vwoff0 = (tid / VCH) * VP + (tid % VCH) * 16; const bf16_t* vgp0 = Vg + (size_t)(tid / VCH) * ldv + (tid % VCH) * 8;
    constexpr int VKS = NTHREADS / VCH;
#define vwoff_(p) (vwoff0 + (p) * VKS * VP)
#define vgp_(p) (vgp0 + (size_t)(p) * VKS * ldv)
    float m_run = -1e30f; lsum = 0.f;
#pragma unroll
    for (int mb = 0; mb < NMB; ++mb)
#pragma unroll
        for (int i = 0; i < 16; ++i) O[mb][i] = 0.f;
    u32x4 kreg, vreg[VPT];
    {
        const u32x4 k0 = *(const u32x4*)kgp, k1 = *(const u32x4*)(kgp + (size_t)64 * ldk);
#pragma unroll
        for (int p = 0; p < VPT; ++p) vreg[p] = *(const u32x4*)vgp_(p);
        __syncthreads();
        *(LAS u32x4*)(lds + kwoff) = k0; *(LAS u32x4*)(lds + AK_BUF + kwoff) = k1;
#pragma unroll
        for (int p = 0; p < VPT; ++p) *(LAS u32x4*)(lds + AV_OFF + vwoff_(p)) = vreg[p];
    }
    __syncthreads();
    kreg = *(const u32x4*)(kgp + (size_t)(ntiles > 2 ? 128 : 0) * ldk);
#pragma unroll
    for (int p = 0; p < VPT; ++p) vreg[p] = *(const u32x4*)(vgp_(p) + (size_t)64 * ldv);
    f32x16 S0, S1;
#pragma unroll
    for (int i = 0; i < 16; ++i) { S0[i] = 0.f; S1[i] = 0.f; }
#pragma unroll
    for (int c = 0; c < 4; ++c) {
        const bf16x8 a0 = *(const LAS bf16x8*)(lds + krd + 32 * c);
        const bf16x8 a1 = *(const LAS bf16x8*)(lds + krd + 32 * AK_PITCH + 32 * c);
        S0 = __builtin_amdgcn_mfma_f32_32x32x16_bf16(a0, qf[c], S0, 0, 0, 0);
        S1 = __builtin_amdgcn_mfma_f32_32x32x16_bf16(a1, qf[c], S1, 0, 0, 0);
    }
    if (g == 1) ATT_BAR();
    for (int t = 0; t < ntiles; ++t) {
        const int sv = t + g;
        if (sv >= 1) {
            if (sv < ntiles) {
#pragma unroll
                for (int p = 0; p < VPT; ++p) *(LAS u32x4*)(lds + AV_OFF + (sv & 1) * VBUF + vwoff_(p)) = vreg[p]; }
            if (sv + 1 < ntiles) *(LAS u32x4*)(lds + ((sv + 1) & 1) * AK_BUF + kwoff) = kreg;
        }
        if (sv + 1 < ntiles) {
#pragma unroll
            for (int p = 0; p < VPT; ++p) vreg[p] = *(const u32x4*)(vgp_(p) + (size_t)(sv + 1) * 64 * ldv); }
        if (sv + 2 < ntiles) kreg = *(const u32x4*)(kgp + (size_t)(sv + 2) * 64 * ldk);
        if constexpr (!NOMAX) {
        float mx = max3_(S0[0], S1[0], S0[1]), mx2 = max3_(S1[1], S0[2], S1[2]);
#pragma unroll
        for (int i = 3; i < 15; i += 2) { mx = max3_(mx, S0[i], S1[i]); mx2 = max3_(mx2, S0[i + 1], S1[i + 1]); }
        mx = max3_(mx, S0[15], S1[15]);
        mx = max3_(mx, mx2, mx2);
        { const u32x2 sw = __builtin_amdgcn_permlane32_swap(__float_as_uint(mx), __float_as_uint(mx), false, false);
          mx = max3_(__uint_as_float(sw[0]), __uint_as_float(sw[1]), m_run); }
        const float m_new = mx;
        if (__builtin_amdgcn_ballot_w64(m_new > m_run) != 0ull) {
            const float alpha = __builtin_amdgcn_exp2f(m_run - m_new);
            lsum *= alpha;
#pragma unroll
            for (int mb = 0; mb < NMB; ++mb)
#pragma unroll
                for (int i = 0; i < 16; ++i) O[mb][i] *= alpha;
            m_run = m_new;
        }
        }
#pragma unroll
        for (int i = 0; i < 16; ++i) { if constexpr (NOMAX) { S0[i] = __builtin_amdgcn_exp2f(S0[i]); S1[i] = __builtin_amdgcn_exp2f(S1[i]); } else { S0[i] = __builtin_amdgcn_exp2f(S0[i] - m_run); S1[i] = __builtin_amdgcn_exp2f(S1[i] - m_run); } }
        f32x2 ps2 = (f32x2){0.f, 0.f};
#pragma unroll
        for (int i = 0; i < 8; ++i) { ps2 += (f32x2){S0[2 * i], S0[2 * i + 1]}; ps2 += (f32x2){S1[2 * i], S1[2 * i + 1]}; }
        lsum += ps2.x + ps2.y;
        bf16x8 pf[4];
#pragma unroll
        for (int cp = 0; cp < 2; ++cp) {
            u32x4 w0, w1;
#pragma unroll
            for (int q = 0; q < 4; ++q) { w0[q] = pk2(S0[8 * cp + 2 * q], S0[8 * cp + 2 * q + 1]); w1[q] = pk2(S1[8 * cp + 2 * q], S1[8 * cp + 2 * q + 1]); }
            pf[cp] = __builtin_bit_cast(bf16x8, w0); pf[2 + cp] = __builtin_bit_cast(bf16x8, w1);
        }
        ATT_BAR();
        {
            const LAS unsigned char* Vb = lds + AV_OFF + (t & 1) * VBUF + vrd;
            const LAS unsigned char* Kb = lds + ((t + 1) & 1) * AK_BUF + krd;
            const bool qk = t + 1 < ntiles;
            bf16x8 kf[8], va[NMB], vb[NMB];
#define ATT_LDV(dst, kc) do { _Pragma("unroll") for (int mb = 0; mb < NMB; ++mb) { \
                const s16x4 lo_ = __builtin_amdgcn_ds_read_tr16_b64_v4i16((LAS s16x4*)(Vb + (16 * (kc)) * VP + 64 * mb)); \
                const s16x4 hi_ = __builtin_amdgcn_ds_read_tr16_b64_v4i16((LAS s16x4*)(Vb + (16 * (kc) + 8) * VP + 64 * mb)); \
                dst[mb] = __builtin_shufflevector(lo_, hi_, 0, 1, 2, 3, 4, 5, 6, 7); } } while (0)
#define ATT_PV(srcv, kc) do { _Pragma("unroll") for (int mb = 0; mb < NMB; ++mb) O[mb] = __builtin_amdgcn_mfma_f32_32x32x16_bf16(srcv[mb], pf[kc], O[mb], 0, 0, 0); } while (0)
            if (qk) {
#pragma unroll
                for (int c = 0; c < 4; ++c) { kf[2 * c] = *(const LAS bf16x8*)(Kb + 32 * c); kf[2 * c + 1] = *(const LAS bf16x8*)(Kb + 32 * AK_PITCH + 32 * c); }
            }
            ATT_LDV(va, 0);
            __builtin_amdgcn_sched_barrier(0);
            if (qk) {
#pragma unroll
                for (int i = 0; i < 16; ++i) { S0[i] = 0.f; S1[i] = 0.f; }
#pragma unroll
                for (int c = 0; c < 4; ++c) {
                    S0 = __builtin_amdgcn_mfma_f32_32x32x16_bf16(kf[2 * c], qf[c], S0, 0, 0, 0);
                    S1 = __builtin_amdgcn_mfma_f32_32x32x16_bf16(kf[2 * c + 1], qf[c], S1, 0, 0, 0);
                }
            }
            ATT_LDV(vb, 1);
            __builtin_amdgcn_sched_barrier(0);
            ATT_PV(va, 0);
            ATT_LDV(va, 2);
            __builtin_amdgcn_sched_barrier(0);
            ATT_PV(vb, 1);
            ATT_LDV(vb, 3);
            __builtin_amdgcn_sched_barrier(0);
            ATT_PV(va, 2);
            ATT_PV(vb, 3);
#undef ATT_LDV
#undef ATT_PV
        }
        ATT_BAR();
    }
    if (g == 0) ATT_BAR();
    lsum = add_x32(lsum);
}
#undef vwoff_
#undef vgp_

DI void diff_unit(LAS unsigned char* lds, const Ptrs& P, int l, int b, int hd, int qrow0, int key0, int ntiles, float lam, float lam_init) {
    const int tid = tid_(); const int lane = tid & 63, wv = tid >> 6, r = lane & 31, h = lane >> 5;
    bf16_t* BRQ = (bf16_t*)(P.ws + A_BRQ);
    const bf16_t* DK = (const bf16_t*)(P.ws + A_DK) + (size_t)(b * LKV + key0) * 512 + hd * 128;
    const bf16_t* DV = (const bf16_t*)(P.ws + A_DV) + (size_t)(b * LKV + key0) * 512 + hd * 128;
    bf16_t* qp = BRQ + (size_t)(qrow0 + wv * 32 + r) * KBR + 384 + hd * 128;
    bf16x8 q0[4], q1[4];
#pragma unroll
    for (int c = 0; c < 4; ++c) { q0[c] = *(const bf16x8*)(qp + 16 * c + 8 * h); q1[c] = *(const bf16x8*)(qp + 64 + 16 * c + 8 * h); }
    f32x16 O[4]; float l0;
    const unsigned* nrm = (const unsigned*)(P.ws + OFF_CTL) + 32 + 2 * l;
    const float bnd = 2.04f * sqrtf(__uint_as_float(__hip_atomic_load(nrm, __ATOMIC_RELAXED, __HIP_MEMORY_SCOPE_AGENT)) * __uint_as_float(__hip_atomic_load(nrm + 1, __ATOMIC_RELAXED, __HIP_MEMORY_SCOPE_AGENT)));
    const bool small = __builtin_amdgcn_readfirstlane((int)(bnd < 60.0f)) != 0;
    if (small) flash_pass<4, true>(lds, q0, DK, 512, DV, 512, ntiles, O, l0); else
    flash_pass<4>(lds, q0, DK, 512, DV, 512, ntiles, O, l0);
    { const float inv = 1.0f / l0;
#pragma unroll
      for (int mb = 0; mb < 4; ++mb)
#pragma unroll
          for (int g = 0; g < 4; ++g) { const int dv = 32 * mb + 8 * g + 4 * h;
              *(u32x2*)(qp + dv) = (u32x2){pk2(O[mb][4 * g] * inv, O[mb][4 * g + 1] * inv), pk2(O[mb][4 * g + 2] * inv, O[mb][4 * g + 3] * inv)}; } }
    if (small) flash_pass<4, true>(lds, q1, DK + 64, 512, DV, 512, ntiles, O, l0); else
    flash_pass<4>(lds, q1, DK + 64, 512, DV, 512, ntiles, O, l0);
    { const float s1 = lam / l0; float ss = 0.f;
#pragma unroll
      for (int mb = 0; mb < 4; ++mb)
#pragma unroll
          for (int g = 0; g < 4; ++g) { const int dv = 32 * mb + 8 * g + 4 * h; const u32x2 o0 = *(const u32x2*)(qp + dv);
              const float a0 = bflo(o0[0]) - s1 * O[mb][4 * g], a1 = bfhi(o0[0]) - s1 * O[mb][4 * g + 1], a2 = bflo(o0[1]) - s1 * O[mb][4 * g + 2], a3 = bfhi(o0[1]) - s1 * O[mb][4 * g + 3];
              O[mb][4 * g] = a0; O[mb][4 * g + 1] = a1; O[mb][4 * g + 2] = a2; O[mb][4 * g + 3] = a3; ss += a0 * a0 + a1 * a1 + a2 * a2 + a3 * a3; }
      ss = add_x32(ss);
      const float rs = __builtin_amdgcn_rsqf(ss * (1.0f / 128.0f) + EPS) * (1.0f - lam_init);
      const float* sg = P.in[I_SUBLN] + l * 128;
#pragma unroll
      for (int mb = 0; mb < 4; ++mb)
#pragma unroll
          for (int g = 0; g < 4; ++g) { const int dv = 32 * mb + 8 * g + 4 * h; const f32x4 gg = *(const f32x4*)(sg + dv);
              *(u32x2*)(qp + dv) = (u32x2){pk2(O[mb][4 * g] * rs * gg[0], O[mb][4 * g + 1] * rs * gg[1]), pk2(O[mb][4 * g + 2] * rs * gg[2], O[mb][4 * g + 3] * rs * gg[3])}; }
    }
}
DI void gqa_unit(LAS unsigned char* lds, const Ptrs& P, int l, int b, int qh, int qrow0, int key0, int ntiles) {
    const int tid = tid_(); const int lane = tid & 63, wv = tid >> 6, r = lane & 31, h = lane >> 5;
    bf16_t* BRQ = (bf16_t*)(P.ws + A_BRQ);
    const int kvh = qh >> 2;
    const bf16_t* GK = (const bf16_t*)(P.ws + A_GK) + (size_t)(b * LKV + key0) * 128 + kvh * 64;
    const bf16_t* GV = (const bf16_t*)(P.ws + A_GV) + (size_t)(b * LKV + key0) * 128 + kvh * 64;
    bf16_t* qp = BRQ + (size_t)(qrow0 + wv * 32 + r) * KBR + 896 + qh * 64;
    bf16x8 q0[4];
#pragma unroll
    for (int c = 0; c < 4; ++c) q0[c] = *(const bf16x8*)(qp + 16 * c + 8 * h);
    f32x16 O[2]; float l0;
    float mq = fabsf(P.in[I_QNORM][l * 64 + lane]), mk = fabsf(P.in[I_KNORM][l * 64 + lane]);
    mq = wave_max(mq); mk = wave_max(mk);
    const bool small = __builtin_amdgcn_readfirstlane((int)(64.0f * QSCALE * 1.02f * mq * mk < 60.0f)) != 0;
    if (small) flash_pass<2, true>(lds, q0, GK, 128, GV, 128, ntiles, O, l0);
    else flash_pass<2, false>(lds, q0, GK, 128, GV, 128, ntiles, O, l0);
    const float inv = 1.0f / l0;
#pragma unroll
    for (int mb = 0; mb < 2; ++mb)
#pragma unroll
        for (int g = 0; g < 4; ++g) { const int dv = 32 * mb + 8 * g + 4 * h;
            *(u32x2*)(qp + dv) = (u32x2){pk2(O[mb][4 * g] * inv, O[mb][4 * g + 1] * inv), pk2(O[mb][4 * g + 2] * inv, O[mb][4 * g + 3] * inv)}; }
}

DI void gqa_pair_pass(LAS unsigned char* lds, const bf16x8 (&qf)[2][4], const bf16_t* Kg, const bf16_t* Vg, int ntiles, f32x16 (&O)[2][2], float (&lsum)[2]) {
    constexpr int VP = 192, VBUF = 64 * VP;
    const int tid = tid_(), lane = tid & 63;
    const int r = lane & 31, h = lane >> 5, i16 = lane & 15, q4 = i16 >> 2, p4 = i16 & 3, blk = (lane >> 4) & 1;
    const int kkey = tid >> 3, kch = tid & 7;
    const unsigned kwoff = kkey * AK_PITCH + kch * 16, vwoff = kkey * VP + kch * 16;
    const unsigned vrd = (4 * h + q4) * VP + 32 * blk + 8 * p4, krd = r * AK_PITCH + 16 * h;
    const bf16_t* kgp = Kg + (size_t)kkey * 128 + kch * 8; const bf16_t* vgp = Vg + (size_t)kkey * 128 + kch * 8;
#pragma unroll
    for (int hh = 0; hh < 2; ++hh) { lsum[hh] = 0.f;
#pragma unroll
        for (int mb = 0; mb < 2; ++mb)
#pragma unroll
            for (int i = 0; i < 16; ++i) O[hh][mb][i] = 0.f; }
    u32x4 kreg = *(const u32x4*)kgp, vreg = *(const u32x4*)vgp;
    __syncthreads();
    *(LAS u32x4*)(lds + kwoff) = kreg; *(LAS u32x4*)(lds + AV_OFF + vwoff) = vreg;
    kreg = *(const u32x4*)(kgp + (size_t)64 * 128); vreg = *(const u32x4*)(vgp + (size_t)64 * 128);
    __syncthreads();
    for (int t = 0; t < ntiles; ++t) {
        if (t + 1 < ntiles) { *(LAS u32x4*)(lds + ((t + 1) & 1) * AK_BUF + kwoff) = kreg; *(LAS u32x4*)(lds + AV_OFF + ((t + 1) & 1) * VBUF + vwoff) = vreg; }
        if (t + 2 < ntiles) { kreg = *(const u32x4*)(kgp + (size_t)(t + 2) * 64 * 128); vreg = *(const u32x4*)(vgp + (size_t)(t + 2) * 64 * 128); }
        const LAS unsigned char* Kb = lds + (t & 1) * AK_BUF + krd;
        const LAS unsigned char* Vb = lds + AV_OFF + (t & 1) * VBUF + vrd;
        f32x16 S[2][2];
#pragma unroll
        for (int hh = 0; hh < 2; ++hh)
#pragma unroll
            for (int kb = 0; kb < 2; ++kb)
#pragma unroll
                for (int i = 0; i < 16; ++i) S[hh][kb][i] = 0.f;
#pragma unroll
        for (int cg2 = 0; cg2 < 2; ++cg2) {
            bf16x8 kf[4];
#pragma unroll
            for (int cc = 0; cc < 2; ++cc) { const int c = 2 * cg2 + cc; kf[2 * cc] = *(const LAS bf16x8*)(Kb + 32 * c); kf[2 * cc + 1] = *(const LAS bf16x8*)(Kb + 32 * AK_PITCH + 32 * c); }
#pragma unroll
            for (int cc = 0; cc < 2; ++cc)
#pragma unroll
                for (int hh = 0; hh < 2; ++hh) {
                    S[hh][0] = __builtin_amdgcn_mfma_f32_32x32x16_bf16(kf[2 * cc], qf[hh][2 * cg2 + cc], S[hh][0], 0, 0, 0);
                    S[hh][1] = __builtin_amdgcn_mfma_f32_32x32x16_bf16(kf[2 * cc + 1], qf[hh][2 * cg2 + cc], S[hh][1], 0, 0, 0);
                }
            __builtin_amdgcn_sched_barrier(0);
        }
        __builtin_amdgcn_sched_barrier(0);
        bf16x8 pf[2][4];
#pragma unroll
        for (int hh = 0; hh < 2; ++hh) {
#pragma unroll
            for (int i = 0; i < 16; ++i) { S[hh][0][i] = __builtin_amdgcn_exp2f(S[hh][0][i]); S[hh][1][i] = __builtin_amdgcn_exp2f(S[hh][1][i]); }
            f32x2 ps2 = (f32x2){0.f, 0.f};
#pragma unroll
            for (int i = 0; i < 8; ++i) { ps2 += (f32x2){S[hh][0][2 * i], S[hh][0][2 * i + 1]}; ps2 += (f32x2){S[hh][1][2 * i], S[hh][1][2 * i + 1]}; }
            lsum[hh] += ps2.x + ps2.y;
#pragma unroll
            for (int cp = 0; cp < 2; ++cp) {
                u32x4 w0, w1;
#pragma unroll
                for (int q = 0; q < 4; ++q) { w0[q] = pk2(S[hh][0][8 * cp + 2 * q], S[hh][0][8 * cp + 2 * q + 1]); w1[q] = pk2(S[hh][1][8 * cp + 2 * q], S[hh][1][8 * cp + 2 * q + 1]); }
                pf[hh][cp] = __builtin_bit_cast(bf16x8, w0); pf[hh][2 + cp] = __builtin_bit_cast(bf16x8, w1);
            }
        }
        __builtin_amdgcn_sched_barrier(0);
#pragma unroll
        for (int kc = 0; kc < 4; ++kc)
#pragma unroll
            for (int mb = 0; mb < 2; ++mb) {
                const s16x4 lo = __builtin_amdgcn_ds_read_tr16_b64_v4i16((LAS s16x4*)(Vb + (16 * kc) * VP + 64 * mb));
                const s16x4 hi = __builtin_amdgcn_ds_read_tr16_b64_v4i16((LAS s16x4*)(Vb + (16 * kc + 8) * VP + 64 * mb));
                const bf16x8 a = __builtin_shufflevector(lo, hi, 0, 1, 2, 3, 4, 5, 6, 7);
#pragma unroll
                for (int hh = 0; hh < 2; ++hh) O[hh][mb] = __builtin_amdgcn_mfma_f32_32x32x16_bf16(a, pf[hh][kc], O[hh][mb], 0, 0, 0);
            }
        ATT_BAR();
    }
#pragma unroll
    for (int hh = 0; hh < 2; ++hh) lsum[hh] = add_x32(lsum[hh]);
}
DI void gqa_pair_unit(LAS unsigned char* lds, const Ptrs& P, int l, int b, int qh, int qrow0, int key0, int ntiles) {
    const int tid = tid_(); const int lane = tid & 63, wv = tid >> 6, r = lane & 31, h = lane >> 5;
    bf16_t* BRQ = (bf16_t*)(P.ws + A_BRQ);
    const int kvh = qh >> 2;
    const bf16_t* GK = (const bf16_t*)(P.ws + A_GK) + (size_t)(b * LKV + key0) * 128 + kvh * 64;
    const bf16_t* GV = (const bf16_t*)(P.ws + A_GV) + (size_t)(b * LKV + key0) * 128 + kvh * 64;
    bf16_t* qp = BRQ + (size_t)(qrow0 + wv * 32 + r) * KBR + 896 + qh * 64;
    bf16x8 qf[2][4];
#pragma unroll
    for (int hh = 0; hh < 2; ++hh)
#pragma unroll
        for (int c = 0; c < 4; ++c) qf[hh][c] = *(const bf16x8*)(qp + hh * 64 + 16 * c + 8 * h);
    f32x16 O[2][2]; float ls[2];
    gqa_pair_pass(lds, qf, GK, GV, ntiles, O, ls);
#pragma unroll
    for (int hh = 0; hh < 2; ++hh) { const float inv = 1.0f / ls[hh];
#pragma unroll
        for (int mb = 0; mb < 2; ++mb)
#pragma unroll
            for (int g = 0; g < 4; ++g) { const int dv = 32 * mb + 8 * g + 4 * h;
                *(u32x2*)(qp + hh * 64 + dv) = (u32x2){pk2(O[hh][mb][4 * g] * inv, O[hh][mb][4 * g + 1] * inv), pk2(O[hh][mb][4 * g + 2] * inv, O[hh][mb][4 * g + 3] * inv)}; } }
}

DI void conv_unit(LAS unsigned char* lds, const Ptrs& P, int l, int m0, int s0, int Ls) {
    const int tid = tid_(), lane = tid & 63, wv = tid >> 6;
    LAS bf16_t* vs = (LAS bf16_t*)lds;
    LAS float* wsm = (LAS float*)(lds + 94 * 384 * 2);
    const bf16_t* V = (const bf16_t*)(P.ws + A_V);
    __syncthreads();
    for (int idx = tid; idx < 94 * 48; idx += NTHREADS) { const int rr = idx / 48, ch = idx % 48; const int row = m0 - 15 + rr;
        u32x4 v = (u32x4){0u, 0u, 0u, 0u};
        if (row >= s0 && row < s0 + Ls) v = *(const u32x4*)(V + (size_t)row * 384 + ch * 8);
        *(LAS u32x4*)(vs + rr * 384 + ch * 8) = v; }
    const float* dw = P.in[I_CONVDW] + (size_t)l * 31 * 384;
    for (int idx = tid; idx < 31 * 384; idx += NTHREADS) wsm[idx] = dw[idx];
    __syncthreads();
    const float* bias = P.in[I_CONVB] + l * 384; const float* lg = P.in[I_CONVLNG] + l * 384; const float* lb = P.in[I_CONVLNB] + l * 384;
    const int c0 = lane * 6;
    bf16_t* BRQ = (bf16_t*)(P.ws + A_BRQ);
    float a[8][6];
#pragma unroll
    for (int tt = 0; tt < 8; ++tt)
#pragma unroll
        for (int c = 0; c < 6; ++c) a[tt][c] = bias[c0 + c];
    const LAS bf16_t* vbase = vs + (wv * 8) * 384 + c0;
#pragma unroll 1
    for (int j = 0; j < 31; ++j) {
        const LAS float* wp = wsm + j * 384 + c0;
        const f32x2 w01 = *(const LAS f32x2*)wp, w23 = *(const LAS f32x2*)(wp + 2), w45 = *(const LAS f32x2*)(wp + 4);
#pragma unroll
        for (int tt = 0; tt < 8; ++tt) {
            const LAS unsigned* vp = (const LAS unsigned*)(vbase + (tt + j) * 384);
            const unsigned v0 = vp[0], v1 = vp[1], v2 = vp[2];
            a[tt][0] += w01.x * bflo(v0); a[tt][1] += w01.y * bfhi(v0); a[tt][2] += w23.x * bflo(v1); a[tt][3] += w23.y * bfhi(v1); a[tt][4] += w45.x * bflo(v2); a[tt][5] += w45.y * bfhi(v2);
        }
    }
    float lgv[6], lbv[6];
#pragma unroll
    for (int c = 0; c < 6; ++c) { lgv[c] = lg[c0 + c]; lbv[c] = lb[c0 + c]; }
#pragma unroll
    for (int tt = 0; tt < 8; ++tt) {
        float s = a[tt][0] + a[tt][1] + a[tt][2] + a[tt][3] + a[tt][4] + a[tt][5];
        s = wave_sum(s);
        const float mu = s * (1.0f / 384.0f);
        float q = 0.f;
#pragma unroll
        for (int c = 0; c < 6; ++c) { const float d = a[tt][c] - mu; q += d * d; }
        q = wave_sum(q);
        const float rs = __builtin_amdgcn_rsqf(q * (1.0f / 384.0f) + EPS);
        float o[6];
#pragma unroll
        for (int c = 0; c < 6; ++c) { const float y = (a[tt][c] - mu) * rs * lgv[c] + lbv[c]; o[c] = y * sigmoidf_(y); }
        unsigned* dst = (unsigned*)(BRQ + (size_t)(m0 + wv * 8 + tt) * KBR + 1408 + c0);
        dst[0] = pk2(o[0], o[1]); dst[1] = pk2(o[2], o[3]); dst[2] = pk2(o[4], o[5]);
    }
}


#define XB_TMO      128
#define XB_XCNT(j)  (256  + 64 * (j))
#define XB_XSUB(j)  (1280 + 64 * (j))
#define XB_XGEN(j)  (2304 + 64 * (j))
#define XB_TOP      3328
#define XB_TOPGEN   3392
#define XCD_BAR_WORDS 3456
#define XB_SPIN_CAP (1u << 20)
DI unsigned xb_ld(unsigned* p)              { return __hip_atomic_load(p, __ATOMIC_RELAXED, __HIP_MEMORY_SCOPE_AGENT); }
DI unsigned xb_add(unsigned* p, unsigned v) { return __hip_atomic_fetch_add(p, v, __ATOMIC_RELAXED, __HIP_MEMORY_SCOPE_AGENT); }
DI unsigned xb_xcc_id() { return (unsigned)__builtin_amdgcn_s_getreg((3 << 11) | 20) & 0xFu; }
#define XB_SPIN(cond, bar) do { unsigned _sp = 0; while (cond) { __builtin_amdgcn_s_sleep(1); \
    if ((++_sp & 255u) == 0u) { if (xb_ld(&(bar)[XB_TMO])) break; if (_sp > XB_SPIN_CAP) { atomicAdd(&(bar)[XB_TMO], 1u); break; } } } } while (0)
struct XcdBarrier { unsigned* bar; unsigned x; volatile LAS unsigned* st; };
DI XcdBarrier xcd_barrier_post(unsigned* bar, volatile LAS unsigned* st) {
    XcdBarrier b; b.bar = bar; b.x = xb_xcc_id(); b.st = st;
    if (threadIdx.x == 0) (void)xb_add(&bar[XB_XCNT(b.x)], 1u);
    return b;
}
DI void xcd_barrier_complete(unsigned* bar, unsigned x, unsigned& nloc, unsigned& nx) {
    const unsigned G = gridDim.x * gridDim.y * gridDim.z;
    unsigned sum, cnt, mine, sp = 0u;
    for (;;) {
        sum = 0u; cnt = 0u; mine = 0u;
#pragma unroll
        for (unsigned j = 0; j < 16; ++j) { const unsigned c = xb_ld(&bar[XB_XCNT(j)]); sum += c; cnt += (c > 0u) ? 1u : 0u; mine = (j == x) ? c : mine; }
        if (sum == G) break;
        __builtin_amdgcn_s_sleep(1);
        if ((++sp & 255u) == 0u) { if (xb_ld(&bar[XB_TMO])) break; if (sp > XB_SPIN_CAP) { atomicAdd(&bar[XB_TMO], 1u); break; } }
    }
    nloc = mine > 0u ? mine : 1u; nx = cnt > 0u ? cnt : 1u;
}
DI void xcd_barrier(const XcdBarrier& b) {
    asm volatile("s_waitcnt vmcnt(0)" ::: "memory");
    __syncthreads();
    if (threadIdx.x == 0) {
        unsigned* bar = b.bar;
        __builtin_amdgcn_s_waitcnt(0);
        unsigned nloc = b.st[0], nx = b.st[1];
        if (nloc == 0u) { xcd_barrier_complete(bar, b.x, nloc, nx); b.st[0] = nloc; b.st[1] = nx; }
        const unsigned old = xb_add(&bar[XB_XSUB(b.x)], 1u);
        const unsigned gen = old / nloc;
        if (old + 1u == (gen + 1u) * nloc) {
            __builtin_amdgcn_fence(__ATOMIC_RELEASE, "agent");
            asm volatile("s_waitcnt vmcnt(0)" ::: "memory");
            const unsigned og = xb_add(&bar[XB_TOP], 1u);
            const unsigned tg = og / nx;
            if (og + 1u == (tg + 1u) * nx) xb_add(&bar[XB_TOPGEN], 1u);
            else XB_SPIN(xb_ld(&bar[XB_TOPGEN]) == tg, bar);
            __builtin_amdgcn_fence(__ATOMIC_ACQUIRE, "agent");
            xb_add(&bar[XB_XGEN(b.x)], 1u);
            asm volatile("s_waitcnt vmcnt(0)" ::: "memory");
        } else {
            XB_SPIN(xb_ld(&bar[XB_XGEN(b.x)]) == gen, bar);
            __builtin_amdgcn_fence(__ATOMIC_ACQUIRE, "agent");
            asm volatile("s_waitcnt vmcnt(0)" ::: "memory");
        }
    }
    __syncthreads();
}

struct KArgs { Ptrs p; int ph_lo, ph_hi; };

__global__ void __launch_bounds__(NTHREADS, 2) fwd_mega(KArgs args) {
    extern __shared__ __attribute__((aligned(16))) unsigned char lds_raw[];
    LAS unsigned char* lds = (LAS unsigned char*)lds_raw;
    cg::grid_group grid = cg::this_grid();
    const Ptrs& P = args.p;
    unsigned char* ws = P.ws;
    const int tid = threadIdx.x, bid = blockIdx.x, G = gridDim.x;
    unsigned* ctl = (unsigned*)(ws + OFF_CTL);
    float* misc = (float*)(ws + OFF_MISC);
    int ph = 0;
    if (args.ph_hi < 0) grid.sync();
    volatile LAS unsigned* xst = (volatile LAS unsigned*)(lds + 131072 + 16);
    if (tid == 0) { xst[0] = 0u; xst[1] = 0u; }
    __syncthreads();
    { const XcdBarrier xb0 = xcd_barrier_post((unsigned*)(ws + OFF_BAR), xst); if (tid == 0) xst[2] = xb0.x; }
    __syncthreads();
#define PHASE_BEGIN if (ph >= args.ph_lo && ph < args.ph_hi) {
#define PHASE_END(dosync_) if ((dosync_) && ph + 1 < args.ph_hi) { XcdBarrier xb_; xb_.bar = (unsigned*)(args.p.ws + OFF_BAR); xb_.st = (volatile LAS unsigned*)(lds + 131072 + 16); xb_.x = xb_.st[2]; xcd_barrier(xb_); } } ++ph;

    PHASE_BEGIN
        if (bid == 0) {
            if (tid < 64) ctl[tid] = 0u;
            if (tid < 2) { const float* lv = P.in[I_LAMBDA] + tid * 256; float s0 = 0.f, s1 = 0.f;
                for (int i = 0; i < 64; ++i) { s0 += lv[i] * lv[64 + i]; s1 += lv[128 + i] * lv[192 + i]; }
                const float li = 0.8f - 0.6f * expf(-0.3f * (float)tid);
                misc[tid * 2] = expf(s0) - expf(s1) + li; misc[tid * 2 + 1] = li; }
            for (int i = tid; i < 64 * 16; i += NTHREADS) { const int pos = i >> 4, f = i & 15; const float inv = powf(10000.0f, -(float)f / 16.0f); const float ang = (float)pos * inv;
                ((f32x2*)(ws + OFF_ROPE))[i] = (f32x2){cosf(ang), sinf(ang)}; }
        }
        mod_gemv(lds, P, bid, G);
        conv_win(lds, P, 0, bid, G);
        gen_dft(lds, ws, bid, G, true);
    PHASE_END(true)
    PHASE_BEGIN
        rows_first(P);
    PHASE_END(true)

    for (int l = 0; l < 2; ++l) {
        const int nMt = l == 0 ? 68 : 64;
        PHASE_BEGIN
            RectSched S{(const char*)(ws + OFF_HS), (const char*)(ws + OFF_WINT), (size_t)256 * D * 2, (size_t)256 * D * 2, 16, G, bid, nMt, 15, 64, l == 0 ? 0 : 4, 5};
            EpiInA E{ws, P.in[I_QNORM] + l * 64, P.in[I_KNORM] + l * 64, lds + 131072 + 256, ctl + 32 + 2 * l};
            pg8::gemm_phase(lds, D, D, S, E);
        PHASE_END(true)
        PHASE_BEGIN
            fourier_fold(ws, bid, G);
        PHASE_END(true)
        PHASE_BEGIN
            if (bid < 96) {
                OneSched S; S.have = true; S.u.pm = bid & 15; S.u.pn = bid >> 4; S.u.nt = 64;
                S.u.A = (const char*)(ws + A_DFT) + (size_t)S.u.pm * 256 * 4096 * 2; S.u.B = (const char*)(ws + A_FTF) + (size_t)S.u.pn * 256 * 4096 * 2;
                EpiFourier E{(bf16_t*)(ws + A_BRQ), 0, SEQ, 1.0f / 512.0f};
                pg8::gemm_phase(lds, 4096, 4096, S, E);
            } else if (l == 0 && bid < 102) {
                OneSched S; S.have = true; S.u.pm = 0; S.u.pn = bid - 96; S.u.nt = 8;
                S.u.A = (const char*)(ws + OFF_DFTC); S.u.B = (const char*)(ws + A_FTC) + (size_t)S.u.pn * 256 * 512 * 2;
                EpiFourier E{(bf16_t*)(ws + A_BRQ), MLAT, LC, 1.0f / 128.0f};
                pg8::gemm_phase(lds, 512, 512, S, E);
            }
            {
                const float lam = __uint_as_float(__builtin_amdgcn_readfirstlane(__float_as_uint(misc[l * 2]))), lam_init = __uint_as_float(__builtin_amdgcn_readfirstlane(__float_as_uint(misc[l * 2 + 1])));
                bool gsmall;
                { float mq = fabsf(P.in[I_QNORM][l * 64 + (tid & 63)]), mk = fabsf(P.in[I_KNORM][l * 64 + (tid & 63)]);
                  mq = wave_max(mq); mk = wave_max(mk);
                  gsmall = __builtin_amdgcn_readfirstlane((int)(64.0f * QSCALE * 1.02f * mq * mk < 60.0f)) != 0; }
                const int n_diff = 32, n_gqa = 32, n_cd = l == 0 ? 2 : 0, n_cg = l == 0 ? 2 : 0, n_conv = l == 0 ? 34 : 32;
                const int total = n_diff + n_gqa + n_cd + n_cg + n_conv;
                volatile LAS int* slot = (volatile LAS int*)(lds + 131072);
                for (int dx = 0; dx < 8; ++dx) {
                    const int x = (bid + dx) & 7;
                    for (;;) {
                        __syncthreads();
                        if (tid == 0) *slot = (int)atomicAdd(ctl + l * 8 + x, 1u);
                        __syncthreads();
                        int it = *slot;
                        if (it >= total) break;
                        if (it < n_diff) { const int pi = 2 * x + (it >> 4), b = pi >> 2, hd = pi & 3, qb = it & 15; diff_unit(lds, P, l, b, hd, b * SEQ + qb * 256, 0, LKV / 64, lam, lam_init); continue; }
                        it -= n_diff;
                        if (it < n_gqa) { const int b = x >> 1, qh = (x & 1) * 4 + 2 * (it >> 4), qb = it & 15; if (gsmall) gqa_pair_unit(lds, P, l, b, qh, b * SEQ + qb * 256, 0, LKV / 64);
                            else {
#pragma nounroll
                                for (int hh = 0; hh < 2; ++hh) gqa_unit(lds, P, l, b, qh + hh, b * SEQ + qb * 256, 0, LKV / 64); }
                            continue; }
                        it -= n_gqa;
                        if (it < n_cd) { const int pi = 2 * x + it, b = pi >> 2, hd = pi & 3; diff_unit(lds, P, l, b, hd, MLAT + b * LC, SEQ, LC / 64, lam, lam_init); continue; }
                        it -= n_cd;
                        if (it < n_cg) { const int b = x >> 1, qh = (x & 1) * 4 + 2 * it; if (gsmall) gqa_pair_unit(lds, P, l, b, qh, MLAT + b * LC, SEQ, LC / 64);
                            else {
#pragma nounroll
                                for (int hh = 0; hh < 2; ++hh) gqa_unit(lds, P, l, b, qh + hh, MLAT + b * LC, SEQ, LC / 64); }
                            continue; }
                        it -= n_cg;
                        { const int m0 = (x * n_conv + it) * 64; int s0, Ls; if (m0 < MLAT) { s0 = m0 & ~4095; Ls = SEQ; } else { s0 = MLAT + ((m0 - MLAT) & ~255); Ls = LC; }
                          conv_unit(lds, P, l, m0, s0, Ls); }
                    }
                }
                __syncthreads();
            }
        PHASE_END(true)
        PHASE_BEGIN
            {
                bf16_t* wbr = (bf16_t*)(ws + A_WBRT);
                convT(lds, P.in[I_WBRF] + (size_t)l * 384 * D, D, 384, wbr, KBR, D, MapId{0}, bid, G);
                convT(lds, P.in[I_WBRD] + (size_t)l * 512 * D, D, 512, wbr + 384, KBR, D, MapId{0}, (bid + 48) % G, G);
                convT(lds, P.in[I_WBRG] + (size_t)l * 512 * D, D, 512, wbr + 896, KBR, D, MapId{0}, (bid + 112) % G, G);
                convT(lds, P.in[I_WBRC] + (size_t)l * 384 * D, D, 384, wbr + 1408, KBR, D, MapId{0}, (bid + 176) % G, G);
                convT(lds, P.in[I_WOUT] + (size_t)l * D * D, D, D, (bf16_t*)(ws + A_WOUTT), D, D, MapId{0}, (bid + 224) % G, G);
                __syncthreads();
            }
            RectSched S{(const char*)(ws + OFF_HS), (const char*)(ws + OFF_WINT) + (size_t)3840 * D * 2, (size_t)256 * D * 2, (size_t)256 * D * 2, 16, G, bid, nMt, 16, 0, 0, 0};
            EpiGate E{(bf16_t*)(ws + A_G)};
            pg8::gemm_phase(lds, D, D, S, E);
        PHASE_END(true)
        PHASE_BEGIN
            RectSched S{(const char*)(ws + A_BRQ), (const char*)(ws + A_WBRT), (size_t)256 * KBR * 2, (size_t)256 * KBR * 2, 28, G, bid, nMt, 4, 0, 0, 0};
            EpiBranch E{(const bf16_t*)(ws + A_G), (bf16_t*)(ws + OFF_HS)};
            pg8::gemm_phase(lds, KBR, KBR, S, E);
        PHASE_END(true)
        PHASE_BEGIN
            RectSched S{(const char*)(ws + OFF_HS), (const char*)(ws + A_WOUTT), (size_t)256 * D * 2, (size_t)256 * D * 2, 16, G, bid, nMt, 4, 0, 0, 0};
            EpiBf16<0> E{(bf16_t*)(ws + A_MIXO), D};
            pg8::gemm_phase(lds, D, D, S, E);
        PHASE_END(true)
        PHASE_BEGIN
            rows_update(P, l, 0, l == 0 ? MTOT : MLAT);
            convT(lds, P.in[I_WFF1] + (size_t)l * D * DFF, DFF, D, (bf16_t*)(ws + A_WFF1T), D, DFF, MapId{0}, bid, G);
            convT(lds, P.in[I_WFF2] + (size_t)l * DFF * D, D, DFF, (bf16_t*)(ws + A_WFF2T), DFF, D, MapId{0}, bid, G);
        PHASE_END(true)
        PHASE_BEGIN
            RectSched S{(const char*)(ws + OFF_HS), (const char*)(ws + A_WFF1T), (size_t)256 * D * 2, (size_t)256 * D * 2, 16, G, bid, nMt, 16, 0, 0, 0};
            EpiBf16<2> E{(bf16_t*)(ws + A_FF), DFF};
            pg8::gemm_phase(lds, D, D, S, E);
        PHASE_END(true)
        PHASE_BEGIN
            RectSched S{(const char*)(ws + A_FF), (const char*)(ws + A_WFF2T), (size_t)256 * DFF * 2, (size_t)256 * DFF * 2, 64, G, bid, nMt, 4, 0, 0, 0};
            EpiBf16<0> E{(bf16_t*)(ws + A_MIXO), D};
            pg8::gemm_phase(lds, DFF, DFF, S, E);
        PHASE_END(true)
        PHASE_BEGIN
            rows_update(P, l, 1, l == 0 ? MTOT : MLAT);
            if (l == 0) { conv_win(lds, P, 1, bid, G); gen_dft(lds, ws, bid, G, false); }
        PHASE_END(l == 0)
    }
}

extern "C" void kernel_launch(void* const* d_in, const int* in_sizes, int n_in, void* d_out, int out_size, void* d_ws, size_t ws_size, hipStream_t stream) {
    static int grid = 0;
    if (grid == 0) {
        if (n_in != 26 || ws_size < WS_END) { fprintf(stderr, "kernel_launch: unexpected inputs (%d) or workspace (%zu < %zu)\n", n_in, ws_size, (size_t)WS_END); grid = -1; return; }
        int dev = 0, cus = 0, per_cu = 0;
        (void)hipGetDevice(&dev);
        (void)hipDeviceGetAttribute(&cus, hipDeviceAttributeMultiprocessorCount, dev);
        if (hipFuncSetAttribute((const void*)fwd_mega, hipFuncAttributeMaxDynamicSharedMemorySize, LDS_BYTES) != hipSuccess) { fprintf(stderr, "hipFuncSetAttribute failed\n"); grid = -1; return; }
        if (hipOccupancyMaxActiveBlocksPerMultiprocessor(&per_cu, (const void*)fwd_mega, NTHREADS, LDS_BYTES) != hipSuccess || per_cu < 1) { fprintf(stderr, "occupancy query: %d\n", per_cu); per_cu = 1; }
        (void)hipGetLastError();
        grid = cus * per_cu;
        if (grid > 256) grid = 256;
    }
    if (grid < 0) return;
    KArgs a{};
    for (int i = 0; i < 26; ++i) a.p.in[i] = (const float*)d_in[i];
    a.p.out = (float*)d_out; a.p.ws = (unsigned char*)d_ws;
#ifndef PROBE_RANGES
#define PROBE_RANGES {0, 1000}
#endif
    static const int ranges[][2] = { PROBE_RANGES };
    const int nr = (int)(sizeof(ranges) / sizeof(ranges[0]));
    for (int i = 0; i < nr; ++i) {
        if (i > 0) (void)hipMemsetAsync((char*)d_ws + OFF_CTL, 0, 256, stream);
        (void)hipMemsetAsync((char*)d_ws + OFF_BAR, 0, 16384, stream);
        a.ph_lo = ranges[i][0]; a.ph_hi = ranges[i][1];
        void* kargs[] = {&a};
        hipError_t e = hipLaunchCooperativeKernel((const void*)fwd_mega, dim3(grid), dim3(NTHREADS), kargs, LDS_BYTES, stream);
        if (e != hipSuccess) fprintf(stderr, "cooperative launch failed: %s (grid %d)\n", hipGetErrorString(e), grid);
    }
}
```

```cpp
#include <hip/hip_runtime.h>
#include <hip/hip_cooperative_groups.h>
#include <cstdint>
#include <cstdio>
namespace cg = cooperative_groups;

#define LAS __attribute__((address_space(3)))
#define DI __device__ __forceinline__
typedef unsigned short bf16_t;
typedef short bf16x8 __attribute__((ext_vector_type(8)));
typedef short s16x4 __attribute__((ext_vector_type(4)));
typedef float f32x4 __attribute__((ext_vector_type(4)));
typedef float f32x2 __attribute__((ext_vector_type(2)));
typedef float f32x16 __attribute__((ext_vector_type(16)));
typedef unsigned u32x4 __attribute__((ext_vector_type(4)));
typedef unsigned u32x2 __attribute__((ext_vector_type(2)));
typedef __bf16 bf16x2_t __attribute__((ext_vector_type(2)));

DI unsigned pk2(float lo, float hi) { f32x2 v = {lo, hi}; return __builtin_bit_cast(unsigned, __builtin_convertvector(v, bf16x2_t)); }
DI float bflo(unsigned u) { return __uint_as_float(u << 16); }
DI float bfhi(unsigned u) { return __uint_as_float(u & 0xffff0000u); }
DI float sigmoidf_(float x) { return __builtin_amdgcn_rcpf(1.0f + __builtin_amdgcn_exp2f(-1.44269504f * x)); }
DI int tid_() { int t = threadIdx.x; asm volatile("" : "+v"(t)); return t; }
#define SWZ(v, O) __int_as_float(__builtin_amdgcn_ds_swizzle(__float_as_int(v), 0x1F | ((O) << 10)))
DI float add_x32(float v) { const u32x2 s = __builtin_amdgcn_permlane32_swap(__float_as_uint(v), __float_as_uint(v), false, false); return __uint_as_float(s[0]) + __uint_as_float(s[1]); }
DI float max_x32(float v) { const u32x2 s = __builtin_amdgcn_permlane32_swap(__float_as_uint(v), __float_as_uint(v), false, false); return fmaxf(__uint_as_float(s[0]), __uint_as_float(s[1])); }
DI float wave_sum(float v) { v += SWZ(v, 1); v += SWZ(v, 2); v += SWZ(v, 4); v += SWZ(v, 8); v += SWZ(v, 16); return add_x32(v); }
DI float wave_max(float v) { v = fmaxf(v, SWZ(v, 1)); v = fmaxf(v, SWZ(v, 2)); v = fmaxf(v, SWZ(v, 4)); v = fmaxf(v, SWZ(v, 8)); v = fmaxf(v, SWZ(v, 16)); return max_x32(v); }

constexpr int D = 1024, NB = 4, SEQ = 4096, LC = 256, MLAT = NB * SEQ, MCTX = NB * LC, MTOT = MLAT + MCTX, LKV = SEQ + LC;
constexpr int IN_COLS = 7552, NIN = 7936, DFF = 4096, KBR = 1792;
constexpr float EPS = 1e-6f;
constexpr float QSCALE = 0.125f * 1.44269504f;
enum { I_X = 0, I_C, I_CTX, I_CCTX, I_WMOD, I_BMOD, I_GPREMIX, I_GPOSTMIX, I_GPREMLP, I_GPOSTMLP, I_WIN, I_QNORM, I_KNORM, I_LAMBDA, I_SUBLN,
       I_CONVDW, I_CONVB, I_CONVLNG, I_CONVLNB, I_WBRF, I_WBRD, I_WBRG, I_WBRC, I_WOUT, I_WFF1, I_WFF2 };

constexpr size_t OFF_CTL = 0, OFF_MISC = 4096, OFF_MOD = 8192, OFF_ROPE = 253952, OFF_DFTC = 262144, OFF_HS = 524288;
constexpr size_t OFF_WINT = OFF_HS + (size_t)MTOT * D * 2;
constexpr size_t ARENA = OFF_WINT + (size_t)NIN * D * 2;
constexpr size_t A_BRQ = ARENA, A_MIXO = ARENA;
constexpr size_t A_G = ARENA + (size_t)MTOT * KBR * 2;
constexpr size_t A_DFT = A_G;
constexpr size_t A_FTF = A_DFT + (size_t)4096 * 4096 * 2;
constexpr size_t A_FT = A_DFT + (size_t)4096 * 8192 * 2;
constexpr size_t A_FTC = A_FT + (size_t)NB * 384 * 8192 * 2;
constexpr size_t A_DK = A_FTC + (size_t)NB * 384 * 512 * 2;
constexpr size_t A_DV = A_DK + (size_t)MTOT * 512 * 2;
constexpr size_t A_GK = A_DV + (size_t)MTOT * 512 * 2;
constexpr size_t A_GV = A_GK + (size_t)MTOT * 128 * 2;
constexpr size_t A_V = A_GV + (size_t)MTOT * 128 * 2;
constexpr size_t A_VEND = A_V + (size_t)MTOT * 384 * 2;
constexpr size_t A_WBRT = A_G + (size_t)MTOT * 4096 * 2;
constexpr size_t A_WOUTT = A_WBRT + (size_t)D * KBR * 2;
constexpr size_t A_FF = ARENA + (size_t)MTOT * D * 2;
constexpr size_t A_WFF1T = A_FF + (size_t)MTOT * DFF * 2;
constexpr size_t A_WFF2T = A_WFF1T + (size_t)DFF * D * 2;
constexpr size_t A_XC = A_WFF2T + (size_t)DFF * D * 2;
constexpr size_t OFF_BAR = A_VEND;
constexpr size_t WS_END = OFF_BAR + 16384;
static_assert(A_XC + (size_t)MCTX * D * 4 <= A_WBRT, "xc overlaps");
static_assert(A_WOUTT + (size_t)D * D * 2 <= WS_END, "ws end");
static_assert(WS_END <= 268435456ull, "workspace too large");

constexpr int LDS_BYTES = 131072 + 256 + 18432;
constexpr int NTHREADS = 512;

namespace pg8 {
constexpr int BM = 256, BK = 64, HALF = 128, HTB = HALF * BK * 2, NXCD = 8, WGM = 8;
DI int lds_byte(int r, int c) { const int st = (r >> 4) * 2 + (c >> 5), rr = r & 15, cc = c & 31, ob = rr * 64 + cc * 2; return st * 1024 + (ob ^ (((ob >> 9) & 1) << 5)); }
DI void stage_rc(int b, int& R, int& C) { const int st = b / 1024, sb = b % 1024, swz = sb ^ (((sb >> 9) & 1) << 5); R = (st >> 1) * 16 + swz / 64; C = (st & 1) * 32 + (swz % 64) / 2; }
DI int perm32(int rho) { const int n = rho >> 4, i = rho & 15; return 8 * (i >> 2) + 4 * n + (i & 3); }

struct Unit { const char* A; const char* B; int nt, pm, pn; };

DI void rect_map(int L, int nM, int nN, int& pm, int& pn) {
    const int nwg = nM * nN; int wgid = L;
    { const int q = nwg / NXCD, r = nwg % NXCD, xcd = wgid % NXCD, off = wgid / NXCD; wgid = (xcd < r ? xcd * (q + 1) : r * (q + 1) + (xcd - r) * q) + off; }
    const int nig = WGM * nN, gid = wgid / nig, fm = gid * WGM, gsz = (nM - fm) < WGM ? (nM - fm) : WGM;
    pm = fm + ((wgid % nig) % gsz); pn = (wgid % nig) / gsz;
}

template <class Epi, class Sched>
DI void gemm_phase(LAS unsigned char* lds, const int lda, const int ldb, const Sched& S, const Epi& E) {
    int tid = threadIdx.x; asm volatile("" : "+v"(tid));
    const int wid = __builtin_amdgcn_readfirstlane(tid >> 6), lane = tid & 63, wr = wid >> 2, wc = wid & 3, fr = lane & 15, fq = lane >> 4;
    unsigned voffA[2], voffB[2];
#pragma unroll
    for (int i = 0; i < 2; ++i) { int R, C; stage_rc(tid * 16 + i * 8192, R, C); const int Rb = Epi::PERM ? ((R & ~31) + perm32(R & 31)) : R;
        voffA[i] = (unsigned)(R * lda + C) * 2u; voffB[i] = (unsigned)(Rb * ldb + C) * 2u; }
    const size_t kstep = (size_t)(BK * 2);
    const size_t hstepA = (size_t)HALF * lda * 2, hstepB = (size_t)HALF * ldb * 2;
    const unsigned ldsw = (unsigned)wid * 1024u;
    const int aoff = lds_byte(wr * 64 + fr, fq * 8), boff = lds_byte(wc * 32 + fr, fq * 8);
#define PG8_SA(b, h) (((b) * 2 + (h)) * HTB)
#define PG8_SB(b, h) ((4 + (b) * 2 + (h)) * HTB)
#define PG8_STAGE(bufoff, gbase, voff) do { _Pragma("unroll") for (int _i = 0; _i < 2; ++_i) \
        __builtin_amdgcn_global_load_lds((const unsigned*)((const char*)(gbase) + (voff)[_i]), (LAS unsigned*)(lds + (bufoff) + ldsw + _i * 8192), 16, 0, 0); } while (0)
#define PG8_LDA(dst, b, h) do { _Pragma("unroll") for (int m = 0; m < 4; ++m) _Pragma("unroll") for (int k = 0; k < 2; ++k) dst[m][k] = *(const LAS bf16x8*)(lds + PG8_SA(b, h) + aoff + m * 2048 + k * 1024); } while (0)
#define PG8_LDB(dst, b, h) do { _Pragma("unroll") for (int n = 0; n < 2; ++n) _Pragma("unroll") for (int k = 0; k < 2; ++k) dst[n][k] = *(const LAS bf16x8*)(lds + PG8_SB(b, h) + boff + n * 2048 + k * 1024); } while (0)
#define PG8_MMA(ai, bj, At, Bt) do { __builtin_amdgcn_s_setprio(1); _Pragma("unroll") for (int m = 0; m < 4; ++m) _Pragma("unroll") for (int n = 0; n < 2; ++n) _Pragma("unroll") for (int k = 0; k < 2; ++k) \
        acc[ai][bj][m][n] = __builtin_amdgcn_mfma_f32_16x16x32_bf16(Bt[n][k], At[m][k], acc[ai][bj][m][n], 0, 0, 0); __builtin_amdgcn_s_setprio(0); } while (0)
#define PG8_WAIT_V(n) asm volatile("s_waitcnt vmcnt(" #n ")" ::: "memory")
#define PG8_WAIT_L(n) asm volatile("s_waitcnt lgkmcnt(" #n ")" ::: "memory")
#define PG8_BAR __builtin_amdgcn_s_barrier()
#define PG8_SCHED __builtin_amdgcn_sched_barrier(0)
    Unit cur, nxt; int ui = 0;
    if (!S.next(0, cur)) return;
    f32x4 acc[2][2][4][2];
#pragma unroll
    for (int a = 0; a < 2; ++a)
#pragma unroll
        for (int b = 0; b < 2; ++b)
#pragma unroll
            for (int m = 0; m < 4; ++m)
#pragma unroll
                for (int n = 0; n < 2; ++n) acc[a][b][m][n] = (f32x4){0.f, 0.f, 0.f, 0.f};
    bf16x8 At[4][2], B0[2][2], B1[2][2];
    const char* cA = cur.A; const char* cB = cur.B;
    PG8_STAGE(PG8_SB(0, 0), cB, voffB); PG8_STAGE(PG8_SB(0, 1), cB + hstepB, voffB); PG8_STAGE(PG8_SA(0, 0), cA, voffA); PG8_STAGE(PG8_SA(0, 1), cA + hstepA, voffA);
    if (wr == 1) PG8_BAR;
    PG8_WAIT_V(2); PG8_BAR;
    PG8_STAGE(PG8_SB(1, 0), cB + kstep, voffB); PG8_STAGE(PG8_SA(1, 0), cA + kstep, voffA); PG8_STAGE(PG8_SB(1, 1), cB + hstepB + kstep, voffB);
    PG8_WAIT_V(6); PG8_BAR;
    for (;;) {
        const bool has_next = S.next(ui + 1, nxt);
        const char* nA = has_next ? nxt.A : cA; const char* nB = has_next ? nxt.B : cB;
        const int nt = cur.nt;
        for (int t = 0; t < nt; t += 2) {
            if constexpr (Epi::HOOK) { if (t == 6 || t == 14 || t == 22) E.hook(acc, cur, t, wr, wc, fr, fq); }
            const bool last = (t == nt - 2);
            const char* a1 = cA + (size_t)(t + 1) * kstep;
            const char* a2 = last ? nA : cA + (size_t)(t + 2) * kstep; const char* b2 = last ? nB : cB + (size_t)(t + 2) * kstep;
            const char* a3 = a2 + kstep; const char* b3 = b2 + kstep;
            PG8_LDB(B0, 0, 0); PG8_LDB(B1, 0, 1); PG8_SCHED; PG8_LDA(At, 0, 0); PG8_STAGE(PG8_SA(1, 1), a1 + hstepA, voffA);
            PG8_WAIT_V(8); PG8_WAIT_L(0); PG8_BAR; PG8_MMA(0, 0, At, B0); PG8_MMA(0, 1, At, B1); PG8_BAR; PG8_SCHED;
            PG8_LDA(At, 0, 1); PG8_STAGE(PG8_SB(0, 0), b2, voffB); PG8_STAGE(PG8_SB(0, 1), b2 + hstepB, voffB); PG8_STAGE(PG8_SA(0, 0), a2, voffA);
            PG8_WAIT_V(8); PG8_WAIT_L(0); PG8_BAR; PG8_MMA(1, 0, At, B0); PG8_MMA(1, 1, At, B1); PG8_BAR; PG8_SCHED;
            PG8_LDB(B0, 1, 0); PG8_LDB(B1, 1, 1); PG8_SCHED; PG8_LDA(At, 1, 0); PG8_STAGE(PG8_SA(0, 1), a2 + hstepA, voffA);
            PG8_WAIT_V(8); PG8_WAIT_L(0); PG8_BAR; PG8_MMA(0, 0, At, B0); PG8_MMA(0, 1, At, B1); PG8_BAR; PG8_SCHED;
            PG8_LDA(At, 1, 1); PG8_STAGE(PG8_SB(1, 0), b3, voffB); PG8_STAGE(PG8_SB(1, 1), b3 + hstepB, voffB); PG8_STAGE(PG8_SA(1, 0), a3, voffA);
            PG8_WAIT_V(8); PG8_WAIT_L(0); PG8_BAR; PG8_MMA(1, 0, At, B0); PG8_MMA(1, 1, At, B1); PG8_BAR; PG8_SCHED;
        }
        if (wr == 0) PG8_BAR;
        E(acc, cur, wr, wc, fr, fq);
        if (!has_next) break;
#pragma unroll
        for (int a = 0; a < 2; ++a)
#pragma unroll
            for (int b = 0; b < 2; ++b)
#pragma unroll
                for (int m = 0; m < 4; ++m)
#pragma unroll
                    for (int n = 0; n < 2; ++n) acc[a][b][m][n] = (f32x4){0.f, 0.f, 0.f, 0.f};
        cur = nxt; cA = nA; cB = nB; ++ui;
        if (wr == 1) PG8_BAR;
    }
    PG8_WAIT_V(0);
    PG8_BAR;
#undef PG8_SA
#undef PG8_SB
#undef PG8_STAGE
#undef PG8_LDA
#undef PG8_LDB
#undef PG8_MMA
#undef PG8_WAIT_V
#undef PG8_WAIT_L
#undef PG8_BAR
#undef PG8_SCHED
}
}
using pg8::Unit;
typedef f32x4 Acc[2][2][4][2];

struct RectSched {
    const char* A; const char* B; size_t astep, bstep;
    int nt, G, c, nM1, nN1, m2, nM2, nN2;
    DI bool next(int i, Unit& u) const {
        const int L = i * G + c; const int n1 = nM1 * nN1;
        int pm, pn;
        if (L < n1) pg8::rect_map(L, nM1, nN1, pm, pn);
        else if (L < n1 + nM2 * nN2) { pg8::rect_map(L - n1, nM2, nN2, pm, pn); pm += m2; }
        else return false;
        u.pm = pm; u.pn = pn; u.nt = nt; u.A = A + (size_t)pm * astep; u.B = B + (size_t)pn * bstep; return true;
    }
};
struct OneSched {
    Unit u; bool have;
    DI bool next(int i, Unit& o) const { if (i != 0 || !have) return false; o = u; return true; }
};

struct Ptrs {
    const float* in[26]; float* out; unsigned char* ws;
};

struct EpiInA {
    static constexpr bool PERM = true, HOOK = false;
    unsigned char* ws; const float* qn; const float* kn;
    LAS unsigned char* scr;
    unsigned* nrm;
    DI void hook(Acc&, const Unit&, int, int, int, int, int) const {}
    DI void operator()(const Acc& acc, const Unit& u, int wr, int wc, int fr, int fq) const {
        const int pn = u.pn;
        const f32x2* rope = (const f32x2*)(ws + OFF_ROPE);
        bf16_t* BRQ = (bf16_t*)(ws + A_BRQ);
        const bool ctx = u.pm >= 64;
        if (pn <= 1 || pn == 5 || pn == 6) {
            float nmax = 0.f;
#pragma unroll
            for (int ai = 0; ai < 2; ++ai)
#pragma unroll
                for (int m = 0; m < 4; ++m) {
                const int row = u.pm * 256 + ai * 128 + wr * 64 + m * 16 + fr;
                int b, t, kvrow;
                if (!ctx) { b = row >> 12; t = row & 4095; kvrow = b * LKV + t; }
                else { const int j = row - MLAT; b = j >> 8; t = j & 255; kvrow = b * LKV + SEQ + t; }
                const int prow = t >> 6, pcol = t & 63; (void)b; (void)kvrow; (void)prow; (void)pcol;
                    const bool isq = pn >= 5;
                    const int axis = wc & 1; const int pos = axis ? pcol : prow;
                    f32x2 cs[4];
#pragma unroll
                    for (int j = 0; j < 4; ++j) cs[j] = ctx ? (f32x2){1.f, 0.f} : rope[pos * 16 + 4 * fq + j];
#pragma unroll
                    for (int bj = 0; bj < 2; ++bj) {
                        const f32x4 re = acc[ai][bj][m][0], im = acc[ai][bj][m][1];
                        float o0[4], o1[4];
#pragma unroll
                        for (int j = 0; j < 4; ++j) { o0[j] = re[j] * cs[j].x - im[j] * cs[j].y; o1[j] = im[j] * cs[j].x + re[j] * cs[j].y; if (isq) { o0[j] *= QSCALE; o1[j] *= QSCALE; } }
                        const int c = (isq ? (pn - 5) : pn) * 256 + bj * 128 + wc * 32 + 8 * fq;
                        bf16_t* dst = isq ? (BRQ + (size_t)row * KBR + 384 + c) : ((bf16_t*)(ws + A_DK) + (size_t)kvrow * 512 + c);
                        *(u32x4*)dst = (u32x4){pk2(o0[0], o0[1]), pk2(o0[2], o0[3]), pk2(o1[0], o1[1]), pk2(o1[2], o1[3])};
                        float ss = o0[0] * o0[0] + o0[1] * o0[1] + o0[2] * o0[2] + o0[3] * o0[3] + o1[0] * o1[0] + o1[1] * o1[1] + o1[2] * o1[2] + o1[3] * o1[3];
                        ss += SWZ(ss, 16); ss = add_x32(ss); nmax = fmaxf(nmax, ss);
                    }
                }
            nmax = fmaxf(nmax, SWZ(nmax, 8)); nmax = fmaxf(nmax, SWZ(nmax, 4)); nmax = fmaxf(nmax, SWZ(nmax, 2)); nmax = fmaxf(nmax, SWZ(nmax, 1));
            if (fq == 0 && fr == 0) atomicMax(nrm + (pn >= 5 ? 1 : 0), __float_as_uint(nmax));
        } else if (pn == 2 || pn == 3) {
#pragma unroll
            for (int ai = 0; ai < 2; ++ai)
#pragma unroll
                for (int m = 0; m < 4; ++m) {
                const int row = u.pm * 256 + ai * 128 + wr * 64 + m * 16 + fr;
                int b, t, kvrow;
                if (!ctx) { b = row >> 12; t = row & 4095; kvrow = b * LKV + t; }
                else { const int j = row - MLAT; b = j >> 8; t = j & 255; kvrow = b * LKV + SEQ + t; }
                const int prow = t >> 6, pcol = t & 63; (void)b; (void)kvrow; (void)prow; (void)pcol;
#pragma unroll
                    for (int bj = 0; bj < 2; ++bj)
                        { const f32x4 v0 = acc[ai][bj][m][0], v1 = acc[ai][bj][m][1]; const int c = (pn - 2) * 256 + bj * 128 + wc * 32 + 8 * fq;
                            *(u32x4*)((bf16_t*)(ws + A_DV) + (size_t)kvrow * 512 + c) = (u32x4){pk2(v0[0], v0[1]), pk2(v0[2], v0[3]), pk2(v1[0], v1[1]), pk2(v1[2], v1[3])}; }
                }
        } else if (pn == 4 || pn == 7 || pn == 8) {
#pragma unroll
            for (int ai = 0; ai < 2; ++ai)
#pragma unroll
                for (int m = 0; m < 4; ++m) {
                const int row = u.pm * 256 + ai * 128 + wr * 64 + m * 16 + fr;
                int b, t, kvrow;
                if (!ctx) { b = row >> 12; t = row & 4095; kvrow = b * LKV + t; }
                else { const int j = row - MLAT; b = j >> 8; t = j & 255; kvrow = b * LKV + SEQ + t; }
                const int prow = t >> 6, pcol = t & 63; (void)b; (void)kvrow; (void)prow; (void)pcol;
                    const bool isq = pn >= 7; const bool isv = (pn == 4) && wc >= 2;
                    float ss = 0.f;
#pragma unroll
                    for (int bj = 0; bj < 2; ++bj)
#pragma unroll
                        for (int n = 0; n < 2; ++n) { const f32x4 v = acc[ai][bj][m][n]; ss += v[0] * v[0] + v[1] * v[1] + v[2] * v[2] + v[3] * v[3]; }
                    ss += SWZ(ss, 16); ss = add_x32(ss);
                    const float rs = isv ? 1.f : __builtin_amdgcn_rsqf(ss * (1.0f / 64.0f) + EPS);
                    const float* gn = isq ? qn : kn;
                    bf16_t* dst;
                    if (isq) dst = BRQ + (size_t)row * KBR + 896 + ((pn - 7) * 4 + wc) * 64;
                    else if (isv) dst = (bf16_t*)(ws + A_GV) + (size_t)kvrow * 128 + (wc - 2) * 64;
                    else dst = (bf16_t*)(ws + A_GK) + (size_t)kvrow * 128 + wc * 64;
#pragma unroll
                    for (int bj = 0; bj < 2; ++bj) {
                        const int pos = bj ? pcol : prow;
                        float o0[4], o1[4];
#pragma unroll
                        for (int j = 0; j < 4; ++j) {
                            float re = acc[ai][bj][m][0][j], im = acc[ai][bj][m][1][j];
                            if (!isv) { re *= rs * gn[32 * bj + 4 * fq + j]; im *= rs * gn[32 * bj + 16 + 4 * fq + j]; }
                            f32x2 cs = (ctx || isv) ? (f32x2){1.f, 0.f} : rope[pos * 16 + 4 * fq + j];
                            o0[j] = re * cs.x - im * cs.y; o1[j] = im * cs.x + re * cs.y;
                            if (isq) { o0[j] *= QSCALE; o1[j] *= QSCALE; }
                        }
                        *(u32x4*)(dst + 32 * bj + 8 * fq) = (u32x4){pk2(o0[0], o0[1]), pk2(o0[2], o0[3]), pk2(o1[0], o1[1]), pk2(o1[2], o1[3])};
                    }
                }
        } else if (pn <= 11) {
            const int lane = fq * 16 + fr, col = lane >> 2, chunk = lane & 3;
            LAS bf16_t* sw = (LAS bf16_t*)(scr + (wr * 4 + wc) * 2304);
#pragma unroll
            for (int ai = 0; ai < 2; ++ai) {
                const int row0 = u.pm * 256 + ai * 128 + wr * 64;
                int b, t0; if (!ctx) { b = row0 >> 12; t0 = row0 & 4095; } else { const int j = row0 - MLAT; b = j >> 8; t0 = j & 255; }
#pragma unroll
                for (int bj = 0; bj < 2; ++bj)
#pragma unroll
                    for (int n = 0; n < 2; ++n) {
#pragma unroll
                        for (int m = 0; m < 4; ++m) { const f32x4 v = acc[ai][bj][m][n];
#pragma unroll
                            for (int j = 0; j < 4; ++j) sw[(4 * fq + j) * 72 + 16 * m + fr] = (bf16_t)(pk2(v[j], 0.f) & 0xffffu); }
                        asm volatile("s_waitcnt lgkmcnt(0)" ::: "memory");
                        const u32x4 v0 = *(const LAS u32x4*)(sw + col * 72 + chunk * 16), v1 = *(const LAS u32x4*)(sw + col * 72 + chunk * 16 + 8);
                        const int c0 = (pn - 9) * 256 + bj * 128 + wc * 32 + 8 * (col >> 2) + 4 * n + (col & 3); const int part = c0 >= 384 ? 1 : 0; const int ch = c0 - part * 384;
                        bf16_t* dst = ctx ? ((bf16_t*)(ws + A_FTC) + (size_t)(b * 384 + ch) * 512 + part * 256 + t0 + chunk * 16)
                                          : ((bf16_t*)(ws + A_FT) + (size_t)(b * 384 + ch) * 8192 + part * 4096 + t0 + chunk * 16);
                        *(u32x4*)dst = v0; *(u32x4*)(dst + 8) = v1;
                        asm volatile("s_waitcnt lgkmcnt(0)" ::: "memory");
                    }
            }
        } else {
#pragma unroll
            for (int ai = 0; ai < 2; ++ai)
#pragma unroll
                for (int m = 0; m < 4; ++m) {
                const int row = u.pm * 256 + ai * 128 + wr * 64 + m * 16 + fr;
                int b, t, kvrow;
                if (!ctx) { b = row >> 12; t = row & 4095; kvrow = b * LKV + t; }
                else { const int j = row - MLAT; b = j >> 8; t = j & 255; kvrow = b * LKV + SEQ + t; }
                const int prow = t >> 6, pcol = t & 63; (void)b; (void)kvrow; (void)prow; (void)pcol;
#pragma unroll
                    for (int bj = 0; bj < 2; ++bj) {
                        const f32x4 a = acc[ai][bj][m][0], g = acc[ai][bj][m][1];
                        const int ch = ((pn - 12) * 8 + 4 * bj + wc) * 16 + 4 * fq;
                        float o[4];
#pragma unroll
                        for (int j = 0; j < 4; ++j) o[j] = a[j] * sigmoidf_(g[j]);
                        *(u32x2*)((bf16_t*)(ws + A_V) + (size_t)row * 384 + ch) = (u32x2){pk2(o[0], o[1]), pk2(o[2], o[3])};
                    }
                }
        }
    }
};

template <int ACT> struct EpiBf16 {
    static constexpr bool PERM = true, HOOK = false;
    bf16_t* O; int ldc;
    DI void hook(Acc&, const Unit&, int, int, int, int, int) const {}
    DI void operator()(const Acc& acc, const Unit& u, int wr, int wc, int fr, int fq) const {
#pragma unroll
        for (int ai = 0; ai < 2; ++ai)
#pragma unroll
            for (int m = 0; m < 4; ++m) {
                bf16_t* rowp = O + (size_t)(u.pm * 256 + ai * 128 + wr * 64 + m * 16 + fr) * ldc + u.pn * 256 + wc * 32 + 8 * fq;
#pragma unroll
                for (int bj = 0; bj < 2; ++bj) {
                    f32x4 v0 = acc[ai][bj][m][0], v1 = acc[ai][bj][m][1];
                    if (ACT == 1) {
#pragma unroll
                        for (int j = 0; j < 4; ++j) { v0[j] = sigmoidf_(v0[j]); v1[j] = sigmoidf_(v1[j]); }
                    } else if (ACT == 2) {
#pragma unroll
                        for (int j = 0; j < 4; ++j) { float a = fmaxf(v0[j], 0.f), b = fmaxf(v1[j], 0.f); v0[j] = a * a; v1[j] = b * b; }
                    }
                    *(u32x4*)(rowp + bj * 128) = (u32x4){pk2(v0[0], v0[1]), pk2(v0[2], v0[3]), pk2(v1[0], v1[1]), pk2(v1[2], v1[3])};
                }
            }
    }
};

struct EpiGate {
    static constexpr bool PERM = true, HOOK = false;
    bf16_t* G;
    DI void hook(Acc&, const Unit&, int, int, int, int, int) const {}
    DI void operator()(const Acc& acc, const Unit& u, int wr, int wc, int fr, int fq) const {
#pragma unroll
        for (int ai = 0; ai < 2; ++ai)
#pragma unroll
            for (int m = 0; m < 4; ++m) {
                bf16_t* rowp = G + (size_t)(u.pm * 256 + ai * 128 + wr * 64 + m * 16 + fr) * 4096 + u.pn * 64 + 16 * wc + 4 * fq;
                float r0[4], r1[4], r2[4], g3[4];
#pragma unroll
                for (int j = 0; j < 4; ++j) {
                    const float d0 = 1.0f + __builtin_amdgcn_exp2f(-1.44269504f * acc[ai][0][m][0][j]), d1 = 1.0f + __builtin_amdgcn_exp2f(-1.44269504f * acc[ai][0][m][1][j]);
                    const float d2 = 1.0f + __builtin_amdgcn_exp2f(-1.44269504f * acc[ai][1][m][0][j]), d3 = 1.0f + __builtin_amdgcn_exp2f(-1.44269504f * acc[ai][1][m][1][j]);
                    r0[j] = d1 * __builtin_amdgcn_rcpf(d0); r1[j] = d2 * __builtin_amdgcn_rcpf(d1); r2[j] = d3 * __builtin_amdgcn_rcpf(d2); g3[j] = __builtin_amdgcn_rcpf(d3);
                }
                *(u32x2*)(rowp) = (u32x2){pk2(r0[0], r0[1]), pk2(r0[2], r0[3])};
                *(u32x2*)(rowp + 1024) = (u32x2){pk2(r1[0], r1[1]), pk2(r1[2], r1[3])};
                *(u32x2*)(rowp + 2048) = (u32x2){pk2(r2[0], r2[1]), pk2(r2[2], r2[3])};
                *(u32x2*)(rowp + 3072) = (u32x2){pk2(g3[0], g3[1]), pk2(g3[2], g3[3])};
            }
    }
};

struct EpiBranch {
    static constexpr bool PERM = true, HOOK = true;
    const bf16_t* G; bf16_t* O;
    DI void hook(Acc& acc, const Unit& u, int t, int wr, int wc, int fr_, int fq) const {
        int fr = fr_; asm volatile("" : "+v"(fr));
        const int s = (t == 6) ? 0 : (t == 14 ? 1 : 2);
#pragma unroll
        for (int ai = 0; ai < 2; ++ai) {
            u32x4 ga[4][2];
#pragma unroll
            for (int m = 0; m < 4; ++m) {
                const bf16_t* gp = G + (size_t)(u.pm * 256 + ai * 128 + wr * 64 + m * 16 + fr) * 4096 + s * 1024 + u.pn * 256 + wc * 32 + 8 * fq;
#pragma unroll
                for (int bj = 0; bj < 2; ++bj) ga[m][bj] = *(const u32x4*)(gp + bj * 128);
            }
#pragma unroll
            for (int m = 0; m < 4; ++m)
#pragma unroll
                for (int bj = 0; bj < 2; ++bj)
#pragma unroll
                    for (int q = 0; q < 4; ++q) { acc[ai][bj][m][q >> 1][(q & 1) * 2] *= bflo(ga[m][bj][q]); acc[ai][bj][m][q >> 1][(q & 1) * 2 + 1] *= bfhi(ga[m][bj][q]); }
            asm volatile("" ::: "memory");
        }
    }
    DI void operator()(const Acc& acc, const Unit& u, int wr, int wc, int fr, int fq) const {
#pragma unroll
        for (int ai = 0; ai < 2; ++ai) {
            u32x4 g[4][2];
#pragma unroll
            for (int m = 0; m < 4; ++m)
#pragma unroll
                for (int bj = 0; bj < 2; ++bj) g[m][bj] = *(const u32x4*)(G + (size_t)(u.pm * 256 + ai * 128 + wr * 64 + m * 16 + fr) * 4096 + 3072 + u.pn * 256 + wc * 32 + 8 * fq + bj * 128);
#pragma unroll
            for (int m = 0; m < 4; ++m) {
                const size_t row = (size_t)(u.pm * 256 + ai * 128 + wr * 64 + m * 16 + fr);
                const int c = u.pn * 256 + wc * 32 + 8 * fq;
#pragma unroll
                for (int bj = 0; bj < 2; ++bj) {
                    const u32x4 gg = g[m][bj];
                    const f32x4 v0 = acc[ai][bj][m][0], v1 = acc[ai][bj][m][1];
                    *(u32x4*)(O + row * 1024 + c + bj * 128) = (u32x4){pk2(v0[0] * bflo(gg[0]), v0[1] * bfhi(gg[0])), pk2(v0[2] * bflo(gg[1]), v0[3] * bfhi(gg[1])),
                                                                      pk2(v1[0] * bflo(gg[2]), v1[1] * bfhi(gg[2])), pk2(v1[2] * bflo(gg[3]), v1[3] * bfhi(gg[3]))};
                }
            }
            asm volatile("" ::: "memory");
        }
    }
};

struct EpiFourier {
    static constexpr bool PERM = true, HOOK = false;
    bf16_t* BRQ; int row0, seqlen; float scale;
    DI void hook(Acc&, const Unit&, int, int, int, int, int) const {}
    DI void operator()(const Acc& acc, const Unit& u, int wr, int wc, int fr, int fq) const {
#pragma unroll
        for (int ai = 0; ai < 2; ++ai)
#pragma unroll
            for (int m = 0; m < 4; ++m) {
                const int pos = u.pm * 256 + ai * 128 + wr * 64 + m * 16 + fr;
#pragma unroll
                for (int bj = 0; bj < 2; ++bj) {
                    const int c = u.pn * 256 + bj * 128 + wc * 32 + 8 * fq; const int b = c / 384, ch = c - b * 384;
                    const f32x4 v0 = acc[ai][bj][m][0] * scale, v1 = acc[ai][bj][m][1] * scale;
                    *(u32x4*)(BRQ + (size_t)(row0 + b * seqlen + pos) * KBR + ch) = (u32x4){pk2(v0[0], v0[1]), pk2(v0[2], v0[3]), pk2(v1[0], v1[1]), pk2(v1[2], v1[3])};
                }
            }
    }
};

struct MapId { int off; DI int operator()(int n) const { return n + off; } };
struct MapWin {
    DI static int rp(int lc) { return 16 * ((lc >> 2) & 1) + 4 * (lc >> 3) + (lc & 3); }
    DI int operator()(int n) const {
        if (n < 512) return (n & ~31) + rp(n & 31);
        if (n < 1024) return n;
        if (n < 1280) { const int i = n - 1024, bj = i >> 7, wc = (i >> 5) & 3, lc = i & 31; return wc < 2 ? 1024 + wc * 64 + 32 * bj + rp(lc) : 1152 + (wc - 2) * 64 + 32 * bj + lc; }
        if (n < 1792) { const int i = n - 1280; return 1664 + (i & ~31) + rp(i & 31); }
        if (n < 2304) { const int i = n - 1792, tile = i >> 8, ii = i & 255, bj = ii >> 7, wc = (ii >> 5) & 3, lc = ii & 31; return 2176 + (tile * 4 + wc) * 64 + 32 * bj + rp(lc); }
        if (n < 3072) return -1;
        if (n < 3840) { const int i = n - 3072, grp = i >> 5, lc = i & 31, ch = grp * 16 + 4 * (lc >> 3) + (lc & 3); return ((lc >> 2) & 1) ? 3072 + ch : 2688 + ch; }
        { const int i = n - 3840, t = i >> 8, c = i & 255, bj = c >> 7, wc = (c >> 5) & 3, lc = c & 31;
          return 3456 + (2 * bj + ((lc >> 2) & 1)) * 1024 + 64 * t + 16 * wc + 4 * (lc >> 3) + (lc & 3); }
    }
};
template <class Map>
DI void convT(LAS unsigned char* lds, const float* src, int sld, int K, bf16_t* dst, int dld, int N, const Map& map, int item0, int nblk) {
    LAS float* tile = (LAS float*)lds;
    const int tid = tid_(); const int tK = K / 128, tN = N / 64;
    for (int it = item0; it < tK * tN; it += nblk) {
        const int tn = it / tK, tk = it % tK;
        const int col = map(tn * 64 + (tid & 63));
        if (map(tn * 64) < 0) continue;
        float v[16];
#pragma unroll
        for (int p = 0; p < 16; ++p) v[p] = src[(size_t)(tk * 128 + p * 8 + (tid >> 6)) * sld + col];
#pragma unroll
        for (int p = 0; p < 16; ++p) tile[(p * 8 + (tid >> 6)) * 65 + (tid & 63)] = v[p];
        __syncthreads();
#pragma unroll
        for (int hh = 0; hh < 2; ++hh) { const int n = tid >> 3, kc = (tid & 7) + 8 * hh; float w[8];
#pragma unroll
          for (int e = 0; e < 8; ++e) w[e] = tile[(kc * 8 + e) * 65 + n];
          *(u32x4*)(dst + (size_t)(tn * 64 + n) * dld + tk * 128 + kc * 8) = (u32x4){pk2(w[0], w[1]), pk2(w[2], w[3]), pk2(w[4], w[5]), pk2(w[6], w[7])}; }
        __syncthreads();
    }
}
DI void conv_fold(LAS unsigned char* lds, const float* win, bf16_t* wint, int item0, int nblk) {
    LAS float* tile = (LAS float*)lds;
    LAS float* tab = (LAS float*)(lds + 64 * 65 * 4);
    LAS bf16_t* outb = (LAS bf16_t*)(lds + 64 * 65 * 4 + 256);
    const int tid = tid_();
    __syncthreads();
    if (tid < 64) tab[tid] = cospif((float)tid / 32.0f);
    for (int it = item0; it < 6 * 16; it += nblk) {
        const int g = it >> 4, tk = it & 15;
        __syncthreads();
#pragma unroll
        for (int p = 0; p < 8; ++p) { const int kk = p * 8 + (tid >> 6); tile[kk * 65 + (tid & 63)] = win[(size_t)(tk * 64 + kk) * IN_COLS + 1280 + g * 64 + (tid & 63)]; }
        __syncthreads();
        const int k = tid & 63, cq = tid >> 6;
        float ac[8], as[8];
#pragma unroll
        for (int e = 0; e < 8; ++e) { ac[e] = 0.f; as[e] = 0.f; }
        for (int c = 0; c < 64; ++c) {
            const float w = tile[k * 65 + c];
#pragma unroll
            for (int e = 0; e < 8; ++e) { const int idx = c * (cq * 8 + e); ac[e] += w * tab[idx & 63]; as[e] += w * tab[(idx - 16) & 63]; }
        }
#pragma unroll
        for (int e = 0; e < 8; ++e) { outb[(cq * 8 + e) * 72 + k] = (bf16_t)(pk2(ac[e], 0.f) & 0xffffu); outb[(64 + cq * 8 + e) * 72 + k] = (bf16_t)(pk2(as[e], 0.f) & 0xffffu); }
        __syncthreads();
        for (int i = tid; i < 128 * 8; i += NTHREADS) { const int rr = i >> 3, ch = i & 7; const int part = rr >> 6, cp = rr & 63;
            *(u32x4*)(wint + (size_t)(2304 + part * 384 + g * 64 + cp) * D + tk * 64 + ch * 8) = *(const LAS u32x4*)(outb + rr * 72 + ch * 8); }
    }
    __syncthreads();
}
DI void conv_win(LAS unsigned char* lds, const Ptrs& P, int l, int item0, int nblk) {
    const float* win = P.in[I_WIN] + (size_t)l * D * IN_COLS;
    convT(lds, win, IN_COLS, D, (bf16_t*)(P.ws + OFF_WINT), D, NIN, MapWin{}, item0, nblk);
    conv_fold(lds, win, (bf16_t*)(P.ws + OFF_WINT), item0, nblk);
}
DI void gen_dft(LAS unsigned char* lds, unsigned char* ws, int item0, int nblk, bool also_small) {
    const int tid = tid_();
    bf16_t* dft = (bf16_t*)(ws + A_DFT);
    for (int it = item0 * NTHREADS + tid; it < 4096 * 512; it += nblk * NTHREADS) {
        const int k = it >> 9, j0 = (it & 511) * 8;
        float v[8];
#pragma unroll
        for (int e = 0; e < 8; ++e) { const int j = j0 + e; const bool sp = j >= 2049; const float fr = (float)((k * (sp ? j - 2048 : j)) & 4095) * (1.0f / 4096.0f); v[e] = sp ? -__builtin_amdgcn_sinf(fr) : __builtin_amdgcn_cosf(fr); }
        *(u32x4*)(dft + (size_t)k * 4096 + j0) = (u32x4){pk2(v[0], v[1]), pk2(v[2], v[3]), pk2(v[4], v[5]), pk2(v[6], v[7])};
    }
    if (also_small) {
        bf16_t* dc = (bf16_t*)(ws + OFF_DFTC);
        for (int it = item0 * NTHREADS + tid; it < 256 * 64; it += nblk * NTHREADS) {
            const int k = it >> 6, j0 = (it & 63) * 8; const int part = j0 >= 256; const int t0 = j0 & 255;
            float v[8];
#pragma unroll
            for (int e = 0; e < 8; ++e) { const float fr = (float)((k * (t0 + e)) & 255) * (1.0f / 256.0f); v[e] = part ? -__builtin_amdgcn_sinf(fr) : __builtin_amdgcn_cosf(fr); }
            *(u32x4*)(dc + (size_t)k * 512 + j0) = (u32x4){pk2(v[0], v[1]), pk2(v[2], v[3]), pk2(v[4], v[5]), pk2(v[6], v[7])};
        }
    }
}
DI void fourier_fold(unsigned char* ws, int item0, int nblk) {
    const int tid = tid_();
    const bf16_t* FT = (const bf16_t*)(ws + A_FT); bf16_t* FTF = (bf16_t*)(ws + A_FTF);
    for (int it = item0 * NTHREADS + tid; it < 1536 * 1024; it += nblk * NTHREADS) {
        const int n = it >> 10, j0 = (it & 1023) * 4;
        const bf16_t* s = FT + (size_t)n * 8192;
        float o[4];
#pragma unroll
        for (int e = 0; e < 4; ++e) { const int j = j0 + e;
            if (j <= 2048) { const float a = bflo((unsigned)s[j]); o[e] = (j == 0 || j == 2048) ? a : a + bflo((unsigned)s[4096 - j]); }
            else { const int t = j - 2048; o[e] = bflo((unsigned)s[4096 + t]) - bflo((unsigned)s[8192 - t]); } }
        *(u32x2*)(FTF + (size_t)n * 4096 + j0) = (u32x2){pk2(o[0], o[1]), pk2(o[2], o[3])};
    }
}

DI void mod_gemv(LAS unsigned char* lds, const Ptrs& P, int item0, int nblk) {
    LAS float* sc = (LAS float*)lds;
    LAS float* red = (LAS float*)(lds + 20480);
    const int tid = tid_();
    __syncthreads();
    for (int i = tid; i < 5 * 1024; i += NTHREADS) { const float v = i < 4096 ? P.in[I_C][i] : P.in[I_CCTX][i - 4096]; sc[i] = v * sigmoidf_(v); }
    __syncthreads();
    float* MOD = (float*)(P.ws + OFF_MOD);
    for (int it = item0; it < 2 * 192; it += nblk) {
        const int l = it / 192, cg32 = it % 192; const int kg = tid >> 5, cl = tid & 31;
        const float* w = P.in[I_WMOD] + (size_t)l * D * 6144 + cg32 * 32 + cl;
        float a[5] = {0.f, 0.f, 0.f, 0.f, 0.f};
        for (int k = kg * 64; k < kg * 64 + 64; ++k) { const float wv = w[(size_t)k * 6144];
#pragma unroll
            for (int r = 0; r < 5; ++r) a[r] += sc[r * 1024 + k] * wv; }
#pragma unroll
        for (int r = 0; r < 5; ++r) red[(kg * 5 + r) * 32 + cl] = a[r];
        __syncthreads();
        if (tid < 160) { const int r = tid >> 5; float s = 0.f;
#pragma unroll
            for (int g = 0; g < 16; ++g) s += red[(g * 5 + r) * 32 + cl];
            MOD[((size_t)l * 5 + r) * 6144 + cg32 * 32 + cl] = s + P.in[I_BMOD][l * 6144 + cg32 * 32 + cl]; }
        __syncthreads();
    }
}

DI void row_mod_store(const f32x4 (&x)[4], float rstd, const float* gain, const float* shift, const float* scale, bf16_t* hrow, int lane) {
#pragma unroll
    for (int i = 0; i < 4; ++i) { const int c = lane * 4 + 256 * i;
        const f32x4 g = *(const f32x4*)(gain + c), sh = *(const f32x4*)(shift + c), sc = *(const f32x4*)(scale + c);
        float o[4];
#pragma unroll
        for (int j = 0; j < 4; ++j) o[j] = x[i][j] * rstd * g[j] * (1.f + sc[j]) + sh[j];
        *(u32x2*)(hrow + c) = (u32x2){pk2(o[0], o[1]), pk2(o[2], o[3])}; }
}
DI float row_rstd(const f32x4 (&x)[4]) {
    float s = 0.f;
#pragma unroll
    for (int i = 0; i < 4; ++i) s += x[i][0] * x[i][0] + x[i][1] * x[i][1] + x[i][2] * x[i][2] + x[i][3] * x[i][3];
    s = wave_sum(s);
    return __builtin_amdgcn_rsqf(s * (1.0f / 1024.0f) + EPS);
}
DI void rows_first(const Ptrs& P) {
    const int tid = tid_(); const int lane = tid & 63, wv = tid >> 6;
    const float* MOD = (const float*)(P.ws + OFF_MOD);
    for (int row = blockIdx.x * 8 + wv; row < MTOT; row += gridDim.x * 8) {
        const float* xr = row < MLAT ? P.in[I_X] + (size_t)row * D : P.in[I_CTX] + (size_t)(row - MLAT) * D;
        const int mr = row < MLAT ? (row >> 12) : 4;
        f32x4 x[4];
#pragma unroll
        for (int i = 0; i < 4; ++i) x[i] = *(const f32x4*)(xr + lane * 4 + 256 * i);
        const float rstd = row_rstd(x);
        const float* mod = MOD + (size_t)mr * 6144;
        row_mod_store(x, rstd, P.in[I_GPREMIX], mod, mod + 1024, (bf16_t*)(P.ws + OFF_HS) + (size_t)row * D, lane);
    }
}
DI void rows_update(const Ptrs& P, int l, int which  , int nrows) {
    const int tid = tid_(); const int lane = tid & 63, wv = tid >> 6;
    const float* MOD = (const float*)(P.ws + OFF_MOD);
    const bf16_t* Y = (const bf16_t*)(P.ws + A_MIXO);
    const float* gpost = P.in[which ? I_GPOSTMLP : I_GPOSTMIX] + l * D;
    const bool do_h = (which == 0) || (l == 0);
    const int ln = which ? l + 1 : l;
    const float* gnext = which ? P.in[I_GPREMIX] + (do_h ? ln : 0) * D : P.in[I_GPREMLP] + l * D;
    for (int row = blockIdx.x * 8 + wv; row < nrows; row += gridDim.x * 8) {
        const bool lat = row < MLAT;
        const float* xin = lat ? ((l == 0 && which == 0) ? P.in[I_X] + (size_t)row * D : P.out + (size_t)row * D)
                               : ((which == 0) ? P.in[I_CTX] + (size_t)(row - MLAT) * D : (const float*)(P.ws + A_XC) + (size_t)(row - MLAT) * D);
        float* xout = lat ? P.out + (size_t)row * D : (float*)(P.ws + A_XC) + (size_t)(row - MLAT) * D;
        const int mr = lat ? (row >> 12) : 4;
        const float* mod = MOD + ((size_t)l * 5 + mr) * 6144;
        const float* gate = mod + (which ? 5 : 2) * 1024;
        f32x4 x[4], y[4];
#pragma unroll
        for (int i = 0; i < 4; ++i) { x[i] = *(const f32x4*)(xin + lane * 4 + 256 * i);
            const u32x2 yb = *(const u32x2*)(Y + (size_t)row * D + lane * 4 + 256 * i); y[i] = (f32x4){bflo(yb[0]), bfhi(yb[0]), bflo(yb[1]), bfhi(yb[1])}; }
        const float ry = row_rstd(y);
#pragma unroll
        for (int i = 0; i < 4; ++i) { const int c = lane * 4 + 256 * i; const f32x4 gp = *(const f32x4*)(gpost + c), gt = *(const f32x4*)(gate + c);
#pragma unroll
            for (int j = 0; j < 4; ++j) x[i][j] += gt[j] * (y[i][j] * ry * gp[j]);
            *(f32x4*)(xout + c) = x[i]; }
        if (do_h) {
            const float rx = row_rstd(x);
            const float* modn = MOD + ((size_t)ln * 5 + mr) * 6144;
            const float* shiftn = which ? modn : modn + 3 * 1024; const float* scalen = which ? modn + 1024 : modn + 4 * 1024;
            row_mod_store(x, rx, gnext, shiftn, scalen, (bf16_t*)(P.ws + OFF_HS) + (size_t)row * D, lane);
        }
    }
}

constexpr int AK_PITCH = 144;
constexpr int AK_BUF = 64 * AK_PITCH;
constexpr int AV_OFF = 2 * AK_BUF;
#define ATT_BAR() do { __builtin_amdgcn_sched_barrier(0); asm volatile("s_waitcnt lgkmcnt(0)" ::: "memory"); __builtin_amdgcn_s_barrier(); asm volatile("" ::: "memory"); __builtin_amdgcn_sched_barrier(0); } while (0)
DI float max3_(float a, float b, float c) { float d; asm("v_max3_f32 %0, %1, %2, %3" : "=v"(d) : "v"(a), "v"(b), "v"(c)); return d; }
template <int NMB, bool NOMAX = false>
DI void flash_pass(LAS unsigned char* lds, const bf16x8 (&qf)[4], const bf16_t* Kg, int ldk, const bf16_t* Vg, int ldv, int ntiles, f32x16 (&O)[NMB], float& lsum) {
    constexpr int VP = NMB == 4 ? 320 : 192;
    constexpr int VBUF = 64 * VP;
    constexpr int VCH = NMB * 4;
    constexpr int VPT = NMB / 2;
    const int tid = tid_(), lane = tid & 63, g = __builtin_amdgcn_readfirstlane(tid >> 8);
    const int r = lane & 31, h = lane >> 5, i16 = lane & 15, q4 = i16 >> 2, p4 = i16 & 3, blk = (lane >> 4) & 1;
    const int kkey = tid >> 3, kch = tid & 7;
    const unsigned kwoff = kkey * AK_PITCH + kch * 16;
    const unsigned vrd = (4 * h + q4) * VP + 32 * blk + 8 * p4;
    const unsigned krd = r * AK_PITCH + 16 * h;
    const bf16_t* kgp = Kg + (size_t)kkey * ldk + kch * 8;
    const unsigned vwoff0 = (tid / VCH) * VP + (tid % VCH) * 16; const bf16_t* vgp0 = Vg + (size_t)(tid / VCH) * ldv + (tid % VCH) * 8;
    constexpr int VKS = NTHREADS / VCH;
#define vwoff_(p) (vwoff0 + (p) * VKS * VP)
#define vgp_(p) (vgp0 + (size_t)(p) * VKS * ldv)
    float m_run = -1e30f; lsum = 0.f;
#pragma unroll
    for (int mb = 0; mb < NMB; ++mb)
#pragma unroll
        for (int i = 0; i < 16; ++i) O[mb][i] = 0.f;
    u32x4 kreg, vreg[VPT];
    {
        const u32x4 k0 = *(const u32x4*)kgp, k1 = *(const u32x4*)(kgp + (size_t)64 * ldk);
#pragma unroll
        for (int p = 0; p < VPT; ++p) vreg[p] = *(const u32x4*)vgp_(p);
        __syncthreads();
        *(LAS u32x4*)(lds + kwoff) = k0; *(LAS u32x4*)(lds + AK_BUF + kwoff) = k1;
#pragma unroll
        for (int p = 0; p < VPT; ++p) *(LAS u32x4*)(lds + AV_OFF + vwoff_(p)) = vreg[p];
    }
    __syncthreads();
    kreg = *(const u32x4*)(kgp + (size_t)(ntiles > 2 ? 128 : 0) * ldk);
#pragma unroll
    for (int p = 0; p < VPT; ++p) vreg[p] = *(const u32x4*)(vgp_(p) + (size_t)64 * ldv);
    f32x16 S0, S1;
#pragma unroll
    for (int i = 0; i < 16; ++i) { S0[i] = 0.f; S1[i] = 0.f; }
#pragma unroll
    for (int c = 0; c < 4; ++c) {
        const bf16x8 a0 = *(const LAS bf16x8*)(lds + krd + 32 * c);
        const bf16x8 a1 = *(const LAS bf16x8*)(lds + krd + 32 * AK_PITCH + 32 * c);
        S0 = __builtin_amdgcn_mfma_f32_32x32x16_bf16(a0, qf[c], S0, 0, 0, 0);
        S1 = __builtin_amdgcn_mfma_f32_32x32x16_bf16(a1, qf[c], S1, 0, 0, 0);
    }
    if (g == 1) ATT_BAR();
    for (int t = 0; t < ntiles; ++t) {
        const int sv = t + g;
        if (sv >= 1) {
            if (sv < ntiles) {
#pragma unroll
                for (int p = 0; p < VPT; ++p) *(LAS u32x4*)(lds + AV_OFF + (sv & 1) * VBUF + vwoff_(p)) = vreg[p]; }
            if (sv + 1 < ntiles) *(LAS u32x4*)(lds + ((sv + 1) & 1) * AK_BUF + kwoff) = kreg;
        }
        if (sv + 1 < ntiles) {
#pragma unroll
            for (int p = 0; p < VPT; ++p) vreg[p] = *(const u32x4*)(vgp_(p) + (size_t)(sv + 1) * 64 * ldv); }
        if (sv + 2 < ntiles) kreg = *(const u32x4*)(kgp + (size_t)(sv + 2) * 64 * ldk);
        if constexpr (!NOMAX) {
        float mx = max3_(S0[0], S1[0], S0[1]), mx2 = max3_(S1[1], S0[2], S1[2]);
#pragma unroll
        for (int i = 3; i < 15; i += 2) { mx = max3_(mx, S0[i], S1[i]); mx2 = max3_(mx2, S0[i + 1], S1[i + 1]); }
        mx = max3_(mx, S0[15], S1[15]);
        mx = max3_(mx, mx2, mx2);
        { const u32x2 sw = __builtin_amdgcn_permlane32_swap(__float_as_uint(mx), __float_as_uint(mx), false, false);
          mx = max3_(__uint_as_float(sw[0]), __uint_as_float(sw[1]), m_run); }
        const float m_new = mx;
        if (__builtin_amdgcn_ballot_w64(m_new > m_run) != 0ull) {
            const float alpha = __builtin_amdgcn_exp2f(m_run - m_new);
            lsum *= alpha;
#pragma unroll
            for (int mb = 0; mb < NMB; ++mb)
#pragma unroll
                for (int i = 0; i < 16; ++i) O[mb][i] *= alpha;
            m_run = m_new;
        }
        }
#pragma unroll
        for (int i = 0; i < 16; ++i) { if constexpr (NOMAX) { S0[i] = __builtin_amdgcn_exp2f(S0[i]); S1[i] = __builtin_amdgcn_exp2f(S1[i]); } else { S0[i] = __builtin_amdgcn_exp2f(S0[i] - m_run); S1[i] = __builtin_amdgcn_exp2f(S1[i] - m_run); } }
        f32x2 ps2 = (f32x2){0.f, 0.f};
#pragma unroll
        for (int i = 0; i < 8; ++i) { ps2 += (f32x2){S0[2 * i], S0[2 * i + 1]}; ps2 += (f32x2){S1[2 * i], S1[2 * i + 1]}; }
        lsum += ps2.x + ps2.y;
        bf16x8 pf[4];
#pragma unroll
        for (int cp = 0; cp < 2; ++cp) {
            u32x4 w0, w1;
#pragma unroll
            for (int q = 0; q < 4; ++q) { w0[q] = pk2(S0[8 * cp + 2 * q], S0[8 * cp + 2 * q + 1]); w1[q] = pk2(S1[8 * cp + 2 * q], S1[8 * cp + 2 * q + 1]); }
            pf[cp] = __builtin_bit_cast(bf16x8, w0); pf[2 + cp] = __builtin_bit_cast(bf16x8, w1);
        }
        ATT_BAR();
        {
            const LAS unsigned char* Vb = lds + AV_OFF + (t & 1) * VBUF + vrd;
            const LAS unsigned char* Kb = lds + ((t + 1) & 1) * AK_BUF + krd;
            const bool qk = t + 1 < ntiles;
            bf16x8 kf[8], va[NMB], vb[NMB];
#define ATT_LDV(dst, kc) do { _Pragma("unroll") for (int mb = 0; mb < NMB; ++mb) { \
                const s16x4 lo_ = __builtin_amdgcn_ds_read_tr16_b64_v4i16((LAS s16x4*)(Vb + (16 * (kc)) * VP + 64 * mb)); \
                const s16x4 hi_ = __builtin_amdgcn_ds_read_tr16_b64_v4i16((LAS s16x4*)(Vb + (16 * (kc) + 8) * VP + 64 * mb)); \
                dst[mb] = __builtin_shufflevector(lo_, hi_, 0, 1, 2, 3, 4, 5, 6, 7); } } while (0)
#define ATT_PV(srcv, kc) do { _Pragma("unroll") for (int mb = 0; mb < NMB; ++mb) O[mb] = __builtin_amdgcn_mfma_f32_32x32x16_bf16(srcv[mb], pf[kc], O[mb], 0, 0, 0); } while (0)
            if (qk) {
#pragma unroll
                for (int c = 0; c < 4; ++c) { kf[2 * c] = *(const LAS bf16x8*)(Kb + 32 * c); kf[2 * c + 1] = *(const LAS bf16x8*)(Kb + 32 * AK_PITCH + 32 * c); }
            }
            ATT_LDV(va, 0);
            __builtin_amdgcn_sched_barrier(0);
            if (qk) {
#pragma unroll
                for (int i = 0; i < 16; ++i) { S0[i] = 0.f; S1[i] = 0.f; }
#pragma unroll
                for (int c = 0; c < 4; ++c) {
                    S0 = __builtin_amdgcn_mfma_f32_32x32x16_bf16(kf[2 * c], qf[c], S0, 0, 0, 0);
                    S1 = __builtin_amdgcn_mfma_f32_32x32x16_bf16(kf[2 * c + 1], qf[c], S1, 0, 0, 0);
                }
            }
            ATT_LDV(vb, 1);
            __builtin_amdgcn_sched_barrier(0);
            ATT_PV(va, 0);
            ATT_LDV(va, 2);
            __builtin_amdgcn_sched_barrier(0);
            ATT_PV(vb, 1);
            ATT_LDV(vb, 3);
            __builtin_amdgcn_sched_barrier(0);
            ATT_PV(va, 2);
            ATT_PV(vb, 3);
#undef ATT_LDV
#undef ATT_PV
        }
        ATT_BAR();
    }
    if (g == 0) ATT_BAR();
    lsum = add_x32(lsum);
}
#undef vwoff_
#undef vgp_

DI void diff_unit(LAS unsigned char* lds, const Ptrs& P, int l, int b, int hd, int qrow0, int key0, int ntiles, float lam, float lam_init) {
    const int tid = tid_(); const int lane = tid & 63, wv = tid >> 6, r = lane & 31, h = lane >> 5;
    bf16_t* BRQ = (bf16_t*)(P.ws + A_BRQ);
    const bf16_t* DK = (const bf16_t*)(P.ws + A_DK) + (size_t)(b * LKV + key0) * 512 + hd * 128;
    const bf16_t* DV = (const bf16_t*)(P.ws + A_DV) + (size_t)(b * LKV + key0) * 512 + hd * 128;
    bf16_t* qp = BRQ + (size_t)(qrow0 + wv * 32 + r) * KBR + 384 + hd * 128;
    bf16x8 q0[4], q1[4];
#pragma unroll
    for (int c = 0; c < 4; ++c) { q0[c] = *(const bf16x8*)(qp + 16 * c + 8 * h); q1[c] = *(const bf16x8*)(qp + 64 + 16 * c + 8 * h); }
    f32x16 O[4]; float l0;
    const unsigned* nrm = (const unsigned*)(P.ws + OFF_CTL) + 32 + 2 * l;
    const float bnd = 2.04f * sqrtf(__uint_as_float(__hip_atomic_load(nrm, __ATOMIC_RELAXED, __HIP_MEMORY_SCOPE_AGENT)) * __uint_as_float(__hip_atomic_load(nrm + 1, __ATOMIC_RELAXED, __HIP_MEMORY_SCOPE_AGENT)));
    const bool small = __builtin_amdgcn_readfirstlane((int)(bnd < 60.0f)) != 0;
    if (small) flash_pass<4, true>(lds, q0, DK, 512, DV, 512, ntiles, O, l0); else
    flash_pass<4>(lds, q0, DK, 512, DV, 512, ntiles, O, l0);
    { const float inv = 1.0f / l0;
#pragma unroll
      for (int mb = 0; mb < 4; ++mb)
#pragma unroll
          for (int g = 0; g < 4; ++g) { const int dv = 32 * mb + 8 * g + 4 * h;
              *(u32x2*)(qp + dv) = (u32x2){pk2(O[mb][4 * g] * inv, O[mb][4 * g + 1] * inv), pk2(O[mb][4 * g + 2] * inv, O[mb][4 * g + 3] * inv)}; } }
    if (small) flash_pass<4, true>(lds, q1, DK + 64, 512, DV, 512, ntiles, O, l0); else
    flash_pass<4>(lds, q1, DK + 64, 512, DV, 512, ntiles, O, l0);
    { const float s1 = lam / l0; float ss = 0.f;
#pragma unroll
      for (int mb = 0; mb < 4; ++mb)
#pragma unroll
          for (int g = 0; g < 4; ++g) { const int dv = 32 * mb + 8 * g + 4 * h; const u32x2 o0 = *(const u32x2*)(qp + dv);
              const float a0 = bflo(o0[0]) - s1 * O[mb][4 * g], a1 = bfhi(o0[0]) - s1 * O[mb][4 * g + 1], a2 = bflo(o0[1]) - s1 * O[mb][4 * g + 2], a3 = bfhi(o0[1]) - s1 * O[mb][4 * g + 3];
              O[mb][4 * g] = a0; O[mb][4 * g + 1] = a1; O[mb][4 * g + 2] = a2; O[mb][4 * g + 3] = a3; ss += a0 * a0 + a1 * a1 + a2 * a2 + a3 * a3; }
      ss = add_x32(ss);
      const float rs = __builtin_amdgcn_rsqf(ss * (1.0f / 128.0f) + EPS) * (1.0f - lam_init);
      const float* sg = P.in[I_SUBLN] + l * 128;
#pragma unroll
      for (int mb = 0; mb < 4; ++mb)
#pragma unroll
          for (int g = 0; g < 4; ++g) { const int dv = 32 * mb + 8 * g + 4 * h; const f32x4 gg = *(const f32x4*)(sg + dv);
              *(u32x2*)(qp + dv) = (u32x2){pk2(O[mb][4 * g] * rs * gg[0], O[mb][4 * g + 1] * rs * gg[1]), pk2(O[mb][4 * g + 2] * rs * gg[2], O[mb][4 * g + 3] * rs * gg[3])}; }
    }
}
DI void gqa_unit(LAS unsigned char* lds, const Ptrs& P, int l, int b, int qh, int qrow0, int key0, int ntiles) {
    const int tid = tid_(); const int lane = tid & 63, wv = tid >> 6, r = lane & 31, h = lane >> 5;
    bf16_t* BRQ = (bf16_t*)(P.ws + A_BRQ);
    const int kvh = qh >> 2;
    const bf16_t* GK = (const bf16_t*)(P.ws + A_GK) + (size_t)(b * LKV + key0) * 128 + kvh * 64;
    const bf16_t* GV = (const bf16_t*)(P.ws + A_GV) + (size_t)(b * LKV + key0) * 128 + kvh * 64;
    bf16_t* qp = BRQ + (size_t)(qrow0 + wv * 32 + r) * KBR + 896 + qh * 64;
    bf16x8 q0[4];
#pragma unroll
    for (int c = 0; c < 4; ++c) q0[c] = *(const bf16x8*)(qp + 16 * c + 8 * h);
    f32x16 O[2]; float l0;
    float mq = fabsf(P.in[I_QNORM][l * 64 + lane]), mk = fabsf(P.in[I_KNORM][l * 64 + lane]);
    mq = wave_max(mq); mk = wave_max(mk);
    const bool small = __builtin_amdgcn_readfirstlane((int)(64.0f * QSCALE * 1.02f * mq * mk < 60.0f)) != 0;
    if (small) flash_pass<2, true>(lds, q0, GK, 128, GV, 128, ntiles, O, l0);
    else flash_pass<2, false>(lds, q0, GK, 128, GV, 128, ntiles, O, l0);
    const float inv = 1.0f / l0;
#pragma unroll
    for (int mb = 0; mb < 2; ++mb)
#pragma unroll
        for (int g = 0; g < 4; ++g) { const int dv = 32 * mb + 8 * g + 4 * h;
            *(u32x2*)(qp + dv) = (u32x2){pk2(O[mb][4 * g] * inv, O[mb][4 * g + 1] * inv), pk2(O[mb][4 * g + 2] * inv, O[mb][4 * g + 3] * inv)}; }
}

DI void gqa_pair_pass(LAS unsigned char* lds, const bf16x8 (&qf)[2][4], const bf16_t* Kg, const bf16_t* Vg, int ntiles, f32x16 (&O)[2][2], float (&lsum)[2]) {
    constexpr int VP = 192, VBUF = 64 * VP;
    const int tid = tid_(), lane = tid & 63;
    const int r = lane & 31, h = lane >> 5, i16 = lane & 15, q4 = i16 >> 2, p4 = i16 & 3, blk = (lane >> 4) & 1;
    const int kkey = tid >> 3, kch = tid & 7;
    const unsigned kwoff = kkey * AK_PITCH + kch * 16, vwoff = kkey * VP + kch * 16;
    const unsigned vrd = (4 * h + q4) * VP + 32 * blk + 8 * p4, krd = r * AK_PITCH + 16 * h;
    const bf16_t* kgp = Kg + (size_t)kkey * 128 + kch * 8; const bf16_t* vgp = Vg + (size_t)kkey * 128 + kch * 8;
#pragma unroll
    for (int hh = 0; hh < 2; ++hh) { lsum[hh] = 0.f;
#pragma unroll
        for (int mb = 0; mb < 2; ++mb)
#pragma unroll
            for (int i = 0; i < 16; ++i) O[hh][mb][i] = 0.f; }
    u32x4 kreg = *(const u32x4*)kgp, vreg = *(const u32x4*)vgp;
    __syncthreads();
    *(LAS u32x4*)(lds + kwoff) = kreg; *(LAS u32x4*)(lds + AV_OFF + vwoff) = vreg;
    kreg = *(const u32x4*)(kgp + (size_t)64 * 128); vreg = *(const u32x4*)(vgp + (size_t)64 * 128);
    __syncthreads();
    for (int t = 0; t < ntiles; ++t) {
        if (t + 1 < ntiles) { *(LAS u32x4*)(lds + ((t + 1) & 1) * AK_BUF + kwoff) = kreg; *(LAS u32x4*)(lds + AV_OFF + ((t + 1) & 1) * VBUF + vwoff) = vreg; }
        if (t + 2 < ntiles) { kreg = *(const u32x4*)(kgp + (size_t)(t + 2) * 64 * 128); vreg = *(const u32x4*)(vgp + (size_t)(t + 2) * 64 * 128); }
        const LAS unsigned char* Kb = lds + (t & 1) * AK_BUF + krd;
        const LAS unsigned char* Vb = lds + AV_OFF + (t & 1) * VBUF + vrd;
        f32x16 S[2][2];
#pragma unroll
        for (int hh = 0; hh < 2; ++hh)
#pragma unroll
            for (int kb = 0; kb < 2; ++kb)
#pragma unroll
                for (int i = 0; i < 16; ++i) S[hh][kb][i] = 0.f;
#pragma unroll
        for (int cg2 = 0; cg2 < 2; ++cg2) {
            bf16x8 kf[4];
#pragma unroll
            for (int cc = 0; cc < 2; ++cc) { const int c = 2 * cg2 + cc; kf[2 * cc] = *(const LAS bf16x8*)(Kb + 32 * c); kf[2 * cc + 1] = *(const LAS bf16x8*)(Kb + 32 * AK_PITCH + 32 * c); }
#pragma unroll
            for (int cc = 0; cc < 2; ++cc)
#pragma unroll
                for (int hh = 0; hh < 2; ++hh) {
                    S[hh][0] = __builtin_amdgcn_mfma_f32_32x32x16_bf16(kf[2 * cc], qf[hh][2 * cg2 + cc], S[hh][0], 0, 0, 0);
                    S[hh][1] = __builtin_amdgcn_mfma_f32_32x32x16_bf16(kf[2 * cc + 1], qf[hh][2 * cg2 + cc], S[hh][1], 0, 0, 0);
                }
            __builtin_amdgcn_sched_barrier(0);
        }
        __builtin_amdgcn_sched_barrier(0);
        bf16x8 pf[2][4];
#pragma unroll
        for (int hh = 0; hh < 2; ++hh) {
#pragma unroll
            for (int i = 0; i < 16; ++i) { S[hh][0][i] = __builtin_amdgcn_exp2f(S[hh][0][i]); S[hh][1][i] = __builtin_amdgcn_exp2f(S[hh][1][i]); }
            f32x2 ps2 = (f32x2){0.f, 0.f};
#pragma unroll
            for (int i = 0; i < 8; ++i) { ps2 += (f32x2){S[hh][0][2 * i], S[hh][0][2 * i + 1]}; ps2 += (f32x2){S[hh][1][2 * i], S[hh][1][2 * i + 1]}; }
            lsum[hh] += ps2.x + ps2.y;
#pragma unroll
            for (int cp = 0; cp < 2; ++cp) {
                u32x4 w0, w1;
#pragma unroll
                for (int q = 0; q < 4; ++q) { w0[q] = pk2(S[hh][0][8 * cp + 2 * q], S[hh][0][8 * cp + 2 * q + 1]); w1[q] = pk2(S[hh][1][8 * cp + 2 * q], S[hh][1][8 * cp + 2 * q + 1]); }
                pf[hh][cp] = __builtin_bit_cast(bf16x8, w0); pf[hh][2 + cp] = __builtin_bit_cast(bf16x8, w1);
            }
        }
        __builtin_amdgcn_sched_barrier(0);
#pragma unroll
        for (int kc = 0; kc < 4; ++kc)
#pragma unroll
            for (int mb = 0; mb < 2; ++mb) {
                const s16x4 lo = __builtin_amdgcn_ds_read_tr16_b64_v4i16((LAS s16x4*)(Vb + (16 * kc) * VP + 64 * mb));
                const s16x4 hi = __builtin_amdgcn_ds_read_tr16_b64_v4i16((LAS s16x4*)(Vb + (16 * kc + 8) * VP + 64 * mb));
                const bf16x8 a = __builtin_shufflevector(lo, hi, 0, 1, 2, 3, 4, 5, 6, 7);
#pragma unroll
                for (int hh = 0; hh < 2; ++hh) O[hh][mb] = __builtin_amdgcn_mfma_f32_32x32x16_bf16(a, pf[hh][kc], O[hh][mb], 0, 0, 0);
            }
        ATT_BAR();
    }
#pragma unroll
    for (int hh = 0; hh < 2; ++hh) lsum[hh] = add_x32(lsum[hh]);
}
DI void gqa_pair_unit(LAS unsigned char* lds, const Ptrs& P, int l, int b, int qh, int qrow0, int key0, int ntiles) {
    const int tid = tid_(); const int lane = tid & 63, wv = tid >> 6, r = lane & 31, h = lane >> 5;
    bf16_t* BRQ = (bf16_t*)(P.ws + A_BRQ);
    const int kvh = qh >> 2;
    const bf16_t* GK = (const bf16_t*)(P.ws + A_GK) + (size_t)(b * LKV + key0) * 128 + kvh * 64;
    const bf16_t* GV = (const bf16_t*)(P.ws + A_GV) + (size_t)(b * LKV + key0) * 128 + kvh * 64;
    bf16_t* qp = BRQ + (size_t)(qrow0 + wv * 32 + r) * KBR + 896 + qh * 64;
    bf16x8 qf[2][4];
#pragma unroll
    for (int hh = 0; hh < 2; ++hh)
#pragma unroll
        for (int c = 0; c < 4; ++c) qf[hh][c] = *(const bf16x8*)(qp + hh * 64 + 16 * c + 8 * h);
    f32x16 O[2][2]; float ls[2];
    gqa_pair_pass(lds, qf, GK, GV, ntiles, O, ls);
#pragma unroll
    for (int hh = 0; hh < 2; ++hh) { const float inv = 1.0f / ls[hh];
#pragma unroll
        for (int mb = 0; mb < 2; ++mb)
#pragma unroll
            for (int g = 0; g < 4; ++g) { const int dv = 32 * mb + 8 * g + 4 * h;
                *(u32x2*)(qp + hh * 64 + dv) = (u32x2){pk2(O[hh][mb][4 * g] * inv, O[hh][mb][4 * g + 1] * inv), pk2(O[hh][mb][4 * g + 2] * inv, O[hh][mb][4 * g + 3] * inv)}; } }
}

DI void conv_unit(LAS unsigned char* lds, const Ptrs& P, int l, int m0, int s0, int Ls) {
    const int tid = tid_(), lane = tid & 63, wv = tid >> 6;
    LAS bf16_t* vs = (LAS bf16_t*)lds;
    LAS float* wsm = (LAS float*)(lds + 94 * 384 * 2);
    const bf16_t* V = (const bf16_t*)(P.ws + A_V);
    __syncthreads();
    for (int idx = tid; idx < 94 * 48; idx += NTHREADS) { const int rr = idx / 48, ch = idx % 48; const int row = m0 - 15 + rr;
        u32x4 v = (u32x4){0u, 0u, 0u, 0u};
        if (row >= s0 && row < s0 + Ls) v = *(const u32x4*)(V + (size_t)row * 384 + ch * 8);
        *(LAS u32x4*)(vs + rr * 384 + ch * 8) = v; }
    const float* dw = P.in[I_CONVDW] + (size_t)l * 31 * 384;
    for (int idx = tid; idx < 31 * 384; idx += NTHREADS) wsm[idx] = dw[idx];
    __syncthreads();
    const float* bias = P.in[I_CONVB] + l * 384; const float* lg = P.in[I_CONVLNG] + l * 384; const float* lb = P.in[I_CONVLNB] + l * 384;
    const int c0 = lane * 6;
    bf16_t* BRQ = (bf16_t*)(P.ws + A_BRQ);
    float a[8][6];
#pragma unroll
    for (int tt = 0; tt < 8; ++tt)
#pragma unroll
        for (int c = 0; c < 6; ++c) a[tt][c] = bias[c0 + c];
    const LAS bf16_t* vbase = vs + (wv * 8) * 384 + c0;
#pragma unroll 1
    for (int j = 0; j < 31; ++j) {
        const LAS float* wp = wsm + j * 384 + c0;
        const f32x2 w01 = *(const LAS f32x2*)wp, w23 = *(const LAS f32x2*)(wp + 2), w45 = *(const LAS f32x2*)(wp + 4);
#pragma unroll
        for (int tt = 0; tt < 8; ++tt) {
            const LAS unsigned* vp = (const LAS unsigned*)(vbase + (tt + j) * 384);
            const unsigned v0 = vp[0], v1 = vp[1], v2 = vp[2];
            a[tt][0] += w01.x * bflo(v0); a[tt][1] += w01.y * bfhi(v0); a[tt][2] += w23.x * bflo(v1); a[tt][3] += w23.y * bfhi(v1); a[tt][4] += w45.x * bflo(v2); a[tt][5] += w45.y * bfhi(v2);
        }
    }
    float lgv[6], lbv[6];
#pragma unroll
    for (int c = 0; c < 6; ++c) { lgv[c] = lg[c0 + c]; lbv[c] = lb[c0 + c]; }
#pragma unroll
    for (int tt = 0; tt < 8; ++tt) {
        float s = a[tt][0] + a[tt][1] + a[tt][2] + a[tt][3] + a[tt][4] + a[tt][5];
        s = wave_sum(s);
        const float mu = s * (1.0f / 384.0f);
        float q = 0.f;
#pragma unroll
        for (int c = 0; c < 6; ++c) { const float d = a[tt][c] - mu; q += d * d; }
        q = wave_sum(q);
        const float rs = __builtin_amdgcn_rsqf(q * (1.0f / 384.0f) + EPS);
        float o[6];
#pragma unroll
        for (int c = 0; c < 6; ++c) { const float y = (a[tt][c] - mu) * rs * lgv[c] + lbv[c]; o[c] = y * sigmoidf_(y); }
        unsigned* dst = (unsigned*)(BRQ + (size_t)(m0 + wv * 8 + tt) * KBR + 1408 + c0);
        dst[0] = pk2(o[0], o[1]); dst[1] = pk2(o[2], o[3]); dst[2] = pk2(o[4], o[5]);
    }
}


#define XB_TMO      128
#define XB_XCNT(j)  (256  + 64 * (j))
#define XB_XSUB(j)  (1280 + 64 * (j))
#define XB_XGEN(j)  (2304 + 64 * (j))
#define XB_TOP      3328
#define XB_TOPGEN   3392
#define XCD_BAR_WORDS 3456
#define XB_SPIN_CAP (1u << 20)
DI unsigned xb_ld(unsigned* p)              { return __hip_atomic_load(p, __ATOMIC_RELAXED, __HIP_MEMORY_SCOPE_AGENT); }
DI unsigned xb_add(unsigned* p, unsigned v) { return __hip_atomic_fetch_add(p, v, __ATOMIC_RELAXED, __HIP_MEMORY_SCOPE_AGENT); }
DI unsigned xb_xcc_id() { return (unsigned)__builtin_amdgcn_s_getreg((3 << 11) | 20) & 0xFu; }
#define XB_SPIN(cond, bar) do { unsigned _sp = 0; while (cond) { __builtin_amdgcn_s_sleep(1); \
    if ((++_sp & 255u) == 0u) { if (xb_ld(&(bar)[XB_TMO])) break; if (_sp > XB_SPIN_CAP) { atomicAdd(&(bar)[XB_TMO], 1u); break; } } } } while (0)
struct XcdBarrier { unsigned* bar; unsigned x; volatile LAS unsigned* st; };
DI XcdBarrier xcd_barrier_post(unsigned* bar, volatile LAS unsigned* st) {
    XcdBarrier b; b.bar = bar; b.x = xb_xcc_id(); b.st = st;
    if (threadIdx.x == 0) (void)xb_add(&bar[XB_XCNT(b.x)], 1u);
    return b;
}
DI void xcd_barrier_complete(unsigned* bar, unsigned x, unsigned& nloc, unsigned& nx) {
    const unsigned G = gridDim.x * gridDim.y * gridDim.z;
    unsigned sum, cnt, mine, sp = 0u;
    for (;;) {
        sum = 0u; cnt = 0u; mine = 0u;
#pragma unroll
        for (unsigned j = 0; j < 16; ++j) { const unsigned c = xb_ld(&bar[XB_XCNT(j)]); sum += c; cnt += (c > 0u) ? 1u : 0u; mine = (j == x) ? c : mine; }
        if (sum == G) break;
        __builtin_amdgcn_s_sleep(1);
        if ((++sp & 255u) == 0u) { if (xb_ld(&bar[XB_TMO])) break; if (sp > XB_SPIN_CAP) { atomicAdd(&bar[XB_TMO], 1u); break; } }
    }
    nloc = mine > 0u ? mine : 1u; nx = cnt > 0u ? cnt : 1u;
}
DI void xcd_barrier(const XcdBarrier& b) {
    asm volatile("s_waitcnt vmcnt(0)" ::: "memory");
    __syncthreads();
    if (threadIdx.x == 0) {
        unsigned* bar = b.bar;
        __builtin_amdgcn_s_waitcnt(0);
        unsigned nloc = b.st[0], nx = b.st[1];
        if (nloc == 0u) { xcd_barrier_complete(bar, b.x, nloc, nx); b.st[0] = nloc; b.st[1] = nx; }
        const unsigned old = xb_add(&bar[XB_XSUB(b.x)], 1u);
        const unsigned gen = old / nloc;
        if (old + 1u == (gen + 1u) * nloc) {
            __builtin_amdgcn_fence(__ATOMIC_RELEASE, "agent");
            asm volatile("s_waitcnt vmcnt(0)" ::: "memory");
            const unsigned og = xb_add(&bar[XB_TOP], 1u);
            const unsigned tg = og / nx;
            if (og + 1u == (tg + 1u) * nx) xb_add(&bar[XB_TOPGEN], 1u);
            else XB_SPIN(xb_ld(&bar[XB_TOPGEN]) == tg, bar);
            __builtin_amdgcn_fence(__ATOMIC_ACQUIRE, "agent");
            xb_add(&bar[XB_XGEN(b.x)], 1u);
            asm volatile("s_waitcnt vmcnt(0)" ::: "memory");
        } else {
            XB_SPIN(xb_ld(&bar[XB_XGEN(b.x)]) == gen, bar);
            __builtin_amdgcn_fence(__ATOMIC_ACQUIRE, "agent");
            asm volatile("s_waitcnt vmcnt(0)" ::: "memory");
        }
    }
    __syncthreads();
}

struct KArgs { Ptrs p; int ph_lo, ph_hi; };

__global__ void __launch_bounds__(NTHREADS, 2) fwd_mega(KArgs args) {
    extern __shared__ __attribute__((aligned(16))) unsigned char lds_raw[];
    LAS unsigned char* lds = (LAS unsigned char*)lds_raw;
    cg::grid_group grid = cg::this_grid();
    const Ptrs& P = args.p;
    unsigned char* ws = P.ws;
    const int tid = threadIdx.x, bid = blockIdx.x, G = gridDim.x;
    unsigned* ctl = (unsigned*)(ws + OFF_CTL);
    float* misc = (float*)(ws + OFF_MISC);
    int ph = 0;
    if (args.ph_hi < 0) grid.sync();
    volatile LAS unsigned* xst = (volatile LAS unsigned*)(lds + 131072 + 16);
    if (tid == 0) { xst[0] = 0u; xst[1] = 0u; }
    __syncthreads();
    { const XcdBarrier xb0 = xcd_barrier_post((unsigned*)(ws + OFF_BAR), xst); if (tid == 0) xst[2] = xb0.x; }
    __syncthreads();
#define PHASE_BEGIN if (ph >= args.ph_lo && ph < args.ph_hi) {
#define PHASE_END(dosync_) if ((dosync_) && ph + 1 < args.ph_hi) { XcdBarrier xb_; xb_.bar = (unsigned*)(args.p.ws + OFF_BAR); xb_.st = (volatile LAS unsigned*)(lds + 131072 + 16); xb_.x = xb_.st[2]; xcd_barrier(xb_); } } ++ph;

    PHASE_BEGIN
        if (bid == 0) {
            if (tid < 64) ctl[tid] = 0u;
            if (tid < 2) { const float* lv = P.in[I_LAMBDA] + tid * 256; float s0 = 0.f, s1 = 0.f;
                for (int i = 0; i < 64; ++i) { s0 += lv[i] * lv[64 + i]; s1 += lv[128 + i] * lv[192 + i]; }
                const float li = 0.8f - 0.6f * expf(-0.3f * (float)tid);
                misc[tid * 2] = expf(s0) - expf(s1) + li; misc[tid * 2 + 1] = li; }
            for (int i = tid; i < 64 * 16; i += NTHREADS) { const int pos = i >> 4, f = i & 15; const float inv = powf(10000.0f, -(float)f / 16.0f); const float ang = (float)pos * inv;
                ((f32x2*)(ws + OFF_ROPE))[i] = (f32x2){cosf(ang), sinf(ang)}; }
        }
        mod_gemv(lds, P, bid, G);
        conv_win(lds, P, 0, bid, G);
        gen_dft(lds, ws, bid, G, true);
    PHASE_END(true)
    PHASE_BEGIN
        rows_first(P);
    PHASE_END(true)

    for (int l = 0; l < 2; ++l) {
        const int nMt = l == 0 ? 68 : 64;
        PHASE_BEGIN
            RectSched S{(const char*)(ws + OFF_HS), (const char*)(ws + OFF_WINT), (size_t)256 * D * 2, (size_t)256 * D * 2, 16, G, bid, nMt, 15, 64, l == 0 ? 0 : 4, 5};
            EpiInA E{ws, P.in[I_QNORM] + l * 64, P.in[I_KNORM] + l * 64, lds + 131072 + 256, ctl + 32 + 2 * l};
            pg8::gemm_phase(lds, D, D, S, E);
        PHASE_END(true)
        PHASE_BEGIN
            fourier_fold(ws, bid, G);
        PHASE_END(true)
        PHASE_BEGIN
            if (bid < 96) {
                OneSched S; S.have = true; S.u.pm = bid & 15; S.u.pn = bid >> 4; S.u.nt = 64;
                S.u.A = (const char*)(ws + A_DFT) + (size_t)S.u.pm * 256 * 4096 * 2; S.u.B = (const char*)(ws + A_FTF) + (size_t)S.u.pn * 256 * 4096 * 2;
                EpiFourier E{(bf16_t*)(ws + A_BRQ), 0, SEQ, 1.0f / 512.0f};
                pg8::gemm_phase(lds, 4096, 4096, S, E);
            } else if (l == 0 && bid < 102) {
                OneSched S; S.have = true; S.u.pm = 0; S.u.pn = bid - 96; S.u.nt = 8;
                S.u.A = (const char*)(ws + OFF_DFTC); S.u.B = (const char*)(ws + A_FTC) + (size_t)S.u.pn * 256 * 512 * 2;
                EpiFourier E{(bf16_t*)(ws + A_BRQ), MLAT, LC, 1.0f / 128.0f};
                pg8::gemm_phase(lds, 512, 512, S, E);
            }
            {
                const float lam = __uint_as_float(__builtin_amdgcn_readfirstlane(__float_as_uint(misc[l * 2]))), lam_init = __uint_as_float(__builtin_amdgcn_readfirstlane(__float_as_uint(misc[l * 2 + 1])));
                bool gsmall;
                { float mq = fabsf(P.in[I_QNORM][l * 64 + (tid & 63)]), mk = fabsf(P.in[I_KNORM][l * 64 + (tid & 63)]);
                  mq = wave_max(mq); mk = wave_max(mk);
                  gsmall = __builtin_amdgcn_readfirstlane((int)(64.0f * QSCALE * 1.02f * mq * mk < 60.0f)) != 0; }
                const int n_diff = 32, n_gqa = 32, n_cd = l == 0 ? 2 : 0, n_cg = l == 0 ? 2 : 0, n_conv = l == 0 ? 34 : 32;
                const int total = n_diff + n_gqa + n_cd + n_cg + n_conv;
                volatile LAS int* slot = (volatile LAS int*)(lds + 131072);
                for (int dx = 0; dx < 8; ++dx) {
                    const int x = (bid + dx) & 7;
                    for (;;) {
                        __syncthreads();
                        if (tid == 0) *slot = (int)atomicAdd(ctl + l * 8 + x, 1u);
                        __syncthreads();
                        int it = *slot;
                        if (it >= total) break;
                        if (it < n_diff) { const int pi = 2 * x + (it >> 4), b = pi >> 2, hd = pi & 3, qb = it & 15; diff_unit(lds, P, l, b, hd, b * SEQ + qb * 256, 0, LKV / 64, lam, lam_init); continue; }
                        it -= n_diff;
                        if (it < n_gqa) { const int b = x >> 1, qh = (x & 1) * 4 + 2 * (it >> 4), qb = it & 15; if (gsmall) gqa_pair_unit(lds, P, l, b, qh, b * SEQ + qb * 256, 0, LKV / 64);
                            else {
#pragma nounroll
                                for (int hh = 0; hh < 2; ++hh) gqa_unit(lds, P, l, b, qh + hh, b * SEQ + qb * 256, 0, LKV / 64); }
                            continue; }
                        it -= n_gqa;
                        if (it < n_cd) { const int pi = 2 * x + it, b = pi >> 2, hd = pi & 3; diff_unit(lds, P, l, b, hd, MLAT + b * LC, SEQ, LC / 64, lam, lam_init); continue; }
                        it -= n_cd;
                        if (it < n_cg) { const int b = x >> 1, qh = (x & 1) * 4 + 2 * it; if (gsmall) gqa_pair_unit(lds, P, l, b, qh, MLAT + b * LC, SEQ, LC / 64);
                            else {
#pragma nounroll
                                for (int hh = 0; hh < 2; ++hh) gqa_unit(lds, P, l, b, qh + hh, MLAT + b * LC, SEQ, LC / 64); }
                            continue; }
                        it -= n_cg;
                        { const int m0 = (x * n_conv + it) * 64; int s0, Ls; if (m0 < MLAT) { s0 = m0 & ~4095; Ls = SEQ; } else { s0 = MLAT + ((m0 - MLAT) & ~255); Ls = LC; }
                          conv_unit(lds, P, l, m0, s0, Ls); }
                    }
                }
                __syncthreads();
            }
        PHASE_END(true)
        PHASE_BEGIN
            {
                bf16_t* wbr = (bf16_t*)(ws + A_WBRT);
                convT(lds, P.in[I_WBRF] + (size_t)l * 384 * D, D, 384, wbr, KBR, D, MapId{0}, bid, G);
                convT(lds, P.in[I_WBRD] + (size_t)l * 512 * D, D, 512, wbr + 384, KBR, D, MapId{0}, (bid + 48) % G, G);
                convT(lds, P.in[I_WBRG] + (size_t)l * 512 * D, D, 512, wbr + 896, KBR, D, MapId{0}, (bid + 112) % G, G);
                convT(lds, P.in[I_WBRC] + (size_t)l * 384 * D, D, 384, wbr + 1408, KBR, D, MapId{0}, (bid + 176) % G, G);
                convT(lds, P.in[I_WOUT] + (size_t)l * D * D, D, D, (bf16_t*)(ws + A_WOUTT), D, D, MapId{0}, (bid + 224) % G, G);
                __syncthreads();
            }
            RectSched S{(const char*)(ws + OFF_HS), (const char*)(ws + OFF_WINT) + (size_t)3840 * D * 2, (size_t)256 * D * 2, (size_t)256 * D * 2, 16, G, bid, nMt, 16, 0, 0, 0};
            EpiGate E{(bf16_t*)(ws + A_G)};
            pg8::gemm_phase(lds, D, D, S, E);
        PHASE_END(true)
        PHASE_BEGIN
            RectSched S{(const char*)(ws + A_BRQ), (const char*)(ws + A_WBRT), (size_t)256 * KBR * 2, (size_t)256 * KBR * 2, 28, G, bid, nMt, 4, 0, 0, 0};
            EpiBranch E{(const bf16_t*)(ws + A_G), (bf16_t*)(ws + OFF_HS)};
            pg8::gemm_phase(lds, KBR, KBR, S, E);
        PHASE_END(true)
        PHASE_BEGIN
            RectSched S{(const char*)(ws + OFF_HS), (const char*)(ws + A_WOUTT), (size_t)256 * D * 2, (size_t)256 * D * 2, 16, G, bid, nMt, 4, 0, 0, 0};
            EpiBf16<0> E{(bf16_t*)(ws + A_MIXO), D};
            pg8::gemm_phase(lds, D, D, S, E);
        PHASE_END(true)
        PHASE_BEGIN
            rows_update(P, l, 0, l == 0 ? MTOT : MLAT);
            convT(lds, P.in[I_WFF1] + (size_t)l * D * DFF, DFF, D, (bf16_t*)(ws + A_WFF1T), D, DFF, MapId{0}, bid, G);
            convT(lds, P.in[I_WFF2] + (size_t)l * DFF * D, D, DFF, (bf16_t*)(ws + A_WFF2T), DFF, D, MapId{0}, bid, G);
        PHASE_END(true)
        PHASE_BEGIN
            RectSched S{(const char*)(ws + OFF_HS), (const char*)(ws + A_WFF1T), (size_t)256 * D * 2, (size_t)256 * D * 2, 16, G, bid, nMt, 16, 0, 0, 0};
            EpiBf16<2> E{(bf16_t*)(ws + A_FF), DFF};
            pg8::gemm_phase(lds, D, D, S, E);
        PHASE_END(true)
        PHASE_BEGIN
            RectSched S{(const char*)(ws + A_FF), (const char*)(ws + A_WFF2T), (size_t)256 * DFF * 2, (size_t)256 * DFF * 2, 64, G, bid, nMt, 4, 0, 0, 0};
            EpiBf16<0> E{(bf16_t*)(ws + A_MIXO), D};
            pg8::gemm_phase(lds, DFF, DFF, S, E);
        PHASE_END(true)
        PHASE_BEGIN
            rows_update(P, l, 1, l == 0 ? MTOT : MLAT);
            if (l == 0) { conv_win(lds, P, 1, bid, G); gen_dft(lds, ws, bid, G, false); }
        PHASE_END(l == 0)
    }
}

extern "C" void kernel_launch(void* const* d_in, const int* in_sizes, int n_in, void* d_out, int out_size, void* d_ws, size_t ws_size, hipStream_t stream) {
    static int grid = 0;
    if (grid == 0) {
        if (n_in != 26 || ws_size < WS_END) { fprintf(stderr, "kernel_launch: unexpected inputs (%d) or workspace (%zu < %zu)\n", n_in, ws_size, (size_t)WS_END); grid = -1; return; }
        int dev = 0, cus = 0, per_cu = 0;
        (void)hipGetDevice(&dev);
        (void)hipDeviceGetAttribute(&cus, hipDeviceAttributeMultiprocessorCount, dev);
        if (hipFuncSetAttribute((const void*)fwd_mega, hipFuncAttributeMaxDynamicSharedMemorySize, LDS_BYTES) != hipSuccess) { fprintf(stderr, "hipFuncSetAttribute failed\n"); grid = -1; return; }
        if (hipOccupancyMaxActiveBlocksPerMultiprocessor(&per_cu, (const void*)fwd_mega, NTHREADS, LDS_BYTES) != hipSuccess || per_cu < 1) { fprintf(stderr, "occupancy query: %d\n", per_cu); per_cu = 1; }
        (void)hipGetLastError();
        grid = cus * per_cu;
        if (grid > 256) grid = 256;
    }
    if (grid < 0) return;
    KArgs a{};
    for (int i = 0; i < 26; ++i) a.p.in[i] = (const float*)d_in[i];
    a.p.out = (float*)d_out; a.p.ws = (unsigned char*)d_ws;
#ifndef PROBE_RANGES
#define PROBE_RANGES {0, 1000}
#endif
    static const int ranges[][2] = { PROBE_RANGES };
    const int nr = (int)(sizeof(ranges) / sizeof(ranges[0]));
    for (int i = 0; i < nr; ++i) {
        if (i > 0) (void)hipMemsetAsync((char*)d_ws + OFF_CTL, 0, 256, stream);
        (void)hipMemsetAsync((char*)d_ws + OFF_BAR, 0, 16384, stream);
        a.ph_lo = ranges[i][0]; a.ph_hi = ranges[i][1];
        void* kargs[] = {&a};
        hipError_t e = hipLaunchCooperativeKernel((const void*)fwd_mega, dim3(grid), dim3(NTHREADS), kargs, LDS_BYTES, stream);
        if (e != hipSuccess) fprintf(stderr, "cooperative launch failed: %s (grid %d)\n", hipGetErrorString(e), grid);
    }
}
```
